# Optimizing an MI355X kernel written in HIP

```python
import jax, jax.numpy as jnp
from jax import lax
import numpy as np

D_MODEL = 1024
BATCH = 4
SEQ = 8192
DEPTH = 2
DEC_BATCH = 8
DEC_SEQ = 32
PAST_LEN = 1024

CHUNK = 64
EPS = 1e-6
N_HEADS = 16
N_KV_HEADS = 2
GROUP = N_HEADS // N_KV_HEADS
HEAD_DIM = 64
WINDOW = 128
WINDOW_CHUNKS = WINDOW // CHUNK
ATTN_WIDTH = N_HEADS * HEAD_DIM
KV_WIDTH = N_KV_HEADS * HEAD_DIM
POOL_WINDOWS = (2, 4, 8, 16)
POOL_GROUPS = 4
POOL_GROUP_WIDTH = D_MODEL // 8
POOL_WIDTH = POOL_GROUPS * POOL_GROUP_WIDTH
POOL_STATE = 16 - 1
SGU_LEN = 128
SGU_GROUPS = 4
SGU_GROUP_WIDTH = D_MODEL // 8
SGU_WIDTH = SGU_GROUPS * SGU_GROUP_WIDTH
N_BRANCH = 3
Q_END = ATTN_WIDTH
K_END = Q_END + KV_WIDTH
V_END = K_END + KV_WIDTH
POOL_END = V_END + POOL_WIDTH
SU_END = POOL_END + SGU_WIDTH
SV_END = SU_END + SGU_WIDTH
N_IN = SV_END + N_BRANCH * D_MODEL
IN_SPLITS = (Q_END, K_END, V_END, POOL_END, SU_END, SV_END)
D_FF = 2816
CONV_W = 3

kernel_name = "chunk_causal_hybrid_gated_encoder_step"


def rmsnorm(x, g):
    xf = x.astype(jnp.float32)
    y = xf * lax.rsqrt(jnp.mean(xf * xf, axis=-1, keepdims=True) + EPS)
    return (y * g.astype(jnp.float32)).astype(x.dtype)


def alibi_slopes():
    h = jnp.arange(1, N_HEADS + 1, dtype=jnp.float32)
    return jnp.exp2(-8.0 * h / N_HEADS)


def band_attention(q, k, v, qpos, kpos, sink):
    logits = jnp.einsum('bnqkgd,bnskd->bnkgqs', q, k).astype(jnp.float32) * (HEAD_DIM ** -0.5)
    qc = (qpos // CHUNK)[:, :, None]
    kc = (kpos // CHUNK)[:, None, :]
    vis = (kpos[:, None, :] >= 0) & (kc <= qc) & (qc - kc <= WINDOW_CHUNKS)
    dist = jnp.abs(qpos[:, :, None] - kpos[:, None, :]).astype(jnp.float32)
    slopes = alibi_slopes().reshape(N_KV_HEADS, GROUP)
    bias = jnp.where(vis[:, None, None], -slopes[None, :, :, None, None] * dist[:, None, None], -jnp.inf)
    logits = logits + bias[None]
    s = sink.astype(jnp.float32).reshape(N_KV_HEADS, GROUP)[None, None, :, :, None, None]
    m = jnp.maximum(jnp.max(logits, axis=-1, keepdims=True), s)
    p = jnp.exp(logits - m)
    denom = jnp.sum(p, axis=-1, keepdims=True) + jnp.exp(s - m)
    return jnp.einsum('bnkgqs,bnskd->bnqkgd', (p / denom).astype(v.dtype), v)


def attn_prompt(q, k, v, sink):
    B, T = q.shape[:2]
    nc = T // CHUNK
    pad = WINDOW_CHUNKS * CHUNK

    def band(a):
        ap = jnp.pad(a, ((0, 0), (pad, 0), (0, 0), (0, 0))).reshape(B, nc + WINDOW_CHUNKS, CHUNK, N_KV_HEADS, HEAD_DIM)
        return jnp.concatenate([ap[:, j:j + nc] for j in range(WINDOW_CHUNKS + 1)], axis=2)

    qb = q.reshape(B, nc, CHUNK, N_KV_HEADS, GROUP, HEAD_DIM)
    qpos = jnp.arange(T, dtype=jnp.int32).reshape(nc, CHUNK)
    kpos = (jnp.arange(nc, dtype=jnp.int32) * CHUNK - pad)[:, None] + jnp.arange((WINDOW_CHUNKS + 1) * CHUNK, dtype=jnp.int32)[None, :]
    o = band_attention(qb, band(k), band(v), qpos, kpos, sink)
    return o.reshape(B, T, ATTN_WIDTH)


def attn_sample(q, k, v, win_k, win_v, pos0, sink):
    B, T = q.shape[:2]
    wc = win_k.shape[1]
    k_all = jnp.concatenate([win_k.astype(k.dtype), k], axis=1)
    v_all = jnp.concatenate([win_v.astype(v.dtype), v], axis=1)
    qpos = (pos0 + jnp.arange(T, dtype=jnp.int32))[None]
    kpos = (pos0 - wc + jnp.arange(wc + T, dtype=jnp.int32))[None]
    o = band_attention(q[:, None], k_all[:, None], v_all[:, None], qpos, kpos, sink)
    return o.reshape(B, T, ATTN_WIDTH), k_all[:, T:], v_all[:, T:]


def pool_mixer(u_ext, pos0, pool_w, pool_scale):
    B, L, _ = u_ext.shape
    T = L - POOL_STATE
    uf = u_ext.astype(jnp.float32)
    cs = jnp.concatenate([jnp.zeros((B, 1, POOL_WIDTH), jnp.float32), jnp.cumsum(uf, axis=1)], axis=1)
    pos = pos0 + jnp.arange(T, dtype=jnp.int32)
    outs = []
    for gi, w in enumerate(POOL_WINDOWS):
        c0, c1 = gi * POOL_GROUP_WIDTH, (gi + 1) * POOL_GROUP_WIDTH
        win_sum = cs[:, POOL_STATE + 1:POOL_STATE + 1 + T, c0:c1] - cs[:, POOL_STATE + 1 - w:POOL_STATE + 1 - w + T, c0:c1]
        cnt = jnp.minimum(pos + 1, w).astype(jnp.float32)[None, :, None]
        d = (win_sum / cnt - uf[:, POOL_STATE:, c0:c1]).astype(u_ext.dtype)
        outs.append(jnp.einsum('btc,cd->btd', d, pool_w[gi]))
    return jnp.concatenate(outs, axis=-1) * pool_scale


def spatial_gate(u, vn, sgu_w, sgu_b):
    L = u.shape[2]
    i = jnp.arange(L)
    mask = (i[None, :] // CHUNK) <= (i[:, None] // CHUNK)
    w = jnp.where(mask[None], sgu_w[:, :L, :L], 0)
    s = jnp.einsum('gij,bnjgc->bnigc', w, vn) + jnp.transpose(sgu_b[:, :L])[None, None, :, :, None]
    return u * s


def conv_ffn(h, conv_prefix, ffn_w_up, ffn_conv_w, ffn_conv_b, ffn_w_down):
    T = h.shape[1]
    up = jnp.einsum('btd,df->btf', h, ffn_w_up)
    a, b = jnp.split(up, 2, axis=-1)
    a_ext = jnp.concatenate([conv_prefix.astype(a.dtype), a], axis=1)
    conv = sum(a_ext[:, j:j + T] * ffn_conv_w[j] for j in range(CONV_W)) + ffn_conv_b
    out = jnp.einsum('btf,fd->btd', jax.nn.gelu(conv) * b, ffn_w_down)
    return out, a_ext[:, -(CONV_W - 1):]


def layer_forward(x, c, win_k, win_v, pool_prefix, conv_prefix, pos0,
                  norm1_g, norm2_g, w_ada, b_ada, w_in, attn_sink, w_o_attn,
                  pool_w, pool_scale, w_o_pool, sgu_norm_g, sgu_w, sgu_b, w_o_sgu,
                  w_out, ffn_w_up, ffn_conv_w, ffn_conv_b, ffn_w_down):
    B, T, _ = x.shape
    mod = jnp.einsum('bd,de->be', jax.nn.silu(c), w_ada) + b_ada
    sh1, sc1, g1, sh2, sc2, g2 = [m[:, None, :] for m in jnp.split(mod, 6, axis=-1)]
    h = rmsnorm(x, norm1_g) * (1 + sc1) + sh1
    z = jnp.einsum('btd,de->bte', h, w_in)
    q, k, v, pu, su, sv, gates = jnp.split(z, IN_SPLITS, axis=-1)
    q = q.reshape(B, T, N_KV_HEADS, GROUP, HEAD_DIM)
    k = k.reshape(B, T, N_KV_HEADS, HEAD_DIM)
    v = v.reshape(B, T, N_KV_HEADS, HEAD_DIM)
    if win_k is None:
        ya = attn_prompt(q, k, v, attn_sink)
        keep = min(WINDOW, T)
        new_k, new_v = k[:, T - keep:], v[:, T - keep:]
    else:
        ya, new_k, new_v = attn_sample(q, k, v, win_k, win_v, pos0, attn_sink)
    u_ext = jnp.concatenate([pool_prefix.astype(pu.dtype), pu], axis=1)
    yb = pool_mixer(u_ext, pos0, pool_w, pool_scale)
    new_pool = u_ext[:, -POOL_STATE:]
    uu = jax.nn.gelu(su)
    vn = rmsnorm(jax.nn.gelu(sv), sgu_norm_g)
    L = SGU_LEN if win_k is None else T
    yc = spatial_gate(uu.reshape(B, T // L, L, SGU_GROUPS, SGU_GROUP_WIDTH),
                      vn.reshape(B, T // L, L, SGU_GROUPS, SGU_GROUP_WIDTH),
                      sgu_w, sgu_b).reshape(B, T, SGU_WIDTH)
    ga, gb, gc = jnp.split(gates, N_BRANCH, axis=-1)
    merged = (jax.nn.sigmoid(ga) * jnp.einsum('bte,ed->btd', ya, w_o_attn)
              + jax.nn.sigmoid(gb) * jnp.einsum('bte,ed->btd', yb, w_o_pool)
              + jax.nn.sigmoid(gc) * jnp.einsum('bte,ed->btd', yc, w_o_sgu))
    x = x + g1 * jnp.einsum('btd,de->bte', merged, w_out)
    h2 = rmsnorm(x, norm2_g) * (1 + sc2) + sh2
    f, new_conv = conv_ffn(h2, conv_prefix, ffn_w_up, ffn_conv_w, ffn_conv_b, ffn_w_down)
    x = x + g2 * f
    return x, new_k, new_v, new_pool, new_conv, vn


def setup_inputs(seed: int = 0) -> dict:
    key = jax.random.key(seed)
    ks = jax.random.split(key, 28)

    def nrm(k, shape, scale):
        return jax.random.normal(k, shape, jnp.float32) * scale

    win_cache = min(WINDOW, PAST_LEN)
    return {
        "x_prompt": nrm(ks[0], (BATCH, SEQ, D_MODEL), 1.0),
        "x_sample": nrm(ks[1], (DEC_BATCH, DEC_SEQ, D_MODEL), 1.0),
        "c_prompt": nrm(ks[2], (BATCH, D_MODEL), 1.0),
        "c_sample": nrm(ks[3], (DEC_BATCH, D_MODEL), 1.0),
        "cache_k_win": nrm(ks[4], (DEPTH, DEC_BATCH, win_cache, N_KV_HEADS, HEAD_DIM), 1.0),
        "cache_v_win": nrm(ks[5], (DEPTH, DEC_BATCH, win_cache, N_KV_HEADS, HEAD_DIM), 1.0),
        "state_pool": nrm(ks[6], (DEPTH, DEC_BATCH, POOL_STATE, POOL_WIDTH), 1.0),
        "state_ffn_conv": nrm(ks[7], (DEPTH, DEC_BATCH, CONV_W - 1, D_FF), 1.0),
        "norm1_g": 1.0 + nrm(ks[8], (DEPTH, D_MODEL), 0.05),
        "norm2_g": 1.0 + nrm(ks[9], (DEPTH, D_MODEL), 0.05),
        "w_ada": nrm(ks[10], (DEPTH, D_MODEL, 6 * D_MODEL), 0.5 * D_MODEL ** -0.5),
        "b_ada": nrm(ks[11], (DEPTH, 6 * D_MODEL), 0.02),
        "w_in": nrm(ks[12], (DEPTH, D_MODEL, N_IN), D_MODEL ** -0.5),
        "attn_sink": nrm(ks[13], (DEPTH, N_HEADS), 0.5),
        "w_o_attn": nrm(ks[14], (DEPTH, ATTN_WIDTH, D_MODEL), ATTN_WIDTH ** -0.5),
        "pool_w": nrm(ks[15], (DEPTH, POOL_GROUPS, POOL_GROUP_WIDTH, POOL_GROUP_WIDTH), POOL_GROUP_WIDTH ** -0.5),
        "pool_scale": 1.0 + nrm(ks[16], (DEPTH, POOL_WIDTH), 0.1),
        "w_o_pool": nrm(ks[17], (DEPTH, POOL_WIDTH, D_MODEL), POOL_WIDTH ** -0.5),
        "sgu_norm_g": 1.0 + nrm(ks[18], (DEPTH, SGU_WIDTH), 0.05),
        "sgu_w": nrm(ks[19], (DEPTH, SGU_GROUPS, SGU_LEN, SGU_LEN), SGU_LEN ** -0.5),
        "sgu_b": 1.0 + nrm(ks[20], (DEPTH, SGU_GROUPS, SGU_LEN), 0.1),
        "w_o_sgu": nrm(ks[21], (DEPTH, SGU_WIDTH, D_MODEL), SGU_WIDTH ** -0.5),
        "w_out": nrm(ks[22], (DEPTH, D_MODEL, D_MODEL), D_MODEL ** -0.5),
        "ffn_w_up": nrm(ks[23], (DEPTH, D_MODEL, 2 * D_FF), D_MODEL ** -0.5),
        "ffn_conv_w": nrm(ks[24], (DEPTH, CONV_W, D_FF), CONV_W ** -0.5),
        "ffn_conv_b": nrm(ks[25], (DEPTH, D_FF), 0.02),
        "ffn_w_down": nrm(ks[26], (DEPTH, D_FF, D_MODEL), D_FF ** -0.5),
        "final_norm_g": 1.0 + nrm(ks[27], (D_MODEL,), 0.05),
    }


def reference(x_prompt, x_sample, c_prompt, c_sample, cache_k_win, cache_v_win, state_pool, state_ffn_conv,
              norm1_g, norm2_g, w_ada, b_ada, w_in, attn_sink, w_o_attn, pool_w, pool_scale, w_o_pool,
              sgu_norm_g, sgu_w, sgu_b, w_o_sgu, w_out, ffn_w_up, ffn_conv_w, ffn_conv_b, ffn_w_down,
              final_norm_g):
    layer_params = (norm1_g, norm2_g, w_ada, b_ada, w_in, attn_sink, w_o_attn, pool_w, pool_scale, w_o_pool,
                    sgu_norm_g, sgu_w, sgu_b, w_o_sgu, w_out, ffn_w_up, ffn_conv_w, ffn_conv_b, ffn_w_down)
    xp, xs = x_prompt, x_sample
    kp, vp, pp, cp = [], [], [], []
    ks_, vs_, ps_, cs_, ss_ = [], [], [], [], []
    for l in range(DEPTH):
        lw = [p[l] for p in layer_params]
        zero_pool = jnp.zeros((xp.shape[0], POOL_STATE, POOL_WIDTH), xp.dtype)
        zero_conv = jnp.zeros((xp.shape[0], CONV_W - 1, D_FF), xp.dtype)
        xp, nk, nv, npool, nconv, _ = layer_forward(xp, c_prompt, None, None, zero_pool, zero_conv, 0, *lw)
        kp.append(nk); vp.append(nv); pp.append(npool); cp.append(nconv)
        xs, nk, nv, npool, nconv, nsv = layer_forward(xs, c_sample, cache_k_win[l], cache_v_win[l],
                                                     state_pool[l], state_ffn_conv[l], PAST_LEN, *lw)
        ks_.append(nk); vs_.append(nv); ps_.append(npool); cs_.append(nconv); ss_.append(nsv)
    y_prompt = rmsnorm(xp, final_norm_g)
    y_sample = rmsnorm(xs, final_norm_g)
    return (y_prompt, y_sample,
            jnp.stack(kp), jnp.stack(vp), jnp.stack(pp), jnp.stack(cp),
            jnp.stack(ks_), jnp.stack(vs_), jnp.stack(ps_), jnp.stack(cs_), jnp.stack(ss_))
```

```cpp
#include <hip/hip_runtime.h>
#include <hip/hip_cooperative_groups.h>
#include <cstdio>
namespace cg = cooperative_groups;

#ifndef MULTI_LAUNCH
#define MULTI_LAUNCH 0
#endif

#define LAS __attribute__((address_space(3)))
typedef unsigned short bf16_t;
typedef short bf16x8 __attribute__((ext_vector_type(8)));
typedef float f32x4 __attribute__((ext_vector_type(4)));
typedef unsigned u32x4 __attribute__((ext_vector_type(4)));
typedef unsigned u32x2 __attribute__((ext_vector_type(2)));

constexpr int D = 1024, SEQ = 8192, NBP = 4, NBS = 8, ST = 32;
constexpr int MP = NBP * SEQ;
constexpr int MS = NBS * ST;
constexpr int M = MP + MS;
constexpr int NIN = 5888, DFF = 2816, NUP = 5632;
constexpr int NTHREADS = 512, NWAVES = 8;
constexpr int ZC_Q = 0, ZC_K = 1024, ZC_V = 1152, ZC_PU = 1280, ZC_SU = 1792, ZC_SV = 2304, ZC_G = 2816;
constexpr size_t O_YP = 0;
constexpr size_t O_YS = O_YP + (size_t)MP * D;
constexpr size_t O_KP = O_YS + (size_t)MS * D;
constexpr size_t O_VP = O_KP + 2 * 4 * 128 * 128;
constexpr size_t O_PP = O_VP + 2 * 4 * 128 * 128;
constexpr size_t O_CP = O_PP + 2 * 4 * 15 * 512;
constexpr size_t O_KS = O_CP + 2 * 4 * 2 * DFF;
constexpr size_t O_VS = O_KS + 2 * 8 * 128 * 128;
constexpr size_t O_PS = O_VS + 2 * 8 * 128 * 128;
constexpr size_t O_CS = O_PS + 2 * 8 * 15 * 512;
constexpr size_t O_SV = O_CS + 2 * 8 * 2 * DFF;
constexpr size_t WS_MOD = 4096;
constexpr size_t WS_W = 1048576;
constexpr size_t WL_IN = 0;
constexpr size_t WL_CAT = WL_IN + (size_t)NIN * D * 2;
constexpr size_t WL_OUT = WL_CAT + (size_t)D * 2048 * 2;
constexpr size_t WL_UP = WL_OUT + (size_t)D * D * 2;
constexpr size_t WL_DN = WL_UP + (size_t)NUP * D * 2;
constexpr size_t WL_PW = WL_DN + (size_t)D * DFF * 2;
constexpr size_t WL_SG = WL_PW + 4 * 128 * 128 * 2;
constexpr size_t WL_SIZE = WL_SG + 4 * 128 * 128 * 2;
constexpr size_t WS_H = WS_W + 2 * WL_SIZE;
constexpr size_t WS_Z = WS_H + (size_t)M * D * 2;
constexpr size_t WS_END = WS_Z + (size_t)M * NIN * 2;
constexpr int LDS_BYTES = 131072 + 8192;

struct Params {
    const float *x_prompt, *x_sample, *c_prompt, *c_sample, *cache_k, *cache_v, *state_pool, *state_conv;
    const float *norm1_g, *norm2_g, *w_ada, *b_ada, *w_in, *attn_sink, *w_o_attn, *pool_w, *pool_scale, *w_o_pool;
    const float *sgu_norm_g, *sgu_w, *sgu_b, *w_o_sgu, *w_out, *ffn_w_up, *ffn_conv_w, *ffn_conv_b, *ffn_w_down, *final_norm_g;
    float* out; unsigned char* ws;
    int ph_lo, ph_hi;
};

__device__ __forceinline__ unsigned f2bf(float f) { unsigned u = __builtin_bit_cast(unsigned, f); return (u + 0x7fffu + ((u >> 16) & 1u)) >> 16; }
__device__ __forceinline__ unsigned pk2(float lo, float hi) { return f2bf(lo) | (f2bf(hi) << 16); }
__device__ __forceinline__ float bflo(unsigned w) { return __builtin_bit_cast(float, w << 16); }
__device__ __forceinline__ float bfhi(unsigned w) { return __builtin_bit_cast(float, w & 0xffff0000u); }
__device__ __forceinline__ float bf1(bf16_t h) { return __builtin_bit_cast(float, ((unsigned)h) << 16); }
__device__ __forceinline__ float sigmoidf_(float x) { return 1.0f / (1.0f + __expf(-x)); }
__device__ __forceinline__ float gelu_tanh(float x) { const float u = 0.7978845608028654f * (x + 0.044715f * x * x * x); return x / (1.0f + __expf(-2.0f * u)); }
__device__ __forceinline__ float wave_sum(float v) {
#pragma unroll
    for (int o = 1; o < 64; o <<= 1) v += __shfl_xor(v, o);
    return v;
}
__device__ __forceinline__ int batch_of_row(int row) { return row < MP ? (row >> 13) : 4 + ((row - MP) >> 5); }

namespace pg8 {
constexpr int BM = 256, BK = 64, HALF = 128, HTB = HALF * BK * 2, NXCD = 8, WGM = 8;
__device__ __forceinline__ int lds_byte(int r, int c) { const int st = (r >> 4) * 2 + (c >> 5), rr = r & 15, cc = c & 31, ob = rr * 64 + cc * 2; return st * 1024 + (ob ^ (((ob >> 9) & 1) << 5)); }
__device__ __forceinline__ void stage_rc(int b, int& R, int& C) { const int st = b / 1024, sb = b % 1024, swz = sb ^ (((sb >> 9) & 1) << 5); R = (st >> 1) * 16 + swz / 64; C = (st & 1) * 32 + (swz % 64) / 2; }
__device__ __forceinline__ int perm32(int rho) { const int n = rho >> 4, i = rho & 15; return 8 * (i >> 2) + 4 * n + (i & 3); }

struct Unit { const char* A; const char* B; int nt, pm, pn, mode; };

__device__ __forceinline__ void tile_of(int wgid, int nM, int nN, int& pm, int& pn) {
    const int nwg = nM * nN;
    { const int q = nwg / NXCD, r = nwg % NXCD, xcd = wgid % NXCD, off = wgid / NXCD; wgid = (xcd < r ? xcd * (q + 1) : r * (q + 1) + (xcd - r) * q) + off; }
    const int nig = WGM * nN, gid = wgid / nig, fm = gid * WGM, gsz = (nM - fm) < WGM ? (nM - fm) : WGM;
    pm = fm + ((wgid % nig) % gsz); pn = (wgid % nig) / gsz;
}

struct SimpleOrder {
    const char* A; const char* B; size_t lda, ldb; int nM, nN, nt, G, c;
    __device__ __forceinline__ bool next(int i, Unit& u) const {
        const long L = (long)i * G + c; if (L >= (long)nM * nN) return false;
        int pm, pn; tile_of((int)L, nM, nN, pm, pn);
        u.pm = pm; u.pn = pn; u.nt = nt; u.mode = 0; u.A = A + (size_t)pm * 256 * lda; u.B = B + (size_t)pn * 256 * ldb; return true;
    }
};
struct MergeOrder {
    const char* A; const char* B; size_t lda, ldb; int nM, nN, G, c;
    __device__ __forceinline__ bool next(int i, Unit& u) const {
        const int ti = i / 3, br = i - ti * 3;
        const long L = (long)ti * G + c; if (L >= (long)nM * nN) return false;
        int pm, pn; tile_of((int)L, nM, nN, pm, pn);
        u.pm = pm; u.pn = pn; u.mode = br;
        const int ak = br == 0 ? ZC_Q : (br == 1 ? ZC_SV : ZC_SU);
        const int bk = br == 0 ? 0 : (br == 1 ? 1024 : 1536);
        u.nt = br == 0 ? 16 : 8;
        u.A = A + (size_t)pm * 256 * lda + (size_t)ak * 2; u.B = B + (size_t)pn * 256 * ldb + (size_t)bk * 2; return true;
    }
};

template <class Epi, class Sched>
__device__ __forceinline__ void gemm_phase(LAS unsigned char* lds, const size_t lda, const size_t ldb, const Sched& S, const Epi& E) {
    int tid_ = threadIdx.x; asm volatile("" : "+v"(tid_));
    const int tid = tid_, wid = __builtin_amdgcn_readfirstlane(tid >> 6), lane = tid & 63, wr = wid >> 2, wc = wid & 3, fr = lane & 15, fq = lane >> 4;
    unsigned voffA[2], voffB[2];
#pragma unroll
    for (int i = 0; i < 2; ++i) { int R, C; stage_rc(tid * 16 + i * 8192, R, C); const int Rb = Epi::PERM ? ((R & ~31) + perm32(R & 31)) : R;
        voffA[i] = (unsigned)(R * lda + C * 2); voffB[i] = (unsigned)(Rb * ldb + C * 2); }
    const size_t kstep = (size_t)(BK * 2);
    const size_t hstepA = (size_t)HALF * lda, hstepB = (size_t)HALF * ldb;
    const unsigned ldsw = (unsigned)wid * 1024u;
    const int aoff = lds_byte(wr * 64 + fr, fq * 8), boff = lds_byte(wc * 32 + fr, fq * 8);
#define PG8_SA(b, h) (((b) * 2 + (h)) * HTB)
#define PG8_SB(b, h) ((4 + (b) * 2 + (h)) * HTB)
#define PG8_STAGE(bufoff, gbase, voff) do { _Pragma("unroll") for (int _i = 0; _i < 2; ++_i) \
        __builtin_amdgcn_global_load_lds((const unsigned*)((const char*)(gbase) + (voff)[_i]), (LAS unsigned*)(lds + (bufoff) + ldsw + _i * 8192), 16, 0, 0); } while (0)
#define PG8_LDA(dst, b, h) do { _Pragma("unroll") for (int m = 0; m < 4; ++m) _Pragma("unroll") for (int k = 0; k < 2; ++k) dst[m][k] = *(const LAS bf16x8*)(lds + PG8_SA(b, h) + aoff + m * 2048 + k * 1024); } while (0)
#define PG8_LDB(dst, b, h) do { _Pragma("unroll") for (int n = 0; n < 2; ++n) _Pragma("unroll") for (int k = 0; k < 2; ++k) dst[n][k] = *(const LAS bf16x8*)(lds + PG8_SB(b, h) + boff + n * 2048 + k * 1024); } while (0)
#define PG8_MMA(ai, bj, At, Bt) do { __builtin_amdgcn_s_setprio(1); _Pragma("unroll") for (int m = 0; m < 4; ++m) _Pragma("unroll") for (int n = 0; n < 2; ++n) _Pragma("unroll") for (int k = 0; k < 2; ++k) \
        acc[ai][bj][m][n] = __builtin_amdgcn_mfma_f32_16x16x32_bf16(Bt[n][k], At[m][k], acc[ai][bj][m][n], 0, 0, 0); __builtin_amdgcn_s_setprio(0); } while (0)
#define PG8_WAIT_V(n) asm volatile("s_waitcnt vmcnt(" #n ")" ::: "memory")
#define PG8_WAIT_L(n) asm volatile("s_waitcnt lgkmcnt(" #n ")" ::: "memory")
#define PG8_BAR __builtin_amdgcn_s_barrier()
#define PG8_SCHED __builtin_amdgcn_sched_barrier(0)
    Unit cur, nxt; int ui = 0;
    if (!S.next(0, cur)) return;
    f32x4 acc[2][2][4][2];
#pragma unroll
    for (int a = 0; a < 2; ++a)
#pragma unroll
        for (int b = 0; b < 2; ++b)
#pragma unroll
            for (int m = 0; m < 4; ++m)
#pragma unroll
                for (int n = 0; n < 2; ++n) acc[a][b][m][n] = (f32x4){0.f, 0.f, 0.f, 0.f};
    bf16x8 At[4][2], B0[2][2], B1[2][2];
    const char* cA = cur.A; const char* cB = cur.B;
    PG8_STAGE(PG8_SB(0, 0), cB, voffB); PG8_STAGE(PG8_SA(0, 0), cA, voffA); PG8_STAGE(PG8_SB(0, 1), cB + hstepB, voffB); PG8_STAGE(PG8_SA(0, 1), cA + hstepA, voffA);
    if (wr == 1) PG8_BAR;
    PG8_WAIT_V(4); PG8_BAR;
    PG8_STAGE(PG8_SB(1, 0), cB + kstep, voffB); PG8_STAGE(PG8_SA(1, 0), cA + kstep, voffA); PG8_STAGE(PG8_SB(1, 1), cB + hstepB + kstep, voffB);
    PG8_WAIT_V(6); PG8_BAR;
    for (;;) {
        const bool has_next = S.next(ui + 1, nxt);
        const char* nA = has_next ? nxt.A : cA; const char* nB = has_next ? nxt.B : cB;
        const int nt = cur.nt;
        for (int t = 0; t < nt; t += 2) {
            const bool last = (t == nt - 2);
            const char* a1 = cA + (size_t)(t + 1) * kstep;
            const char* a2 = last ? nA : cA + (size_t)(t + 2) * kstep; const char* b2 = last ? nB : cB + (size_t)(t + 2) * kstep;
            const char* a3 = a2 + kstep; const char* b3 = b2 + kstep;
            PG8_LDB(B0, 0, 0); PG8_SCHED; PG8_LDA(At, 0, 0); PG8_STAGE(PG8_SA(1, 1), a1 + hstepA, voffA);
            PG8_WAIT_L(8); PG8_BAR; PG8_WAIT_L(0); PG8_MMA(0, 0, At, B0); PG8_BAR; PG8_SCHED;
            PG8_LDB(B1, 0, 1); PG8_STAGE(PG8_SB(0, 0), b2, voffB);
            PG8_BAR; PG8_WAIT_L(0); PG8_MMA(0, 1, At, B1); PG8_BAR;
            PG8_LDA(At, 0, 1); PG8_STAGE(PG8_SA(0, 0), a2, voffA);
            PG8_BAR; PG8_WAIT_L(0); PG8_MMA(1, 0, At, B0); PG8_BAR; PG8_SCHED;
            PG8_STAGE(PG8_SB(0, 1), b2 + hstepB, voffB);
            PG8_WAIT_V(6); PG8_BAR; PG8_MMA(1, 1, At, B1); PG8_BAR;
            PG8_LDB(B0, 1, 0); PG8_SCHED; PG8_LDA(At, 1, 0); PG8_STAGE(PG8_SA(0, 1), a2 + hstepA, voffA);
            PG8_WAIT_L(8); PG8_BAR; PG8_WAIT_L(0); PG8_MMA(0, 0, At, B0); PG8_BAR; PG8_SCHED;
            PG8_LDB(B1, 1, 1); PG8_STAGE(PG8_SB(1, 0), b3, voffB);
            PG8_BAR; PG8_WAIT_L(0); PG8_MMA(0, 1, At, B1); PG8_BAR;
            PG8_LDA(At, 1, 1); PG8_STAGE(PG8_SA(1, 0), a3, voffA);
            PG8_BAR; PG8_WAIT_L(0); PG8_MMA(1, 0, At, B0); PG8_BAR; PG8_SCHED;
            PG8_STAGE(PG8_SB(1, 1), b3 + hstepB, voffB);
            PG8_WAIT_V(6); PG8_BAR; PG8_MMA(1, 1, At, B1); PG8_BAR;
        }
        E(acc, cur, wr, wc, fr, fq);
        if (!has_next) break;
#pragma unroll
        for (int a = 0; a < 2; ++a)
#pragma unroll
            for (int b = 0; b < 2; ++b)
#pragma unroll
                for (int m = 0; m < 4; ++m)
#pragma unroll
                    for (int n = 0; n < 2; ++n) acc[a][b][m][n] = (f32x4){0.f, 0.f, 0.f, 0.f};
        cur = nxt; cA = nA; cB = nB; ++ui;
    }
    PG8_WAIT_V(0);
    if (wr == 0) PG8_BAR;
    PG8_BAR;
#undef PG8_SA
#undef PG8_SB
#undef PG8_STAGE
#undef PG8_LDA
#undef PG8_LDB
#undef PG8_MMA
#undef PG8_WAIT_V
#undef PG8_WAIT_L
#undef PG8_BAR
#undef PG8_SCHED
}
}

struct EpiZ {
    static constexpr bool PERM = true;
    bf16_t* Z; float* out; int layer;
    __device__ __forceinline__ void operator()(const f32x4 (&acc)[2][2][4][2], const pg8::Unit& u, int wr, int wc, int fr, int fq) const {
        const int pn = u.pn;
#pragma unroll
        for (int ai = 0; ai < 2; ++ai)
#pragma unroll
            for (int m = 0; m < 4; ++m) {
                const int row = u.pm * 256 + ai * 128 + wr * 64 + m * 16 + fr;
                int b, t; const bool samp = row >= MP;
                if (!samp) { b = row >> 13; t = row & 8191; } else { b = (row - MP) >> 5; t = (row - MP) & 31; }
#pragma unroll
                for (int bj = 0; bj < 2; ++bj) {
                    const int col0 = pn * 256 + bj * 128 + wc * 32 + 8 * fq;
                    f32x4 v0 = acc[ai][bj][m][0], v1 = acc[ai][bj][m][1];
                    if (pn == 4) {
                        const int cc = col0 - ZC_K; float* dst = nullptr;
                        if (!samp) { if (t >= SEQ - 128) dst = out + (cc < 128 ? O_KP : O_VP) + ((size_t)((layer * 4 + b) * 128 + (t - (SEQ - 128))) * 128 + (cc & 127)); }
                        else dst = out + (cc < 128 ? O_KS : O_VS) + ((size_t)((layer * 8 + b) * 128 + 96 + t) * 128 + (cc & 127));
                        if (dst) { *(f32x4*)dst = v0; *(f32x4*)(dst + 4) = v1; }
                    } else if (pn == 5 || pn == 6) {
                        const int cc = col0 - ZC_PU; float* dst = nullptr;
                        if (!samp) { if (t >= SEQ - 15) dst = out + O_PP + ((size_t)((layer * 4 + b) * 15 + (t - (SEQ - 15))) * 512 + cc); }
                        else { if (t >= ST - 15) dst = out + O_PS + ((size_t)((layer * 8 + b) * 15 + (t - (ST - 15))) * 512 + cc); }
                        if (dst) { *(f32x4*)dst = v0; *(f32x4*)(dst + 4) = v1; }
                    }
                    if (pn >= 11) {
#pragma unroll
                        for (int j = 0; j < 4; ++j) { v0[j] = sigmoidf_(v0[j]); v1[j] = sigmoidf_(v1[j]); }
                    } else if (pn >= 7) {
#pragma unroll
                        for (int j = 0; j < 4; ++j) { v0[j] = gelu_tanh(v0[j]); v1[j] = gelu_tanh(v1[j]); }
                    }
                    u32x4 w; w.x = pk2(v0[0], v0[1]); w.y = pk2(v0[2], v0[3]); w.z = pk2(v1[0], v1[1]); w.w = pk2(v1[2], v1[3]);
                    *(u32x4*)(Z + (size_t)row * NIN + col0) = w;
                }
            }
    }
};
struct EpiMerge {
    static constexpr bool PERM = true;
    const bf16_t* Z; bf16_t* MG;
    __device__ __forceinline__ void operator()(const f32x4 (&acc)[2][2][4][2], const pg8::Unit& u, int wr, int wc, int fr, int fq) const {
        const int mode = u.mode;
#pragma unroll
        for (int ai = 0; ai < 2; ++ai)
#pragma unroll
            for (int m = 0; m < 4; ++m) {
                const int row = u.pm * 256 + ai * 128 + wr * 64 + m * 16 + fr;
#pragma unroll
                for (int bj = 0; bj < 2; ++bj) {
                    const int col0 = u.pn * 256 + bj * 128 + wc * 32 + 8 * fq;
                    const u32x4 g = *(const u32x4*)(Z + (size_t)row * NIN + ZC_G + mode * 1024 + col0);
                    f32x4 v0 = acc[ai][bj][m][0], v1 = acc[ai][bj][m][1];
                    v0[0] *= bflo(g.x); v0[1] *= bfhi(g.x); v0[2] *= bflo(g.y); v0[3] *= bfhi(g.y);
                    v1[0] *= bflo(g.z); v1[1] *= bfhi(g.z); v1[2] *= bflo(g.w); v1[3] *= bfhi(g.w);
                    bf16_t* mp = MG + (size_t)row * D + col0;
                    if (mode != 0) { const u32x4 o = *(const u32x4*)mp;
                        v0[0] += bflo(o.x); v0[1] += bfhi(o.x); v0[2] += bflo(o.y); v0[3] += bfhi(o.y);
                        v1[0] += bflo(o.z); v1[1] += bfhi(o.z); v1[2] += bflo(o.w); v1[3] += bfhi(o.w); }
                    u32x4 w; w.x = pk2(v0[0], v0[1]); w.y = pk2(v0[2], v0[3]); w.z = pk2(v1[0], v1[1]); w.w = pk2(v1[2], v1[3]);
                    *(u32x4*)mp = w;
                }
            }
    }
};
struct EpiRes {
    static constexpr bool PERM = false;
    const float* srcp; const float* srcs; float* X; const float* gmod;
    __device__ __forceinline__ void operator()(const f32x4 (&acc)[2][2][4][2], const pg8::Unit& u, int wr, int wc, int fr, int fq) const {
#pragma unroll
        for (int ai = 0; ai < 2; ++ai)
#pragma unroll
            for (int m = 0; m < 4; ++m) {
                const int row = u.pm * 256 + ai * 128 + wr * 64 + m * 16 + fr;
                const float* sp = row < MP ? srcp + (size_t)row * D : srcs + (size_t)(row - MP) * D;
                const float* gp = gmod + (size_t)batch_of_row(row) * 6144;
                float* xp = X + (size_t)row * D;
#pragma unroll
                for (int bj = 0; bj < 2; ++bj)
#pragma unroll
                    for (int n = 0; n < 2; ++n) {
                        const int col = u.pn * 256 + bj * 128 + wc * 32 + 16 * n + 4 * fq;
                        const f32x4 s = *(const f32x4*)(sp + col), g = *(const f32x4*)(gp + col);
                        *(f32x4*)(xp + col) = s + g * acc[ai][bj][m][n];
                    }
            }
    }
};
struct EpiUp {
    static constexpr bool PERM = true;
    bf16_t* AB; float* out; int layer;
    __device__ __forceinline__ void operator()(const f32x4 (&acc)[2][2][4][2], const pg8::Unit& u, int wr, int wc, int fr, int fq) const {
#pragma unroll
        for (int ai = 0; ai < 2; ++ai)
#pragma unroll
            for (int m = 0; m < 4; ++m) {
                const int row = u.pm * 256 + ai * 128 + wr * 64 + m * 16 + fr;
                int b, t; const bool samp = row >= MP;
                if (!samp) { b = row >> 13; t = row & 8191; } else { b = (row - MP) >> 5; t = (row - MP) & 31; }
#pragma unroll
                for (int bj = 0; bj < 2; ++bj) {
                    const int col0 = u.pn * 256 + bj * 128 + wc * 32 + 8 * fq;
                    const f32x4 v0 = acc[ai][bj][m][0], v1 = acc[ai][bj][m][1];
                    if (u.pn < 11) {
                        float* dst = nullptr;
                        if (!samp) { if (t >= SEQ - 2) dst = out + O_CP + ((size_t)((layer * 4 + b) * 2 + (t - (SEQ - 2))) * DFF + col0); }
                        else { if (t >= ST - 2) dst = out + O_CS + ((size_t)((layer * 8 + b) * 2 + (t - (ST - 2))) * DFF + col0); }
                        if (dst) { *(f32x4*)dst = v0; *(f32x4*)(dst + 4) = v1; }
                    }
                    u32x4 w; w.x = pk2(v0[0], v0[1]); w.y = pk2(v0[2], v0[3]); w.z = pk2(v1[0], v1[1]); w.w = pk2(v1[2], v1[3]);
                    *(u32x4*)(AB + (size_t)row * NUP + col0) = w;
                }
            }
    }
};

__device__ __forceinline__ void p0_transpose_item(const float* W, int N, bf16_t* WT, size_t ldt, int col_off, LAS float* scr, int item, int lane) {
    const int nblk = N / 32, kb = item / nblk, nb = item % nblk, k0 = 64 * kb, n0 = 32 * nb;
#pragma unroll 8
    for (int i = 0; i < 32; ++i) { const int kk = 2 * i + (lane >> 5); scr[kk * 33 + (lane & 31)] = W[(size_t)(k0 + kk) * N + n0 + (lane & 31)]; }
    asm volatile("s_waitcnt lgkmcnt(0)" ::: "memory");
    const int c = lane & 7;
#pragma unroll
    for (int j = 0; j < 4; ++j) { const int n = (lane >> 3) + 8 * j; const LAS float* s = scr + (8 * c) * 33 + n;
        u32x4 o; o.x = pk2(s[0 * 33], s[1 * 33]); o.y = pk2(s[2 * 33], s[3 * 33]); o.z = pk2(s[4 * 33], s[5 * 33]); o.w = pk2(s[6 * 33], s[7 * 33]);
        *(u32x4*)(WT + (size_t)(n0 + n) * ldt + col_off + k0 + 8 * c) = o; }
    asm volatile("s_waitcnt lgkmcnt(0)" ::: "memory");
}

__device__ __forceinline__ void phase_p0(const Params& P, LAS unsigned char* lds) {
    const int tid = threadIdx.x, lane = tid & 63, wave = tid >> 6;
    const int G = gridDim.x, gw = blockIdx.x * NWAVES + wave, NGW = G * NWAVES;
    LAS float* scr = (LAS float*)(lds + wave * 8704);
    constexpr int I_IN = 16 * (NIN / 32), I_OA = 16 * 32, I_OP = 8 * 32, I_OS = 8 * 32, I_OUT = 16 * 32, I_UP = 16 * (NUP / 32), I_DN = (DFF / 64) * 32, I_PW = 4 * 2 * 4;
    constexpr int I_L = I_IN + I_OA + I_OP + I_OS + I_OUT + I_UP + I_DN + I_PW;
    for (int it = gw; it < 2 * I_L; it += NGW) {
        const int l = it / I_L; int r = it - l * I_L;
        unsigned char* wl = P.ws + WS_W + (size_t)l * WL_SIZE;
        if (r < I_IN) { p0_transpose_item(P.w_in + (size_t)l * D * NIN, NIN, (bf16_t*)(wl + WL_IN), D, 0, scr, r, lane); continue; } r -= I_IN;
        if (r < I_OA) { p0_transpose_item(P.w_o_attn + (size_t)l * D * D, D, (bf16_t*)(wl + WL_CAT), 2048, 0, scr, r, lane); continue; } r -= I_OA;
        if (r < I_OP) { p0_transpose_item(P.w_o_pool + (size_t)l * 512 * D, D, (bf16_t*)(wl + WL_CAT), 2048, 1024, scr, r, lane); continue; } r -= I_OP;
        if (r < I_OS) { p0_transpose_item(P.w_o_sgu + (size_t)l * 512 * D, D, (bf16_t*)(wl + WL_CAT), 2048, 1536, scr, r, lane); continue; } r -= I_OS;
        if (r < I_OUT) { p0_transpose_item(P.w_out + (size_t)l * D * D, D, (bf16_t*)(wl + WL_OUT), D, 0, scr, r, lane); continue; } r -= I_OUT;
        if (r < I_UP) { p0_transpose_item(P.ffn_w_up + (size_t)l * D * NUP, NUP, (bf16_t*)(wl + WL_UP), D, 0, scr, r, lane); continue; } r -= I_UP;
        if (r < I_DN) { p0_transpose_item(P.ffn_w_down + (size_t)l * DFF * D, D, (bf16_t*)(wl + WL_DN), DFF, 0, scr, r, lane); continue; } r -= I_DN;
        { const int g = r >> 3, rr = r & 7;
          p0_transpose_item(P.pool_w + ((size_t)l * 4 + g) * 128 * 128, 128, (bf16_t*)(wl + WL_PW) + (size_t)g * 128 * 128, 128, 0, scr, rr, lane); }
    }
    const int gt = blockIdx.x * NTHREADS + tid, NGT = G * NTHREADS;
    for (int e = gt; e < 2 * 4 * 128 * 128; e += NGT) {
        const int l = e >> 16, r = e & 65535, i = (r >> 7) & 127, j = r & 127;
        const float v = ((j >> 6) <= (i >> 6)) ? P.sgu_w[e] : 0.f;
        ((bf16_t*)(P.ws + WS_W + (size_t)l * WL_SIZE + WL_SG))[r] = (bf16_t)f2bf(v);
    }
    for (int e = gt; e < 2 * 8 * 96 * 128; e += NGT) {
        const int lb = e / (96 * 128), r = e - lb * (96 * 128);
        P.out[O_KS + (size_t)lb * 128 * 128 + r] = P.cache_k[(size_t)lb * 128 * 128 + 32 * 128 + r];
        P.out[O_VS + (size_t)lb * 128 * 128 + r] = P.cache_v[(size_t)lb * 128 * 128 + 32 * 128 + r];
    }
    __syncthreads();
    LAS float* part = (LAS float*)lds;
    for (int it = blockIdx.x; it < 2 * 96; it += G) {
        const int l = it / 96, e0 = (it % 96) * 64;
        float acc[12];
#pragma unroll
        for (int b = 0; b < 12; ++b) acc[b] = 0.f;
        const float* wp = P.w_ada + (size_t)l * D * 6144 + e0 + lane;
        for (int d = wave * 128; d < wave * 128 + 128; ++d) {
            const float wv = wp[(size_t)d * 6144];
#pragma unroll
            for (int b = 0; b < 12; ++b) { const float cv = b < 4 ? P.c_prompt[b * D + d] : P.c_sample[(b - 4) * D + d]; acc[b] += cv * sigmoidf_(cv) * wv; }
        }
#pragma unroll
        for (int b = 0; b < 12; ++b) part[(wave * 12 + b) * 64 + lane] = acc[b];
        __syncthreads();
        for (int o = tid; o < 12 * 64; o += NTHREADS) {
            const int b = o >> 6, c = o & 63; float s = P.b_ada[(size_t)l * 6144 + e0 + c];
#pragma unroll
            for (int w = 0; w < 8; ++w) s += part[(w * 12 + b) * 64 + c];
            ((float*)(P.ws + WS_MOD))[((size_t)l * 12 + b) * 6144 + e0 + c] = s;
        }
        __syncthreads();
    }
}

__device__ __forceinline__ void phase_norm(const Params& P, const float* srcp, const float* srcs, const float* g, const float* mod_sh, const float* mod_sc) {
    const int lane = threadIdx.x & 63, wave = threadIdx.x >> 6;
    const int gw = blockIdx.x * NWAVES + wave, NGW = gridDim.x * NWAVES;
    bf16_t* H = (bf16_t*)(P.ws + WS_H);
    for (int row = gw; row < M; row += NGW) {
        const float* xr = row < MP ? srcp + (size_t)row * D : srcs + (size_t)(row - MP) * D;
        const int b = batch_of_row(row);
        f32x4 v[4]; float s = 0.f;
#pragma unroll
        for (int j = 0; j < 4; ++j) { v[j] = *(const f32x4*)(xr + 4 * lane + 256 * j); s += (v[j][0] * v[j][0] + v[j][1] * v[j][1]) + (v[j][2] * v[j][2] + v[j][3] * v[j][3]); }
        const float rstd = rsqrtf(wave_sum(s) * (1.f / D) + 1e-6f);
#pragma unroll
        for (int j = 0; j < 4; ++j) {
            const int c = 4 * lane + 256 * j;
            const f32x4 gg = *(const f32x4*)(g + c), sc = *(const f32x4*)(mod_sc + (size_t)b * 6144 + c), sh = *(const f32x4*)(mod_sh + (size_t)b * 6144 + c);
            f32x4 h = v[j] * rstd * gg * (sc + 1.0f) + sh;
            u32x2 w; w.x = pk2(h[0], h[1]); w.y = pk2(h[2], h[3]);
            *(u32x2*)(H + (size_t)row * D + c) = w;
        }
    }
}
__device__ __forceinline__ void phase_final(const Params& P) {
    const int lane = threadIdx.x & 63, wave = threadIdx.x >> 6;
    const int gw = blockIdx.x * NWAVES + wave, NGW = gridDim.x * NWAVES;
    for (int row = gw; row < M; row += NGW) {
        float* xr = P.out + (size_t)row * D;
        f32x4 v[4]; float s = 0.f;
#pragma unroll
        for (int j = 0; j < 4; ++j) { v[j] = *(const f32x4*)(xr + 4 * lane + 256 * j); s += (v[j][0] * v[j][0] + v[j][1] * v[j][1]) + (v[j][2] * v[j][2] + v[j][3] * v[j][3]); }
        const float rstd = rsqrtf(wave_sum(s) * (1.f / D) + 1e-6f);
#pragma unroll
        for (int j = 0; j < 4; ++j) { const int c = 4 * lane + 256 * j; const f32x4 gg = *(const f32x4*)(P.final_norm_g + c); *(f32x4*)(xr + c) = v[j] * rstd * gg; }
    }
}

constexpr int KS_STRIDE = 144;
constexpr int VT_STRIDE = 400;
constexpr int ATT_KS = 0, ATT_VT = 192 * KS_STRIDE;

__device__ __forceinline__ void attn_item(const Params& P, int layer, int item, LAS unsigned char* lds) {
    const int tid = threadIdx.x, lane = tid & 63, wave = tid >> 6, fr = lane & 15, fq = lane >> 4;
    bf16_t* Z = (bf16_t*)(P.ws + WS_Z);
    const bool samp = item >= 1024;
    int kvh, c = 0, sb = 0, qrow0, klo, khi, nqt;
    if (!samp) { kvh = item & 1; c = (item >> 1) & 127; const int b = item >> 8; qrow0 = b * SEQ + 64 * c; klo = 128 - 64 * (c < 2 ? c : 2); khi = 192; nqt = 4; }
    else { const int s = item - 1024; kvh = s & 1; sb = s >> 1; qrow0 = MP + sb * ST; klo = 0; khi = 160; nqt = 2; }
    __syncthreads();
    {
        const int ch = tid & 7, key0 = tid >> 3;
#pragma unroll
        for (int p = 0; p < 3; ++p) {
            const int j = key0 + 64 * p;
            u32x4 kk = (u32x4){0u, 0u, 0u, 0u}, vv = (u32x4){0u, 0u, 0u, 0u};
            if (j >= klo && j < khi) {
                if (samp && j < 128) {
                    const float* kp = P.cache_k + ((((size_t)layer * 8 + sb) * 128 + j) * 2 + kvh) * 64 + ch * 8;
                    const float* vp = P.cache_v + ((((size_t)layer * 8 + sb) * 128 + j) * 2 + kvh) * 64 + ch * 8;
                    const f32x4 k0 = *(const f32x4*)kp, k1 = *(const f32x4*)(kp + 4), v0 = *(const f32x4*)vp, v1 = *(const f32x4*)(vp + 4);
                    kk.x = pk2(k0[0], k0[1]); kk.y = pk2(k0[2], k0[3]); kk.z = pk2(k1[0], k1[1]); kk.w = pk2(k1[2], k1[3]);
                    vv.x = pk2(v0[0], v0[1]); vv.y = pk2(v0[2], v0[3]); vv.z = pk2(v1[0], v1[1]); vv.w = pk2(v1[2], v1[3]);
                } else {
                    const int row = samp ? (qrow0 + j - 128) : (qrow0 - 128 + j);
                    const bf16_t* zp = Z + (size_t)row * NIN + kvh * 64 + ch * 8;
                    kk = *(const u32x4*)(zp + ZC_K); vv = *(const u32x4*)(zp + ZC_V);
                }
            }
            *(LAS u32x4*)(lds + ATT_KS + j * KS_STRIDE + ch * 16) = kk;
            LAS bf16_t* vt = (LAS bf16_t*)(lds + ATT_VT + (ch * 8) * VT_STRIDE + j * 2);
            vt[0 * (VT_STRIDE / 2)] = (bf16_t)(vv.x & 0xffff); vt[1 * (VT_STRIDE / 2)] = (bf16_t)(vv.x >> 16);
            vt[2 * (VT_STRIDE / 2)] = (bf16_t)(vv.y & 0xffff); vt[3 * (VT_STRIDE / 2)] = (bf16_t)(vv.y >> 16);
            vt[4 * (VT_STRIDE / 2)] = (bf16_t)(vv.z & 0xffff); vt[5 * (VT_STRIDE / 2)] = (bf16_t)(vv.z >> 16);
            vt[6 * (VT_STRIDE / 2)] = (bf16_t)(vv.w & 0xffff); vt[7 * (VT_STRIDE / 2)] = (bf16_t)(vv.w >> 16);
        }
    }
    __syncthreads();
    const int h = kvh * 8 + wave;
    const float slope = exp2f(-0.5f * (float)(h + 1));
    const float sink = P.attn_sink[layer * 16 + h];
#pragma unroll 1
    for (int qt = 0; qt < nqt; ++qt) {
        const int qrow = qrow0 + 16 * qt + fr;
        bf16_t* qp = Z + (size_t)qrow * NIN + h * 64;
        const bf16x8 q0 = *(const bf16x8*)(qp + 8 * fq), q1 = *(const bf16x8*)(qp + 32 + 8 * fq);
        f32x4 st[12];
#pragma unroll
        for (int kt = 0; kt < 12; ++kt) {
            const LAS unsigned char* kp = lds + ATT_KS + (16 * kt + fr) * KS_STRIDE + 16 * fq;
            const bf16x8 a0 = *(const LAS bf16x8*)kp, a1 = *(const LAS bf16x8*)(kp + 64);
            f32x4 a = (f32x4){0.f, 0.f, 0.f, 0.f};
            a = __builtin_amdgcn_mfma_f32_16x16x32_bf16(a0, q0, a, 0, 0, 0);
            a = __builtin_amdgcn_mfma_f32_16x16x32_bf16(a1, q1, a, 0, 0, 0);
            st[kt] = a;
            if ((kt & 3) == 3) asm volatile("" ::: "memory");
        }
        const int ql = 16 * qt + fr;
        float mx = -INFINITY;
#pragma unroll
        for (int kt = 0; kt < 12; ++kt)
#pragma unroll
            for (int jj = 0; jj < 4; ++jj) {
                const int key = 16 * kt + 4 * fq + jj;
                const float dist = fabsf((float)(128 + ql - key));
                float lg = st[kt][jj] * 0.125f - slope * dist;
                lg = (key >= klo && key < khi) ? lg : -INFINITY;
                st[kt][jj] = lg; mx = fmaxf(mx, lg);
            }
        mx = fmaxf(mx, __shfl_xor(mx, 16)); mx = fmaxf(mx, __shfl_xor(mx, 32));
        mx = fmaxf(mx, sink);
        float sum = 0.f;
#pragma unroll
        for (int kt = 0; kt < 12; ++kt)
#pragma unroll
            for (int jj = 0; jj < 4; ++jj) { const float p = __expf(st[kt][jj] - mx); st[kt][jj] = p; sum += p; }
        sum += __shfl_xor(sum, 16); sum += __shfl_xor(sum, 32);
        const float inv = 1.0f / (sum + __expf(sink - mx));
        bf16x8 pb[6];
#pragma unroll
        for (int s = 0; s < 6; ++s) {
            u32x4 w; w.x = pk2(st[2 * s][0] * inv, st[2 * s][1] * inv); w.y = pk2(st[2 * s][2] * inv, st[2 * s][3] * inv);
            w.z = pk2(st[2 * s + 1][0] * inv, st[2 * s + 1][1] * inv); w.w = pk2(st[2 * s + 1][2] * inv, st[2 * s + 1][3] * inv);
            pb[s] = __builtin_bit_cast(bf16x8, w);
        }
#pragma unroll 1
        for (int dt = 0; dt < 4; ++dt) {
            f32x4 o = (f32x4){0.f, 0.f, 0.f, 0.f};
#pragma unroll
            for (int s = 0; s < 6; ++s) {
                const LAS unsigned char* vp = lds + ATT_VT + (16 * dt + fr) * VT_STRIDE + (32 * s + 4 * fq) * 2;
                const u32x2 lo = *(const LAS u32x2*)vp, hi = *(const LAS u32x2*)(vp + 32);
                const u32x4 av = (u32x4){lo.x, lo.y, hi.x, hi.y};
                o = __builtin_amdgcn_mfma_f32_16x16x32_bf16(__builtin_bit_cast(bf16x8, av), pb[s], o, 0, 0, 0);
            }
            u32x2 w; w.x = pk2(o[0], o[1]); w.y = pk2(o[2], o[3]);
            *(u32x2*)(qp + 16 * dt + 4 * fq) = w;
        }
    }
}

constexpr int MX_RS = 0, MX_VNT = 1024, MX_U = 36864, MX_DT = 76800, MX_ST = 272;
__device__ __forceinline__ void mix_item(const Params& P, int layer, int item, LAS unsigned char* lds) {
    const int tid = threadIdx.x, lane = tid & 63, wave = tid >> 6, fr = lane & 15, fq = lane >> 4;
    bf16_t* Z = (bf16_t*)(P.ws + WS_Z);
    const unsigned char* wl = P.ws + WS_W + (size_t)layer * WL_SIZE;
    const bool samp = item >= 256;
    int row0, L, t0, sb = 0;
    if (!samp) { const int b = item >> 6, ch = item & 63; row0 = b * SEQ + ch * 128; L = 128; t0 = ch * 128; }
    else { sb = item - 256; row0 = MP + sb * ST; L = ST; t0 = 0; }
    LAS float* RS = (LAS float*)(lds + MX_RS);
    __syncthreads();
    for (int k = 0; k < 16; ++k) {
        const int i = wave * 16 + k;
        if (i < L) {
            const u32x4 w = *(const u32x4*)(Z + (size_t)(row0 + i) * NIN + ZC_SV + lane * 8);
            float s = bflo(w.x) * bflo(w.x) + bfhi(w.x) * bfhi(w.x) + bflo(w.y) * bflo(w.y) + bfhi(w.y) * bfhi(w.y)
                    + bflo(w.z) * bflo(w.z) + bfhi(w.z) * bfhi(w.z) + bflo(w.w) * bflo(w.w) + bfhi(w.w) * bfhi(w.w);
            s = wave_sum(s);
            if (lane == 0) RS[i] = rsqrtf(s * (1.f / 512.f) + 1e-6f);
        }
    }
    __syncthreads();
    for (int g = 0; g < 4; ++g) {
#pragma unroll
        for (int p = 0; p < 4; ++p) {
            const int idx = tid + NTHREADS * p, j = idx >> 4, c8 = idx & 15;
            float vn[8];
            if (j < L) {
                const u32x4 w = *(const u32x4*)(Z + (size_t)(row0 + j) * NIN + ZC_SV + g * 128 + c8 * 8);
                const float rs = RS[j]; const float* ng = P.sgu_norm_g + layer * 512 + g * 128 + c8 * 8;
                vn[0] = bflo(w.x) * rs * ng[0]; vn[1] = bfhi(w.x) * rs * ng[1]; vn[2] = bflo(w.y) * rs * ng[2]; vn[3] = bfhi(w.y) * rs * ng[3];
                vn[4] = bflo(w.z) * rs * ng[4]; vn[5] = bfhi(w.z) * rs * ng[5]; vn[6] = bflo(w.w) * rs * ng[6]; vn[7] = bfhi(w.w) * rs * ng[7];
                if (samp) { float* dst = P.out + O_SV + ((size_t)((layer * 8 + sb) * ST + j)) * 512 + g * 128 + c8 * 8;
                    *(f32x4*)dst = (f32x4){vn[0], vn[1], vn[2], vn[3]}; *(f32x4*)(dst + 4) = (f32x4){vn[4], vn[5], vn[6], vn[7]}; }
            } else {
#pragma unroll
                for (int e = 0; e < 8; ++e) vn[e] = 0.f;
            }
            LAS bf16_t* vt = (LAS bf16_t*)(lds + MX_VNT + (c8 * 8) * MX_ST + j * 2);
#pragma unroll
            for (int e = 0; e < 8; ++e) vt[e * (MX_ST / 2)] = (bf16_t)f2bf(vn[e]);
        }
        __syncthreads();
        if (wave * 16 < L) {
            const int i = wave * 16 + fr;
            const bf16_t* wrow = (const bf16_t*)(wl + WL_SG) + ((size_t)g * 128 + i) * 128 + 8 * fq;
            bf16x8 wf[4];
#pragma unroll
            for (int ks = 0; ks < 4; ++ks) wf[ks] = *(const bf16x8*)(wrow + 32 * ks);
            const float bias = P.sgu_b[(layer * 4 + g) * 128 + i];
            bf16_t* zrow = Z + (size_t)(row0 + i) * NIN + ZC_SU + g * 128 + 4 * fq;
#pragma unroll
            for (int ct = 0; ct < 8; ++ct) {
                f32x4 a = (f32x4){0.f, 0.f, 0.f, 0.f};
#pragma unroll
                for (int ks = 0; ks < 4; ++ks) {
                    const bf16x8 av = *(const LAS bf16x8*)(lds + MX_VNT + (16 * ct + fr) * MX_ST + (32 * ks + 8 * fq) * 2);
                    a = __builtin_amdgcn_mfma_f32_16x16x32_bf16(av, wf[ks], a, 0, 0, 0);
                }
                const u32x2 uu = *(const u32x2*)(zrow + 16 * ct);
                u32x2 w; w.x = pk2(bflo(uu.x) * (a[0] + bias), bfhi(uu.x) * (a[1] + bias)); w.y = pk2(bflo(uu.y) * (a[2] + bias), bfhi(uu.y) * (a[3] + bias));
                *(u32x2*)(zrow + 16 * ct) = w;
            }
        }
        __syncthreads();
    }
    for (int g = 0; g < 4; ++g) {
        const int wlen = 2 << g;
        for (int idx = tid; idx < (15 + L) * 16; idx += NTHREADS) {
            const int hh = idx >> 4, c8 = idx & 15, rel = hh - 15;
            u32x4 w = (u32x4){0u, 0u, 0u, 0u};
            if (rel >= 0 || (!samp && t0 > 0)) w = *(const u32x4*)(Z + (size_t)(row0 + rel) * NIN + ZC_PU + g * 128 + c8 * 8);
            else if (samp) {
                const float* sp = P.state_pool + ((size_t)(layer * 8 + sb) * 15 + hh) * 512 + g * 128 + c8 * 8;
                const f32x4 a = *(const f32x4*)sp, b = *(const f32x4*)(sp + 4);
                w.x = pk2(a[0], a[1]); w.y = pk2(a[2], a[3]); w.z = pk2(b[0], b[1]); w.w = pk2(b[2], b[3]);
            }
            *(LAS u32x4*)(lds + MX_U + hh * MX_ST + c8 * 16) = w;
        }
        __syncthreads();
        for (int idx = tid; idx < L * 16; idx += NTHREADS) {
            const int i = idx >> 4, c8 = idx & 15;
            float s[8];
#pragma unroll
            for (int e = 0; e < 8; ++e) s[e] = 0.f;
            for (int k = 0; k < wlen; ++k) {
                const u32x4 w = *(const LAS u32x4*)(lds + MX_U + (15 + i - k) * MX_ST + c8 * 16);
                s[0] += bflo(w.x); s[1] += bfhi(w.x); s[2] += bflo(w.y); s[3] += bfhi(w.y); s[4] += bflo(w.z); s[5] += bfhi(w.z); s[6] += bflo(w.w); s[7] += bfhi(w.w);
            }
            const u32x4 w = *(const LAS u32x4*)(lds + MX_U + (15 + i) * MX_ST + c8 * 16);
            const int pos1 = samp ? (1024 + i + 1) : (t0 + i + 1);
            const float rc = 1.0f / (float)(pos1 < wlen ? pos1 : wlen);
            u32x4 o;
            o.x = pk2(s[0] * rc - bflo(w.x), s[1] * rc - bfhi(w.x)); o.y = pk2(s[2] * rc - bflo(w.y), s[3] * rc - bfhi(w.y));
            o.z = pk2(s[4] * rc - bflo(w.z), s[5] * rc - bfhi(w.z)); o.w = pk2(s[6] * rc - bflo(w.w), s[7] * rc - bfhi(w.w));
            *(LAS u32x4*)(lds + MX_DT + i * MX_ST + c8 * 16) = o;
        }
        __syncthreads();
        if (wave * 16 < L) {
            const int i = wave * 16 + fr;
            bf16x8 df[4];
#pragma unroll
            for (int ks = 0; ks < 4; ++ks) df[ks] = *(const LAS bf16x8*)(lds + MX_DT + i * MX_ST + (32 * ks + 8 * fq) * 2);
            const bf16_t* pw = (const bf16_t*)(wl + WL_PW) + (size_t)g * 128 * 128;
            bf16_t* zrow = Z + (size_t)(row0 + i) * NIN + ZC_SV + g * 128 + 4 * fq;
            const float* psc = P.pool_scale + layer * 512 + g * 128 + 4 * fq;
#pragma unroll
            for (int nt = 0; nt < 8; ++nt) {
                f32x4 a = (f32x4){0.f, 0.f, 0.f, 0.f};
#pragma unroll
                for (int ks = 0; ks < 4; ++ks) {
                    const bf16x8 wv = *(const bf16x8*)(pw + (size_t)(16 * nt + fr) * 128 + 32 * ks + 8 * fq);
                    a = __builtin_amdgcn_mfma_f32_16x16x32_bf16(wv, df[ks], a, 0, 0, 0);
                }
                const f32x4 sc = *(const f32x4*)(psc + 16 * nt);
                u32x2 w; w.x = pk2(a[0] * sc[0], a[1] * sc[1]); w.y = pk2(a[2] * sc[2], a[3] * sc[3]);
                *(u32x2*)(zrow + 16 * nt) = w;
            }
        }
        __syncthreads();
    }
}

__device__ __forceinline__ void phase_mixers(const Params& P, int layer, LAS unsigned char* lds) {
    constexpr int N_ATT = 1024 + 16, N_MIX = 256 + 8;
    for (int it = blockIdx.x; it < N_ATT + N_MIX; it += gridDim.x) {
        if (it < N_ATT) attn_item(P, layer, it, lds);
        else mix_item(P, layer, it - N_ATT, lds);
    }
}

__device__ __forceinline__ void phase_conv(const Params& P, int layer) {
    bf16_t* AB = (bf16_t*)(P.ws + WS_Z);
    const int gt = blockIdx.x * NTHREADS + threadIdx.x, NGT = gridDim.x * NTHREADS;
    const float* cw = P.ffn_conv_w + (size_t)layer * 3 * DFF; const float* cb = P.ffn_conv_b + (size_t)layer * DFF;
    for (int idx = gt; idx < M * (DFF / 8); idx += NGT) {
        const int r = idx / (DFF / 8), f = (idx - r * (DFF / 8)) * 8;
        int t, sb = 0; const bool samp = r >= MP;
        if (!samp) t = r & 8191; else { t = (r - MP) & 31; sb = (r - MP) >> 5; }
        float a0[8], a1[8], a2[8];
        { const u32x4 w = *(const u32x4*)(AB + (size_t)r * NUP + f);
          a0[0] = bflo(w.x); a0[1] = bfhi(w.x); a0[2] = bflo(w.y); a0[3] = bfhi(w.y); a0[4] = bflo(w.z); a0[5] = bfhi(w.z); a0[6] = bflo(w.w); a0[7] = bfhi(w.w); }
        const float* pf = P.state_conv + ((size_t)(layer * 8 + sb) * 2) * DFF + f;
        if (t >= 1) { const u32x4 w = *(const u32x4*)(AB + (size_t)(r - 1) * NUP + f);
          a1[0] = bflo(w.x); a1[1] = bfhi(w.x); a1[2] = bflo(w.y); a1[3] = bfhi(w.y); a1[4] = bflo(w.z); a1[5] = bfhi(w.z); a1[6] = bflo(w.w); a1[7] = bfhi(w.w); }
        else {
#pragma unroll
            for (int e = 0; e < 8; ++e) a1[e] = samp ? pf[DFF + e] : 0.f; }
        if (t >= 2) { const u32x4 w = *(const u32x4*)(AB + (size_t)(r - 2) * NUP + f);
          a2[0] = bflo(w.x); a2[1] = bfhi(w.x); a2[2] = bflo(w.y); a2[3] = bfhi(w.y); a2[4] = bflo(w.z); a2[5] = bfhi(w.z); a2[6] = bflo(w.w); a2[7] = bfhi(w.w); }
        else {
#pragma unroll
            for (int e = 0; e < 8; ++e) a2[e] = samp ? pf[(t == 1 ? DFF : 0) + e] : 0.f; }
        const u32x4 bw = *(const u32x4*)(AB + (size_t)r * NUP + DFF + f);
        float bb[8] = {bflo(bw.x), bfhi(bw.x), bflo(bw.y), bfhi(bw.y), bflo(bw.z), bfhi(bw.z), bflo(bw.w), bfhi(bw.w)};
        float go[8];
#pragma unroll
        for (int e = 0; e < 8; ++e) {
            const float cv = a2[e] * cw[f + e] + a1[e] * cw[DFF + f + e] + a0[e] * cw[2 * DFF + f + e] + cb[f + e];
            go[e] = gelu_tanh(cv) * bb[e];
        }
        u32x4 o; o.x = pk2(go[0], go[1]); o.y = pk2(go[2], go[3]); o.z = pk2(go[4], go[5]); o.w = pk2(go[6], go[7]);
        *(u32x4*)(AB + (size_t)r * NUP + DFF + f) = o;
    }
}

constexpr int NPHASES = 20;
#define RUN(k) (lo <= (k) && (k) < hi)
#define SYNC(k) do { if ((k) + 1 < hi) grid.sync(); } while (0)
template <int l>
__device__ __forceinline__ void layer_phases(const Params& P, LAS unsigned char* lds, cg::grid_group& grid) {
    const int lo = P.ph_lo, hi = P.ph_hi;
    const int G = gridDim.x, c = blockIdx.x;
    unsigned char* ws = P.ws;
    const float* MOD = (const float*)(ws + WS_MOD);
    bf16_t* H = (bf16_t*)(ws + WS_H);
    bf16_t* Z = (bf16_t*)(ws + WS_Z);
    constexpr int pb = 1 + 9 * l;
    const unsigned char* wl = ws + WS_W + (size_t)l * WL_SIZE;
    const float* modl = MOD + (size_t)l * 12 * 6144;
    const float* srcp = l == 0 ? P.x_prompt : P.out + O_YP;
    const float* srcs = l == 0 ? P.x_sample : P.out + O_YS;
    if (RUN(pb + 0)) { phase_norm(P, srcp, srcs, P.norm1_g + l * D, modl + 0 * D, modl + 1 * D); SYNC(pb + 0); }
    if (RUN(pb + 1)) {
        pg8::SimpleOrder S{(const char*)H, (const char*)(wl + WL_IN), (size_t)D * 2, (size_t)D * 2, M / 256, NIN / 256, D / 64, G, c};
        EpiZ E{Z, P.out, l};
        pg8::gemm_phase<EpiZ, pg8::SimpleOrder>(lds, (size_t)D * 2, (size_t)D * 2, S, E);
        SYNC(pb + 1);
    }
    if (RUN(pb + 2)) { phase_mixers(P, l, lds); SYNC(pb + 2); }
    if (RUN(pb + 3)) {
        pg8::MergeOrder S{(const char*)Z, (const char*)(wl + WL_CAT), (size_t)NIN * 2, (size_t)2048 * 2, M / 256, D / 256, G, c};
        EpiMerge E{Z, H};
        pg8::gemm_phase<EpiMerge, pg8::MergeOrder>(lds, (size_t)NIN * 2, (size_t)2048 * 2, S, E);
        SYNC(pb + 3);
    }
    if (RUN(pb + 4)) {
        pg8::SimpleOrder S{(const char*)H, (const char*)(wl + WL_OUT), (size_t)D * 2, (size_t)D * 2, M / 256, D / 256, D / 64, G, c};
        EpiRes E{srcp, srcs, P.out, modl + 2 * D};
        pg8::gemm_phase<EpiRes, pg8::SimpleOrder>(lds, (size_t)D * 2, (size_t)D * 2, S, E);
        SYNC(pb + 4);
    }
    if (RUN(pb + 5)) { phase_norm(P, P.out + O_YP, P.out + O_YS, P.norm2_g + l * D, modl + 3 * D, modl + 4 * D); SYNC(pb + 5); }
    if (RUN(pb + 6)) {
        pg8::SimpleOrder S{(const char*)H, (const char*)(wl + WL_UP), (size_t)D * 2, (size_t)D * 2, M / 256, NUP / 256, D / 64, G, c};
        EpiUp E{Z, P.out, l};
        pg8::gemm_phase<EpiUp, pg8::SimpleOrder>(lds, (size_t)D * 2, (size_t)D * 2, S, E);
        SYNC(pb + 6);
    }
    if (RUN(pb + 7)) { phase_conv(P, l); SYNC(pb + 7); }
    if (RUN(pb + 8)) {
        pg8::SimpleOrder S{(const char*)(Z + DFF), (const char*)(wl + WL_DN), (size_t)NUP * 2, (size_t)DFF * 2, M / 256, D / 256, DFF / 64, G, c};
        EpiRes E{P.out + O_YP, P.out + O_YS, P.out, modl + 5 * D};
        pg8::gemm_phase<EpiRes, pg8::SimpleOrder>(lds, (size_t)NUP * 2, (size_t)DFF * 2, S, E);
        SYNC(pb + 8);
    }
}
__global__ void __launch_bounds__(NTHREADS) mk_fwd(Params P) {
    extern __shared__ __attribute__((aligned(16))) unsigned char lds_raw[];
    LAS unsigned char* lds = (LAS unsigned char*)lds_raw;
    cg::grid_group grid = cg::this_grid();
    const int lo = P.ph_lo, hi = P.ph_hi;
    if (RUN(0)) { phase_p0(P, lds); SYNC(0); }
    layer_phases<0>(P, lds, grid);
    layer_phases<1>(P, lds, grid);
    if (RUN(19)) phase_final(P);
}
#undef RUN
#undef SYNC

extern "C" void kernel_launch(void* const* d_in, const int* in_sizes, int n_in, void* d_out, int out_size, void* d_ws, size_t ws_size, hipStream_t stream) {
    static int grid = 0;
    if (grid == 0) {
        if (n_in != 28 || ws_size < WS_END) { fprintf(stderr, "kernel_launch: need 28 inputs and %zu B of workspace (got %d, %zu)\n", (size_t)WS_END, n_in, ws_size); grid = -1; return; }
        int dev = 0, cus = 0, per_cu = 0;
        hipGetDevice(&dev);
        hipDeviceGetAttribute(&cus, hipDeviceAttributeMultiprocessorCount, dev);
        if (hipFuncSetAttribute((const void*)mk_fwd, hipFuncAttributeMaxDynamicSharedMemorySize, LDS_BYTES) != hipSuccess) { fprintf(stderr, "kernel_launch: hipFuncSetAttribute failed\n"); grid = -1; return; }
        if (hipOccupancyMaxActiveBlocksPerMultiprocessor(&per_cu, (const void*)mk_fwd, NTHREADS, LDS_BYTES) != hipSuccess || per_cu < 1) { fprintf(stderr, "kernel_launch: occupancy query failed (%d)\n", per_cu); per_cu = 1; }
        (void)hipGetLastError();
        grid = cus * per_cu;
    }
    if (grid < 0) return;
    Params p{};
    const float** ip = (const float**)&p;
    for (int i = 0; i < 28; ++i) ip[i] = (const float*)d_in[i];
    p.out = (float*)d_out; p.ws = (unsigned char*)d_ws;
#if MULTI_LAUNCH
    for (int ph = 0; ph < NPHASES; ++ph) {
        p.ph_lo = ph; p.ph_hi = ph + 1;
        hipLaunchKernelGGL(mk_fwd, dim3(grid), dim3(NTHREADS), LDS_BYTES, stream, p);
    }
#else
    p.ph_lo = 0; p.ph_hi = NPHASES;
    void* args[] = {&p};
    hipError_t e = hipLaunchCooperativeKernel((const void*)mk_fwd, dim3(grid), dim3(NTHREADS), args, LDS_BYTES, stream);
    if (e != hipSuccess) fprintf(stderr, "cooperative launch failed: %s (grid %d)\n", hipGetErrorString(e), grid);
#endif
}
```

```cpp
#include <hip/hip_runtime.h>
#include <hip/hip_cooperative_groups.h>
#include <cstdio>
namespace cg = cooperative_groups;

#ifndef MULTI_LAUNCH
#define MULTI_LAUNCH 0
#endif

#ifndef PROBE
#define PROBE 0
#endif
#define LAS __attribute__((address_space(3)))
typedef unsigned short bf16_t;
typedef short bf16x8 __attribute__((ext_vector_type(8)));
typedef float f32x4 __attribute__((ext_vector_type(4)));
typedef unsigned u32x4 __attribute__((ext_vector_type(4)));
typedef unsigned u32x2 __attribute__((ext_vector_type(2)));

constexpr int D = 1024, SEQ = 8192, NBP = 4, NBS = 8, ST = 32;
constexpr int MP = NBP * SEQ;
constexpr int MS = NBS * ST;
constexpr int M = MP + MS;
constexpr int NIN = 5888, DFF = 2816, NUP = 5632;
constexpr int NTHREADS = 512, NWAVES = 8;
constexpr int ZC_Q = 0, ZC_K = 1024, ZC_V = 1152, ZC_PU = 1280, ZC_SU = 1792, ZC_SV = 2304, ZC_G = 2816;
constexpr size_t O_YP = 0;
constexpr size_t O_YS = O_YP + (size_t)MP * D;
constexpr size_t O_KP = O_YS + (size_t)MS * D;
constexpr size_t O_VP = O_KP + 2 * 4 * 128 * 128;
constexpr size_t O_PP = O_VP + 2 * 4 * 128 * 128;
constexpr size_t O_CP = O_PP + 2 * 4 * 15 * 512;
constexpr size_t O_KS = O_CP + 2 * 4 * 2 * DFF;
constexpr size_t O_VS = O_KS + 2 * 8 * 128 * 128;
constexpr size_t O_PS = O_VS + 2 * 8 * 128 * 128;
constexpr size_t O_CS = O_PS + 2 * 8 * 15 * 512;
constexpr size_t O_SV = O_CS + 2 * 8 * 2 * DFF;
constexpr size_t WS_MOD = 4096;
constexpr size_t WS_W = 1048576;
constexpr size_t WL_IN = 0;
constexpr size_t WL_CAT = WL_IN + (size_t)NIN * D * 2;
constexpr size_t WL_OUT = WL_CAT + (size_t)D * 2048 * 2;
constexpr size_t WL_UP = WL_OUT + (size_t)D * D * 2;
constexpr size_t WL_DN = WL_UP + (size_t)NUP * D * 2;
constexpr size_t WL_PW = WL_DN + (size_t)D * DFF * 2;
constexpr size_t WL_SG = WL_PW + 4 * 128 * 128 * 2;
constexpr size_t WL_SIZE = WL_SG + 4 * 128 * 128 * 2;
constexpr size_t WS_H = WS_W + 2 * WL_SIZE;
constexpr size_t WS_Z = WS_H + (size_t)M * D * 2;
constexpr size_t WS_END = WS_Z + (size_t)M * NIN * 2;
constexpr int LDS_BYTES = 131072 + 8192;

struct Params {
    const float *x_prompt, *x_sample, *c_prompt, *c_sample, *cache_k, *cache_v, *state_pool, *state_conv;
    const float *norm1_g, *norm2_g, *w_ada, *b_ada, *w_in, *attn_sink, *w_o_attn, *pool_w, *pool_scale, *w_o_pool;
    const float *sgu_norm_g, *sgu_w, *sgu_b, *w_o_sgu, *w_out, *ffn_w_up, *ffn_conv_w, *ffn_conv_b, *ffn_w_down, *final_norm_g;
    float* out; unsigned char* ws;
    int ph_lo, ph_hi;
};

typedef __bf16 bf16x2_t __attribute__((ext_vector_type(2)));
typedef float f32x2_t __attribute__((ext_vector_type(2)));
__device__ __forceinline__ unsigned pk2(float lo, float hi) { const f32x2_t v = {lo, hi}; return __builtin_bit_cast(unsigned, __builtin_convertvector(v, bf16x2_t)); }
__device__ __forceinline__ unsigned f2bf(float f) { return pk2(f, 0.f) & 0xffffu; }
__device__ __forceinline__ float bflo(unsigned w) { return __builtin_bit_cast(float, w << 16); }
__device__ __forceinline__ float bfhi(unsigned w) { return __builtin_bit_cast(float, w & 0xffff0000u); }
__device__ __forceinline__ float bf1(bf16_t h) { return __builtin_bit_cast(float, ((unsigned)h) << 16); }
__device__ __forceinline__ float sigmoidf_(float x) { return __builtin_amdgcn_rcpf(1.0f + __builtin_amdgcn_exp2f(-1.4426950408889634f * x)); }
__device__ __forceinline__ float gelu_tanh(float x) { const float e = __builtin_amdgcn_exp2f(x * (-2.3022081985f - 0.1029432347f * x * x)); return x * __builtin_amdgcn_rcpf(1.0f + e); }
__device__ __forceinline__ float wave_sum(float v) {
#pragma unroll
    for (int o = 1; o < 64; o <<= 1) v += __shfl_xor(v, o);
    return v;
}
__device__ __forceinline__ int batch_of_row(int row) { return row < MP ? (row >> 13) : 4 + ((row - MP) >> 5); }

namespace pg8 {
constexpr int BM = 256, BK = 64, HALF = 128, HTB = HALF * BK * 2, NXCD = 8, WGM = 8;
__device__ __forceinline__ int lds_byte(int r, int c) { const int st = (r >> 4) * 2 + (c >> 5), rr = r & 15, cc = c & 31, ob = rr * 64 + cc * 2; return st * 1024 + (ob ^ (((ob >> 9) & 1) << 5)); }
__device__ __forceinline__ void stage_rc(int b, int& R, int& C) { const int st = b / 1024, sb = b % 1024, swz = sb ^ (((sb >> 9) & 1) << 5); R = (st >> 1) * 16 + swz / 64; C = (st & 1) * 32 + (swz % 64) / 2; }
__device__ __forceinline__ int perm32(int rho) { const int n = rho >> 4, i = rho & 15; return 8 * (i >> 2) + 4 * n + (i & 3); }

struct Unit { const char* A; const char* B; int nt, pm, pn, mode; };

__device__ __forceinline__ void tile_of(int wgid, int nM, int nN, int& pm, int& pn) {
    const int nwg = nM * nN;
    { const int q = nwg / NXCD, r = nwg % NXCD, xcd = wgid % NXCD, off = wgid / NXCD; wgid = (xcd < r ? xcd * (q + 1) : r * (q + 1) + (xcd - r) * q) + off; }
    const int nig = WGM * nN, gid = wgid / nig, fm = gid * WGM, gsz = (nM - fm) < WGM ? (nM - fm) : WGM;
    pm = fm + ((wgid % nig) % gsz); pn = (wgid % nig) / gsz;
}

struct SimpleOrder {
    const char* A; const char* B; size_t lda, ldb; int nM, nN, nt, G, c;
    __device__ __forceinline__ bool next(int i, Unit& u) const {
        const long L = (long)i * G + c; if (L >= (long)nM * nN) return false;
        int pm, pn; tile_of((int)L, nM, nN, pm, pn);
        u.pm = pm; u.pn = pn; u.nt = nt; u.mode = 0; u.A = A + (size_t)pm * 256 * lda; u.B = B + (size_t)pn * 256 * ldb; return true;
    }
};
struct MergeOrder {
    const char* A; const char* B; size_t lda, ldb; int nM, nN, G, c;
    __device__ __forceinline__ bool next(int i, Unit& u) const {
        const int ti = i / 3, br = i - ti * 3;
        const long L = (long)ti * G + c; if (L >= (long)nM * nN) return false;
        int pm, pn; tile_of((int)L, nM, nN, pm, pn);
        u.pm = pm; u.pn = pn; u.mode = br;
        const int ak = br == 0 ? ZC_Q : (br == 1 ? ZC_SV : ZC_SU);
        const int bk = br == 0 ? 0 : (br == 1 ? 1024 : 1536);
        u.nt = br == 0 ? 16 : 8;
        u.A = A + (size_t)pm * 256 * lda + (size_t)ak * 2; u.B = B + (size_t)pn * 256 * ldb + (size_t)bk * 2; return true;
    }
};

template <class Epi, class Sched>
__device__ __forceinline__ void gemm_phase(LAS unsigned char* lds, const size_t lda, const size_t ldb, const Sched& S, const Epi& E) {
    int tid_ = threadIdx.x; asm volatile("" : "+v"(tid_));
    const int tid = tid_, wid = __builtin_amdgcn_readfirstlane(tid >> 6), lane = tid & 63, wr = wid >> 2, wc = wid & 3, fr = lane & 15, fq = lane >> 4;
    unsigned voffA[2], voffB[2];
#pragma unroll
    for (int i = 0; i < 2; ++i) { int R, C; stage_rc(tid * 16 + i * 8192, R, C); const int Rb = Epi::PERM ? ((R & ~31) + perm32(R & 31)) : R;
        voffA[i] = (unsigned)(R * lda + C * 2); voffB[i] = (unsigned)(Rb * ldb + C * 2); }
    const size_t kstep = (size_t)(BK * 2);
    const size_t hstepA = (size_t)HALF * lda, hstepB = (size_t)HALF * ldb;
    const unsigned ldsw = (unsigned)wid * 1024u;
    const int aoff = lds_byte(wr * 64 + fr, fq * 8), boff = lds_byte(wc * 32 + fr, fq * 8);
#define PG8_SA(b, h) (((b) * 2 + (h)) * HTB)
#define PG8_SB(b, h) ((4 + (b) * 2 + (h)) * HTB)
#define PG8_STAGE(bufoff, gbase, voff) do { _Pragma("unroll") for (int _i = 0; _i < 2; ++_i) \
        __builtin_amdgcn_global_load_lds((const unsigned*)((const char*)(gbase) + (voff)[_i]), (LAS unsigned*)(lds + (bufoff) + ldsw + _i * 8192), 16, 0, 0); } while (0)
#define PG8_LDA(dst, b, h) do { _Pragma("unroll") for (int m = 0; m < 4; ++m) _Pragma("unroll") for (int k = 0; k < 2; ++k) dst[m][k] = *(const LAS bf16x8*)(lds + PG8_SA(b, h) + aoff + m * 2048 + k * 1024); } while (0)
#define PG8_LDB(dst, b, h) do { _Pragma("unroll") for (int n = 0; n < 2; ++n) _Pragma("unroll") for (int k = 0; k < 2; ++k) dst[n][k] = *(const LAS bf16x8*)(lds + PG8_SB(b, h) + boff + n * 2048 + k * 1024); } while (0)
#define PG8_MMA(ai, bj, At, Bt) do { __builtin_amdgcn_s_setprio(1); _Pragma("unroll") for (int m = 0; m < 4; ++m) _Pragma("unroll") for (int n = 0; n < 2; ++n) _Pragma("unroll") for (int k = 0; k < 2; ++k) \
        acc[ai][bj][m][n] = __builtin_amdgcn_mfma_f32_16x16x32_bf16(Bt[n][k], At[m][k], acc[ai][bj][m][n], 0, 0, 0); __builtin_amdgcn_s_setprio(0); } while (0)
#define PG8_WAIT_V(n) asm volatile("s_waitcnt vmcnt(" #n ")" ::: "memory")
#define PG8_WAIT_L(n) asm volatile("s_waitcnt lgkmcnt(" #n ")" ::: "memory")
#define PG8_BAR __builtin_amdgcn_s_barrier()
#define PG8_SCHED __builtin_amdgcn_sched_barrier(0)
    Unit cur, nxt; int ui = 0;
    if (!S.next(0, cur)) return;
    f32x4 acc[2][2][4][2];
#pragma unroll
    for (int a = 0; a < 2; ++a)
#pragma unroll
        for (int b = 0; b < 2; ++b)
#pragma unroll
            for (int m = 0; m < 4; ++m)
#pragma unroll
                for (int n = 0; n < 2; ++n) acc[a][b][m][n] = (f32x4){0.f, 0.f, 0.f, 0.f};
    bf16x8 At[4][2], B0[2][2], B1[2][2];
    const char* cA = cur.A; const char* cB = cur.B;
    PG8_STAGE(PG8_SB(0, 0), cB, voffB); PG8_STAGE(PG8_SA(0, 0), cA, voffA); PG8_STAGE(PG8_SB(0, 1), cB + hstepB, voffB); PG8_STAGE(PG8_SA(0, 1), cA + hstepA, voffA);
    if (wr == 1) PG8_BAR;
    PG8_WAIT_V(4); PG8_BAR;
    PG8_STAGE(PG8_SB(1, 0), cB + kstep, voffB); PG8_STAGE(PG8_SA(1, 0), cA + kstep, voffA); PG8_STAGE(PG8_SB(1, 1), cB + hstepB + kstep, voffB);
    PG8_WAIT_V(6); PG8_BAR;
    for (;;) {
        const bool has_next = S.next(ui + 1, nxt);
        const char* nA = has_next ? nxt.A : cA; const char* nB = has_next ? nxt.B : cB;
        const int nt = cur.nt;
        for (int t = 0; t < nt; t += 2) {
            const bool last = (t == nt - 2);
            const char* a1 = cA + (size_t)(t + 1) * kstep;
            const char* a2 = last ? nA : cA + (size_t)(t + 2) * kstep; const char* b2 = last ? nB : cB + (size_t)(t + 2) * kstep;
            const char* a3 = a2 + kstep; const char* b3 = b2 + kstep;
            PG8_LDB(B0, 0, 0); PG8_SCHED; PG8_LDA(At, 0, 0); PG8_STAGE(PG8_SA(1, 1), a1 + hstepA, voffA);
            PG8_WAIT_L(8); PG8_BAR; PG8_WAIT_L(0); PG8_MMA(0, 0, At, B0); PG8_BAR; PG8_SCHED;
            PG8_LDB(B1, 0, 1); PG8_STAGE(PG8_SB(0, 0), b2, voffB);
            PG8_BAR; PG8_WAIT_L(0); PG8_MMA(0, 1, At, B1); PG8_BAR;
            PG8_LDA(At, 0, 1); PG8_STAGE(PG8_SA(0, 0), a2, voffA);
            PG8_BAR; PG8_WAIT_L(0); PG8_MMA(1, 0, At, B0); PG8_BAR; PG8_SCHED;
            PG8_STAGE(PG8_SB(0, 1), b2 + hstepB, voffB);
            PG8_WAIT_V(6); PG8_BAR; PG8_MMA(1, 1, At, B1); PG8_BAR;
            PG8_LDB(B0, 1, 0); PG8_SCHED; PG8_LDA(At, 1, 0); PG8_STAGE(PG8_SA(0, 1), a2 + hstepA, voffA);
            PG8_WAIT_L(8); PG8_BAR; PG8_WAIT_L(0); PG8_MMA(0, 0, At, B0); PG8_BAR; PG8_SCHED;
            PG8_LDB(B1, 1, 1); PG8_STAGE(PG8_SB(1, 0), b3, voffB);
            PG8_BAR; PG8_WAIT_L(0); PG8_MMA(0, 1, At, B1); PG8_BAR;
            PG8_LDA(At, 1, 1); PG8_STAGE(PG8_SA(1, 0), a3, voffA);
            PG8_BAR; PG8_WAIT_L(0); PG8_MMA(1, 0, At, B0); PG8_BAR; PG8_SCHED;
            PG8_STAGE(PG8_SB(1, 1), b3 + hstepB, voffB);
            PG8_WAIT_V(6); PG8_BAR; PG8_MMA(1, 1, At, B1); PG8_BAR;
        }
        if (wr == 0) PG8_BAR;
        E(acc, cur, wr, wc, fr, fq);
        if (!has_next) break;
#pragma unroll
        for (int a = 0; a < 2; ++a)
#pragma unroll
            for (int b = 0; b < 2; ++b)
#pragma unroll
                for (int m = 0; m < 4; ++m)
#pragma unroll
                    for (int n = 0; n < 2; ++n) acc[a][b][m][n] = (f32x4){0.f, 0.f, 0.f, 0.f};
        cur = nxt; cA = nA; cB = nB; ++ui;
        if (wr == 1) PG8_BAR;
    }
    PG8_WAIT_V(0);
    PG8_BAR;
#undef PG8_SA
#undef PG8_SB
#undef PG8_STAGE
#undef PG8_LDA
#undef PG8_LDB
#undef PG8_MMA
#undef PG8_WAIT_V
#undef PG8_WAIT_L
#undef PG8_BAR
#undef PG8_SCHED
}
}

struct EpiZ {
    static constexpr bool PERM = true;
    bf16_t* Z; float* out; int layer;
    __device__ __forceinline__ void operator()(const f32x4 (&acc)[2][2][4][2], const pg8::Unit& u, int wr, int wc, int fr, int fq) const {
        const int pn = u.pn;
#pragma unroll
        for (int ai = 0; ai < 2; ++ai)
#pragma unroll
            for (int m = 0; m < 4; ++m) {
                const int row = u.pm * 256 + ai * 128 + wr * 64 + m * 16 + fr;
                int b, t; const bool samp = row >= MP;
                if (!samp) { b = row >> 13; t = row & 8191; } else { b = (row - MP) >> 5; t = (row - MP) & 31; }
#pragma unroll
                for (int bj = 0; bj < 2; ++bj) {
                    const int col0 = pn * 256 + bj * 128 + wc * 32 + 8 * fq;
                    f32x4 v0 = acc[ai][bj][m][0], v1 = acc[ai][bj][m][1];
                    if (pn == 4) {
                        const int cc = col0 - ZC_K; float* dst = nullptr;
                        if (!samp) { if (t >= SEQ - 128) dst = out + (cc < 128 ? O_KP : O_VP) + ((size_t)((layer * 4 + b) * 128 + (t - (SEQ - 128))) * 128 + (cc & 127)); }
                        else dst = out + (cc < 128 ? O_KS : O_VS) + ((size_t)((layer * 8 + b) * 128 + 96 + t) * 128 + (cc & 127));
                        if (dst) { *(f32x4*)dst = v0; *(f32x4*)(dst + 4) = v1; }
                    } else if (pn == 5 || pn == 6) {
                        const int cc = col0 - ZC_PU; float* dst = nullptr;
                        if (!samp) { if (t >= SEQ - 15) dst = out + O_PP + ((size_t)((layer * 4 + b) * 15 + (t - (SEQ - 15))) * 512 + cc); }
                        else { if (t >= ST - 15) dst = out + O_PS + ((size_t)((layer * 8 + b) * 15 + (t - (ST - 15))) * 512 + cc); }
                        if (dst) { *(f32x4*)dst = v0; *(f32x4*)(dst + 4) = v1; }
                    }
                    if (pn >= 11) {
#pragma unroll
                        for (int j = 0; j < 4; ++j) { v0[j] = sigmoidf_(v0[j]); v1[j] = sigmoidf_(v1[j]); }
                    } else if (pn >= 7) {
#pragma unroll
                        for (int j = 0; j < 4; ++j) { v0[j] = gelu_tanh(v0[j]); v1[j] = gelu_tanh(v1[j]); }
                    }
                    u32x4 w; w.x = pk2(v0[0], v0[1]); w.y = pk2(v0[2], v0[3]); w.z = pk2(v1[0], v1[1]); w.w = pk2(v1[2], v1[3]);
                    *(u32x4*)(Z + (size_t)row * NIN + col0) = w;
                }
            }
    }
};
struct EpiMerge {
    static constexpr bool PERM = true;
    const bf16_t* Z; bf16_t* MG;
    __device__ __forceinline__ void operator()(const f32x4 (&acc)[2][2][4][2], const pg8::Unit& u, int wr, int wc, int fr, int fq) const {
        const int mode = u.mode;
#pragma unroll
        for (int ai = 0; ai < 2; ++ai)
#pragma unroll
            for (int m = 0; m < 4; ++m) {
                const int row = u.pm * 256 + ai * 128 + wr * 64 + m * 16 + fr;
#pragma unroll
                for (int bj = 0; bj < 2; ++bj) {
                    const int col0 = u.pn * 256 + bj * 128 + wc * 32 + 8 * fq;
                    const u32x4 g = *(const u32x4*)(Z + (size_t)row * NIN + ZC_G + mode * 1024 + col0);
                    f32x4 v0 = acc[ai][bj][m][0], v1 = acc[ai][bj][m][1];
                    v0[0] *= bflo(g.x); v0[1] *= bfhi(g.x); v0[2] *= bflo(g.y); v0[3] *= bfhi(g.y);
                    v1[0] *= bflo(g.z); v1[1] *= bfhi(g.z); v1[2] *= bflo(g.w); v1[3] *= bfhi(g.w);
                    bf16_t* mp = MG + (size_t)row * D + col0;
                    if (mode != 0) { const u32x4 o = *(const u32x4*)mp;
                        v0[0] += bflo(o.x); v0[1] += bfhi(o.x); v0[2] += bflo(o.y); v0[3] += bfhi(o.y);
                        v1[0] += bflo(o.z); v1[1] += bfhi(o.z); v1[2] += bflo(o.w); v1[3] += bfhi(o.w); }
                    u32x4 w; w.x = pk2(v0[0], v0[1]); w.y = pk2(v0[2], v0[3]); w.z = pk2(v1[0], v1[1]); w.w = pk2(v1[2], v1[3]);
                    *(u32x4*)mp = w;
                }
            }
    }
};
struct EpiRes {
    static constexpr bool PERM = false;
    const float* srcp; const float* srcs; float* X; const float* gmod;
    __device__ __forceinline__ void operator()(const f32x4 (&acc)[2][2][4][2], const pg8::Unit& u, int wr, int wc, int fr, int fq) const {
#pragma unroll
        for (int ai = 0; ai < 2; ++ai)
#pragma unroll
            for (int m = 0; m < 4; ++m) {
                const int row = u.pm * 256 + ai * 128 + wr * 64 + m * 16 + fr;
                const float* sp = row < MP ? srcp + (size_t)row * D : srcs + (size_t)(row - MP) * D;
                const float* gp = gmod + (size_t)batch_of_row(row) * 6144;
                float* xp = X + (size_t)row * D;
#pragma unroll
                for (int bj = 0; bj < 2; ++bj)
#pragma unroll
                    for (int n = 0; n < 2; ++n) {
                        const int col = u.pn * 256 + bj * 128 + wc * 32 + 16 * n + 4 * fq;
                        const f32x4 s = *(const f32x4*)(sp + col), g = *(const f32x4*)(gp + col);
                        *(f32x4*)(xp + col) = s + g * acc[ai][bj][m][n];
                    }
            }
    }
};
struct EpiUp {
    static constexpr bool PERM = true;
    bf16_t* AB; float* out; int layer;
    __device__ __forceinline__ void operator()(const f32x4 (&acc)[2][2][4][2], const pg8::Unit& u, int wr, int wc, int fr, int fq) const {
#pragma unroll
        for (int ai = 0; ai < 2; ++ai)
#pragma unroll
            for (int m = 0; m < 4; ++m) {
                const int row = u.pm * 256 + ai * 128 + wr * 64 + m * 16 + fr;
                int b, t; const bool samp = row >= MP;
                if (!samp) { b = row >> 13; t = row & 8191; } else { b = (row - MP) >> 5; t = (row - MP) & 31; }
#pragma unroll
                for (int bj = 0; bj < 2; ++bj) {
                    const int col0 = u.pn * 256 + bj * 128 + wc * 32 + 8 * fq;
                    const f32x4 v0 = acc[ai][bj][m][0], v1 = acc[ai][bj][m][1];
                    if (u.pn < 11) {
                        float* dst = nullptr;
                        if (!samp) { if (t >= SEQ - 2) dst = out + O_CP + ((size_t)((layer * 4 + b) * 2 + (t - (SEQ - 2))) * DFF + col0); }
                        else { if (t >= ST - 2) dst = out + O_CS + ((size_t)((layer * 8 + b) * 2 + (t - (ST - 2))) * DFF + col0); }
                        if (dst) { *(f32x4*)dst = v0; *(f32x4*)(dst + 4) = v1; }
                    }
                    u32x4 w; w.x = pk2(v0[0], v0[1]); w.y = pk2(v0[2], v0[3]); w.z = pk2(v1[0], v1[1]); w.w = pk2(v1[2], v1[3]);
                    *(u32x4*)(AB + (size_t)row * NUP + col0) = w;
                }
            }
    }
};

__device__ __forceinline__ void p0_transpose_item(const float* W, int N, bf16_t* WT, size_t ldt, int col_off, LAS float* scr, int item, int lane) {
    const int nblk = N / 32, kb = item / nblk, nb = item % nblk, k0 = 64 * kb, n0 = 32 * nb;
#pragma unroll 8
    for (int i = 0; i < 32; ++i) { const int kk = 2 * i + (lane >> 5); scr[kk * 33 + (lane & 31)] = W[(size_t)(k0 + kk) * N + n0 + (lane & 31)]; }
    asm volatile("s_waitcnt lgkmcnt(0)" ::: "memory");
    const int c = lane & 7;
#pragma unroll
    for (int j = 0; j < 4; ++j) { const int n = (lane >> 3) + 8 * j; const LAS float* s = scr + (8 * c) * 33 + n;
        u32x4 o; o.x = pk2(s[0 * 33], s[1 * 33]); o.y = pk2(s[2 * 33], s[3 * 33]); o.z = pk2(s[4 * 33], s[5 * 33]); o.w = pk2(s[6 * 33], s[7 * 33]);
        *(u32x4*)(WT + (size_t)(n0 + n) * ldt + col_off + k0 + 8 * c) = o; }
    asm volatile("s_waitcnt lgkmcnt(0)" ::: "memory");
}

__device__ __forceinline__ void phase_p0(const Params& P, LAS unsigned char* lds) {
    const int tid = threadIdx.x, lane = tid & 63, wave = tid >> 6;
    const int G = gridDim.x, gw = blockIdx.x * NWAVES + wave, NGW = G * NWAVES;
    LAS float* scr = (LAS float*)(lds + wave * 8704);
    constexpr int I_IN = 16 * (NIN / 32), I_OA = 16 * 32, I_OP = 8 * 32, I_OS = 8 * 32, I_OUT = 16 * 32, I_UP = 16 * (NUP / 32), I_DN = (DFF / 64) * 32, I_PW = 4 * 2 * 4;
    constexpr int I_L = I_IN + I_OA + I_OP + I_OS + I_OUT + I_UP + I_DN + I_PW;
    for (int it = gw; it < 2 * I_L; it += NGW) {
        const int l = it / I_L; int r = it - l * I_L;
        unsigned char* wl = P.ws + WS_W + (size_t)l * WL_SIZE;
        if (r < I_IN) { p0_transpose_item(P.w_in + (size_t)l * D * NIN, NIN, (bf16_t*)(wl + WL_IN), D, 0, scr, r, lane); continue; } r -= I_IN;
        if (r < I_OA) { p0_transpose_item(P.w_o_attn + (size_t)l * D * D, D, (bf16_t*)(wl + WL_CAT), 2048, 0, scr, r, lane); continue; } r -= I_OA;
        if (r < I_OP) { p0_transpose_item(P.w_o_pool + (size_t)l * 512 * D, D, (bf16_t*)(wl + WL_CAT), 2048, 1024, scr, r, lane); continue; } r -= I_OP;
        if (r < I_OS) { p0_transpose_item(P.w_o_sgu + (size_t)l * 512 * D, D, (bf16_t*)(wl + WL_CAT), 2048, 1536, scr, r, lane); continue; } r -= I_OS;
        if (r < I_OUT) { p0_transpose_item(P.w_out + (size_t)l * D * D, D, (bf16_t*)(wl + WL_OUT), D, 0, scr, r, lane); continue; } r -= I_OUT;
        if (r < I_UP) { p0_transpose_item(P.ffn_w_up + (size_t)l * D * NUP, NUP, (bf16_t*)(wl + WL_UP), D, 0, scr, r, lane); continue; } r -= I_UP;
        if (r < I_DN) { p0_transpose_item(P.ffn_w_down + (size_t)l * DFF * D, D, (bf16_t*)(wl + WL_DN), DFF, 0, scr, r, lane); continue; } r -= I_DN;
        { const int g = r >> 3, rr = r & 7;
          p0_transpose_item(P.pool_w + ((size_t)l * 4 + g) * 128 * 128, 128, (bf16_t*)(wl + WL_PW) + (size_t)g * 128 * 128, 128, 0, scr, rr, lane); }
    }
    const int gt = blockIdx.x * NTHREADS + tid, NGT = G * NTHREADS;
    for (int e = gt; e < 2 * 4 * 128 * 128; e += NGT) {
        const int l = e >> 16, r = e & 65535, i = (r >> 7) & 127, j = r & 127;
        const float v = ((j >> 6) <= (i >> 6)) ? P.sgu_w[e] : 0.f;
        ((bf16_t*)(P.ws + WS_W + (size_t)l * WL_SIZE + WL_SG))[r] = (bf16_t)f2bf(v);
    }
    for (int e = gt; e < 2 * 8 * 96 * 128; e += NGT) {
        const int lb = e / (96 * 128), r = e - lb * (96 * 128);
        P.out[O_KS + (size_t)lb * 128 * 128 + r] = P.cache_k[(size_t)lb * 128 * 128 + 32 * 128 + r];
        P.out[O_VS + (size_t)lb * 128 * 128 + r] = P.cache_v[(size_t)lb * 128 * 128 + 32 * 128 + r];
    }
    __syncthreads();
    LAS float* part = (LAS float*)lds;
    for (int it = blockIdx.x; it < 2 * 96; it += G) {
        const int l = it / 96, e0 = (it % 96) * 64;
        float acc[12];
#pragma unroll
        for (int b = 0; b < 12; ++b) acc[b] = 0.f;
        const float* wp = P.w_ada + (size_t)l * D * 6144 + e0 + lane;
        for (int d = wave * 128; d < wave * 128 + 128; ++d) {
            const float wv = wp[(size_t)d * 6144];
#pragma unroll
            for (int b = 0; b < 12; ++b) { const float cv = b < 4 ? P.c_prompt[b * D + d] : P.c_sample[(b - 4) * D + d]; acc[b] += cv * sigmoidf_(cv) * wv; }
        }
#pragma unroll
        for (int b = 0; b < 12; ++b) part[(wave * 12 + b) * 64 + lane] = acc[b];
        __syncthreads();
        for (int o = tid; o < 12 * 64; o += NTHREADS) {
            const int b = o >> 6, c = o & 63; float s = P.b_ada[(size_t)l * 6144 + e0 + c];
#pragma unroll
            for (int w = 0; w < 8; ++w) s += part[(w * 12 + b) * 64 + c];
            ((float*)(P.ws + WS_MOD))[((size_t)l * 12 + b) * 6144 + e0 + c] = s;
        }
        __syncthreads();
    }
}

__device__ __forceinline__ void phase_norm(const Params& P, const float* srcp, const float* srcs, const float* g, const float* mod_sh, const float* mod_sc) {
    const int lane = threadIdx.x & 63, wave = threadIdx.x >> 6;
    const int gw = blockIdx.x * NWAVES + wave, NGW = gridDim.x * NWAVES;
    bf16_t* H = (bf16_t*)(P.ws + WS_H);
    for (int row = gw; row < M; row += NGW) {
        const float* xr = row < MP ? srcp + (size_t)row * D : srcs + (size_t)(row - MP) * D;
        const int b = batch_of_row(row);
        f32x4 v[4]; float s = 0.f;
#pragma unroll
        for (int j = 0; j < 4; ++j) { v[j] = *(const f32x4*)(xr + 4 * lane + 256 * j); s += (v[j][0] * v[j][0] + v[j][1] * v[j][1]) + (v[j][2] * v[j][2] + v[j][3] * v[j][3]); }
        const float rstd = rsqrtf(wave_sum(s) * (1.f / D) + 1e-6f);
#pragma unroll
        for (int j = 0; j < 4; ++j) {
            const int c = 4 * lane + 256 * j;
            const f32x4 gg = *(const f32x4*)(g + c), sc = *(const f32x4*)(mod_sc + (size_t)b * 6144 + c), sh = *(const f32x4*)(mod_sh + (size_t)b * 6144 + c);
            f32x4 h = v[j] * rstd * gg * (sc + 1.0f) + sh;
            u32x2 w; w.x = pk2(h[0], h[1]); w.y = pk2(h[2], h[3]);
            *(u32x2*)(H + (size_t)row * D + c) = w;
        }
    }
}
__device__ __forceinline__ void phase_final(const Params& P) {
    const int lane = threadIdx.x & 63, wave = threadIdx.x >> 6;
    const int gw = blockIdx.x * NWAVES + wave, NGW = gridDim.x * NWAVES;
    for (int row = gw; row < M; row += NGW) {
        float* xr = P.out + (size_t)row * D;
        f32x4 v[4]; float s = 0.f;
#pragma unroll
        for (int j = 0; j < 4; ++j) { v[j] = *(const f32x4*)(xr + 4 * lane + 256 * j); s += (v[j][0] * v[j][0] + v[j][1] * v[j][1]) + (v[j][2] * v[j][2] + v[j][3] * v[j][3]); }
        const float rstd = rsqrtf(wave_sum(s) * (1.f / D) + 1e-6f);
#pragma unroll
        for (int j = 0; j < 4; ++j) { const int c = 4 * lane + 256 * j; const f32x4 gg = *(const f32x4*)(P.final_norm_g + c); *(f32x4*)(xr + c) = v[j] * rstd * gg; }
    }
}

constexpr int KS_STRIDE = 144;
constexpr int VT_STRIDE = 400;
constexpr int ATT_KS = 0, ATT_VT = 192 * KS_STRIDE;

__device__ __forceinline__ void attn_item(const Params& P, int layer, int item, LAS unsigned char* lds) {
    const int tid = threadIdx.x, lane = tid & 63, wave = tid >> 6, fr = lane & 15, fq = lane >> 4;
    bf16_t* Z = (bf16_t*)(P.ws + WS_Z);
    const bool samp = item >= 1024;
    int kvh, c = 0, sb = 0, qrow0, klo, khi, nqt;
    if (!samp) { kvh = item & 1; c = (item >> 1) & 127; const int b = item >> 8; qrow0 = b * SEQ + 64 * c; klo = 128 - 64 * (c < 2 ? c : 2); khi = 192; nqt = 4; }
    else { const int s = item - 1024; kvh = s & 1; sb = s >> 1; qrow0 = MP + sb * ST; klo = 0; khi = 160; nqt = 2; }
    __syncthreads();
    {
        const int ch = tid & 7, key0 = tid >> 3;
#pragma unroll
        for (int p = 0; p < 3; ++p) {
            const int j = key0 + 64 * p;
            u32x4 kk = (u32x4){0u, 0u, 0u, 0u}, vv = (u32x4){0u, 0u, 0u, 0u};
            if (j >= klo && j < khi) {
                if (samp && j < 128) {
                    const float* kp = P.cache_k + ((((size_t)layer * 8 + sb) * 128 + j) * 2 + kvh) * 64 + ch * 8;
                    const float* vp = P.cache_v + ((((size_t)layer * 8 + sb) * 128 + j) * 2 + kvh) * 64 + ch * 8;
                    const f32x4 k0 = *(const f32x4*)kp, k1 = *(const f32x4*)(kp + 4), v0 = *(const f32x4*)vp, v1 = *(const f32x4*)(vp + 4);
                    kk.x = pk2(k0[0], k0[1]); kk.y = pk2(k0[2], k0[3]); kk.z = pk2(k1[0], k1[1]); kk.w = pk2(k1[2], k1[3]);
                    vv.x = pk2(v0[0], v0[1]); vv.y = pk2(v0[2], v0[3]); vv.z = pk2(v1[0], v1[1]); vv.w = pk2(v1[2], v1[3]);
                } else {
                    const int row = samp ? (qrow0 + j - 128) : (qrow0 - 128 + j);
                    const bf16_t* zp = Z + (size_t)row * NIN + kvh * 64 + ch * 8;
                    kk = *(const u32x4*)(zp + ZC_K); vv = *(const u32x4*)(zp + ZC_V);
                }
            }
            *(LAS u32x4*)(lds + ATT_KS + j * KS_STRIDE + ch * 16) = kk;
            LAS bf16_t* vt = (LAS bf16_t*)(lds + ATT_VT + (ch * 8) * VT_STRIDE + j * 2);
            vt[0 * (VT_STRIDE / 2)] = (bf16_t)(vv.x & 0xffff); vt[1 * (VT_STRIDE / 2)] = (bf16_t)(vv.x >> 16);
            vt[2 * (VT_STRIDE / 2)] = (bf16_t)(vv.y & 0xffff); vt[3 * (VT_STRIDE / 2)] = (bf16_t)(vv.y >> 16);
            vt[4 * (VT_STRIDE / 2)] = (bf16_t)(vv.z & 0xffff); vt[5 * (VT_STRIDE / 2)] = (bf16_t)(vv.z >> 16);
            vt[6 * (VT_STRIDE / 2)] = (bf16_t)(vv.w & 0xffff); vt[7 * (VT_STRIDE / 2)] = (bf16_t)(vv.w >> 16);
        }
    }
    __syncthreads();
    const int h = kvh * 8 + wave;
    const float slope = exp2f(-0.5f * (float)(h + 1)) * 1.4426950408889634f;
    const float sink = P.attn_sink[layer * 16 + h] * 1.4426950408889634f;
#pragma unroll 1
    for (int qt = 0; qt < nqt; ++qt) {
        const int qrow = qrow0 + 16 * qt + fr;
        bf16_t* qp = Z + (size_t)qrow * NIN + h * 64;
        const bf16x8 q0 = *(const bf16x8*)(qp + 8 * fq), q1 = *(const bf16x8*)(qp + 32 + 8 * fq);
        f32x4 st[12];
#pragma unroll
        for (int kt = 0; kt < 12; ++kt) {
            const LAS unsigned char* kp = lds + ATT_KS + (16 * kt + fr) * KS_STRIDE + 16 * fq;
            const bf16x8 a0 = *(const LAS bf16x8*)kp, a1 = *(const LAS bf16x8*)(kp + 64);
            f32x4 a = (f32x4){0.f, 0.f, 0.f, 0.f};
            a = __builtin_amdgcn_mfma_f32_16x16x32_bf16(a0, q0, a, 0, 0, 0);
            a = __builtin_amdgcn_mfma_f32_16x16x32_bf16(a1, q1, a, 0, 0, 0);
            st[kt] = a;
            if ((kt & 3) == 3) asm volatile("" ::: "memory");
        }
        const int ql = 16 * qt + fr;
        float mx = -INFINITY;
#pragma unroll
        for (int kt = 0; kt < 12; ++kt)
#pragma unroll
            for (int jj = 0; jj < 4; ++jj) {
                const int key = 16 * kt + 4 * fq + jj;
                const float dist = fabsf((float)(128 + ql - key));
                float lg = st[kt][jj] * (0.125f * 1.4426950408889634f) - slope * dist;
                lg = (key >= klo && key < khi) ? lg : -INFINITY;
                st[kt][jj] = lg; mx = fmaxf(mx, lg);
            }
        mx = fmaxf(mx, __shfl_xor(mx, 16)); mx = fmaxf(mx, __shfl_xor(mx, 32));
        mx = fmaxf(mx, sink);
        float sum = 0.f;
#pragma unroll
        for (int kt = 0; kt < 12; ++kt)
#pragma unroll
            for (int jj = 0; jj < 4; ++jj) { const float p = __builtin_amdgcn_exp2f(st[kt][jj] - mx); st[kt][jj] = p; sum += p; }
        sum += __shfl_xor(sum, 16); sum += __shfl_xor(sum, 32);
        const float inv = __builtin_amdgcn_rcpf(sum + __builtin_amdgcn_exp2f(sink - mx));
        bf16x8 pb[6];
#pragma unroll
        for (int s = 0; s < 6; ++s) {
            u32x4 w; w.x = pk2(st[2 * s][0] * inv, st[2 * s][1] * inv); w.y = pk2(st[2 * s][2] * inv, st[2 * s][3] * inv);
            w.z = pk2(st[2 * s + 1][0] * inv, st[2 * s + 1][1] * inv); w.w = pk2(st[2 * s + 1][2] * inv, st[2 * s + 1][3] * inv);
            pb[s] = __builtin_bit_cast(bf16x8, w);
        }
#pragma unroll 1
        for (int dt = 0; dt < 4; ++dt) {
            f32x4 o = (f32x4){0.f, 0.f, 0.f, 0.f};
#pragma unroll
            for (int s = 0; s < 6; ++s) {
                const LAS unsigned char* vp = lds + ATT_VT + (16 * dt + fr) * VT_STRIDE + (32 * s + 4 * fq) * 2;
                const u32x2 lo = *(const LAS u32x2*)vp, hi = *(const LAS u32x2*)(vp + 32);
                const u32x4 av = (u32x4){lo.x, lo.y, hi.x, hi.y};
                o = __builtin_amdgcn_mfma_f32_16x16x32_bf16(__builtin_bit_cast(bf16x8, av), pb[s], o, 0, 0, 0);
            }
            u32x2 w; w.x = pk2(o[0], o[1]); w.y = pk2(o[2], o[3]);
            *(u32x2*)(qp + 16 * dt + 4 * fq) = w;
        }
    }
}

constexpr int MX_RS = 0, MX_VNT = 1024, MX_U = 36864, MX_DT = 76800, MX_ST = 272;
__device__ __forceinline__ void mix_item(const Params& P, int layer, int item, LAS unsigned char* lds) {
    const int tid = threadIdx.x, lane = tid & 63, wave = tid >> 6, fr = lane & 15, fq = lane >> 4;
    bf16_t* Z = (bf16_t*)(P.ws + WS_Z);
    const unsigned char* wl = P.ws + WS_W + (size_t)layer * WL_SIZE;
    const bool samp = item >= 256;
    int row0, L, t0, sb = 0;
    if (!samp) { const int b = item >> 6, ch = item & 63; row0 = b * SEQ + ch * 128; L = 128; t0 = ch * 128; }
    else { sb = item - 256; row0 = MP + sb * ST; L = ST; t0 = 0; }
    LAS float* RS = (LAS float*)(lds + MX_RS);
    __syncthreads();
    for (int k = 0; k < 16; ++k) {
        const int i = wave * 16 + k;
        if (i < L) {
            const u32x4 w = *(const u32x4*)(Z + (size_t)(row0 + i) * NIN + ZC_SV + lane * 8);
            float s = bflo(w.x) * bflo(w.x) + bfhi(w.x) * bfhi(w.x) + bflo(w.y) * bflo(w.y) + bfhi(w.y) * bfhi(w.y)
                    + bflo(w.z) * bflo(w.z) + bfhi(w.z) * bfhi(w.z) + bflo(w.w) * bflo(w.w) + bfhi(w.w) * bfhi(w.w);
            s = wave_sum(s);
            if (lane == 0) RS[i] = rsqrtf(s * (1.f / 512.f) + 1e-6f);
        }
    }
    __syncthreads();
    for (int g = 0; g < 4; ++g) {
#pragma unroll
        for (int p = 0; p < 4; ++p) {
            const int idx = tid + NTHREADS * p, j = idx >> 4, c8 = idx & 15;
            float vn[8];
            if (j < L) {
                const u32x4 w = *(const u32x4*)(Z + (size_t)(row0 + j) * NIN + ZC_SV + g * 128 + c8 * 8);
                const float rs = RS[j]; const float* ng = P.sgu_norm_g + layer * 512 + g * 128 + c8 * 8;
                vn[0] = bflo(w.x) * rs * ng[0]; vn[1] = bfhi(w.x) * rs * ng[1]; vn[2] = bflo(w.y) * rs * ng[2]; vn[3] = bfhi(w.y) * rs * ng[3];
                vn[4] = bflo(w.z) * rs * ng[4]; vn[5] = bfhi(w.z) * rs * ng[5]; vn[6] = bflo(w.w) * rs * ng[6]; vn[7] = bfhi(w.w) * rs * ng[7];
                if (samp) { float* dst = P.out + O_SV + ((size_t)((layer * 8 + sb) * ST + j)) * 512 + g * 128 + c8 * 8;
                    *(f32x4*)dst = (f32x4){vn[0], vn[1], vn[2], vn[3]}; *(f32x4*)(dst + 4) = (f32x4){vn[4], vn[5], vn[6], vn[7]}; }
            } else {
#pragma unroll
                for (int e = 0; e < 8; ++e) vn[e] = 0.f;
            }
            LAS bf16_t* vt = (LAS bf16_t*)(lds + MX_VNT + (c8 * 8) * MX_ST + j * 2);
#pragma unroll
            for (int e = 0; e < 8; ++e) vt[e * (MX_ST / 2)] = (bf16_t)f2bf(vn[e]);
        }
        __syncthreads();
        if (wave * 16 < L) {
            const int i = wave * 16 + fr;
            const bf16_t* wrow = (const bf16_t*)(wl + WL_SG) + ((size_t)g * 128 + i) * 128 + 8 * fq;
            bf16x8 wf[4];
#pragma unroll
            for (int ks = 0; ks < 4; ++ks) wf[ks] = *(const bf16x8*)(wrow + 32 * ks);
            const float bias = P.sgu_b[(layer * 4 + g) * 128 + i];
            bf16_t* zrow = Z + (size_t)(row0 + i) * NIN + ZC_SU + g * 128 + 4 * fq;
#pragma unroll
            for (int ct = 0; ct < 8; ++ct) {
                f32x4 a = (f32x4){0.f, 0.f, 0.f, 0.f};
#pragma unroll
                for (int ks = 0; ks < 4; ++ks) {
                    const bf16x8 av = *(const LAS bf16x8*)(lds + MX_VNT + (16 * ct + fr) * MX_ST + (32 * ks + 8 * fq) * 2);
                    a = __builtin_amdgcn_mfma_f32_16x16x32_bf16(av, wf[ks], a, 0, 0, 0);
                }
                const u32x2 uu = *(const u32x2*)(zrow + 16 * ct);
                u32x2 w; w.x = pk2(bflo(uu.x) * (a[0] + bias), bfhi(uu.x) * (a[1] + bias)); w.y = pk2(bflo(uu.y) * (a[2] + bias), bfhi(uu.y) * (a[3] + bias));
                *(u32x2*)(zrow + 16 * ct) = w;
            }
        }
        __syncthreads();
    }
    for (int g = 0; g < 4; ++g) {
        const int wlen = 2 << g;
        for (int idx = tid; idx < (15 + L) * 16; idx += NTHREADS) {
            const int hh = idx >> 4, c8 = idx & 15, rel = hh - 15;
            u32x4 w = (u32x4){0u, 0u, 0u, 0u};
            if (rel >= 0 || (!samp && t0 > 0)) w = *(const u32x4*)(Z + (size_t)(row0 + rel) * NIN + ZC_PU + g * 128 + c8 * 8);
            else if (samp) {
                const float* sp = P.state_pool + ((size_t)(layer * 8 + sb) * 15 + hh) * 512 + g * 128 + c8 * 8;
                const f32x4 a = *(const f32x4*)sp, b = *(const f32x4*)(sp + 4);
                w.x = pk2(a[0], a[1]); w.y = pk2(a[2], a[3]); w.z = pk2(b[0], b[1]); w.w = pk2(b[2], b[3]);
            }
            *(LAS u32x4*)(lds + MX_U + hh * MX_ST + c8 * 16) = w;
        }
        __syncthreads();
        for (int idx = tid; idx < L * 16; idx += NTHREADS) {
            const int i = idx >> 4, c8 = idx & 15;
            float s[8];
#pragma unroll
            for (int e = 0; e < 8; ++e) s[e] = 0.f;
            for (int k = 0; k < wlen; ++k) {
                const u32x4 w = *(const LAS u32x4*)(lds + MX_U + (15 + i - k) * MX_ST + c8 * 16);
                s[0] += bflo(w.x); s[1] += bfhi(w.x); s[2] += bflo(w.y); s[3] += bfhi(w.y); s[4] += bflo(w.z); s[5] += bfhi(w.z); s[6] += bflo(w.w); s[7] += bfhi(w.w);
            }
            const u32x4 w = *(const LAS u32x4*)(lds + MX_U + (15 + i) * MX_ST + c8 * 16);
            const int pos1 = samp ? (1024 + i + 1) : (t0 + i + 1);
            const float rc = 1.0f / (float)(pos1 < wlen ? pos1 : wlen);
            u32x4 o;
            o.x = pk2(s[0] * rc - bflo(w.x), s[1] * rc - bfhi(w.x)); o.y = pk2(s[2] * rc - bflo(w.y), s[3] * rc - bfhi(w.y));
            o.z = pk2(s[4] * rc - bflo(w.z), s[5] * rc - bfhi(w.z)); o.w = pk2(s[6] * rc - bflo(w.w), s[7] * rc - bfhi(w.w));
            *(LAS u32x4*)(lds + MX_DT + i * MX_ST + c8 * 16) = o;
        }
        __syncthreads();
        if (wave * 16 < L) {
            const int i = wave * 16 + fr;
            bf16x8 df[4];
#pragma unroll
            for (int ks = 0; ks < 4; ++ks) df[ks] = *(const LAS bf16x8*)(lds + MX_DT + i * MX_ST + (32 * ks + 8 * fq) * 2);
            const bf16_t* pw = (const bf16_t*)(wl + WL_PW) + (size_t)g * 128 * 128;
            bf16_t* zrow = Z + (size_t)(row0 + i) * NIN + ZC_SV + g * 128 + 4 * fq;
            const float* psc = P.pool_scale + layer * 512 + g * 128 + 4 * fq;
#pragma unroll
            for (int nt = 0; nt < 8; ++nt) {
                f32x4 a = (f32x4){0.f, 0.f, 0.f, 0.f};
#pragma unroll
                for (int ks = 0; ks < 4; ++ks) {
                    const bf16x8 wv = *(const bf16x8*)(pw + (size_t)(16 * nt + fr) * 128 + 32 * ks + 8 * fq);
                    a = __builtin_amdgcn_mfma_f32_16x16x32_bf16(wv, df[ks], a, 0, 0, 0);
                }
                const f32x4 sc = *(const f32x4*)(psc + 16 * nt);
                u32x2 w; w.x = pk2(a[0] * sc[0], a[1] * sc[1]); w.y = pk2(a[2] * sc[2], a[3] * sc[3]);
                *(u32x2*)(zrow + 16 * nt) = w;
            }
        }
        __syncthreads();
    }
}

__device__ __forceinline__ void phase_mixers(const Params& P, int layer, LAS unsigned char* lds) {
    constexpr int N_ATT = 1024 + 16, N_MIX = 256 + 8;
    for (int it = blockIdx.x; it < N_ATT + N_MIX; it += gridDim.x) {
        if (it < N_ATT) attn_item(P, layer, it, lds);
        else mix_item(P, layer, it - N_ATT, lds);
    }
}

__device__ __forceinline__ void phase_conv(const Params& P, int layer) {
    bf16_t* AB = (bf16_t*)(P.ws + WS_Z);
    const int gt = blockIdx.x * NTHREADS + threadIdx.x, NGT = gridDim.x * NTHREADS;
    const float* cw = P.ffn_conv_w + (size_t)layer * 3 * DFF; const float* cb = P.ffn_conv_b + (size_t)layer * DFF;
    for (int idx = gt; idx < M * (DFF / 8); idx += NGT) {
        const int r = idx / (DFF / 8), f = (idx - r * (DFF / 8)) * 8;
        int t, sb = 0; const bool samp = r >= MP;
        if (!samp) t = r & 8191; else { t = (r - MP) & 31; sb = (r - MP) >> 5; }
        float a0[8], a1[8], a2[8];
        { const u32x4 w = *(const u32x4*)(AB + (size_t)r * NUP + f);
          a0[0] = bflo(w.x); a0[1] = bfhi(w.x); a0[2] = bflo(w.y); a0[3] = bfhi(w.y); a0[4] = bflo(w.z); a0[5] = bfhi(w.z); a0[6] = bflo(w.w); a0[7] = bfhi(w.w); }
        const float* pf = P.state_conv + ((size_t)(layer * 8 + sb) * 2) * DFF + f;
        if (t >= 1) { const u32x4 w = *(const u32x4*)(AB + (size_t)(r - 1) * NUP + f);
          a1[0] = bflo(w.x); a1[1] = bfhi(w.x); a1[2] = bflo(w.y); a1[3] = bfhi(w.y); a1[4] = bflo(w.z); a1[5] = bfhi(w.z); a1[6] = bflo(w.w); a1[7] = bfhi(w.w); }
        else {
#pragma unroll
            for (int e = 0; e < 8; ++e) a1[e] = samp ? pf[DFF + e] : 0.f; }
        if (t >= 2) { const u32x4 w = *(const u32x4*)(AB + (size_t)(r - 2) * NUP + f);
          a2[0] = bflo(w.x); a2[1] = bfhi(w.x); a2[2] = bflo(w.y); a2[3] = bfhi(w.y); a2[4] = bflo(w.z); a2[5] = bfhi(w.z); a2[6] = bflo(w.w); a2[7] = bfhi(w.w); }
        else {
#pragma unroll
            for (int e = 0; e < 8; ++e) a2[e] = samp ? pf[(t == 1 ? DFF : 0) + e] : 0.f; }
        const u32x4 bw = *(const u32x4*)(AB + (size_t)r * NUP + DFF + f);
        float bb[8] = {bflo(bw.x), bfhi(bw.x), bflo(bw.y), bfhi(bw.y), bflo(bw.z), bfhi(bw.z), bflo(bw.w), bfhi(bw.w)};
        float go[8];
#pragma unroll
        for (int e = 0; e < 8; ++e) {
            const float cv = a2[e] * cw[f + e] + a1[e] * cw[DFF + f + e] + a0[e] * cw[2 * DFF + f + e] + cb[f + e];
            go[e] = gelu_tanh(cv) * bb[e];
        }
        u32x4 o; o.x = pk2(go[0], go[1]); o.y = pk2(go[2], go[3]); o.z = pk2(go[4], go[5]); o.w = pk2(go[6], go[7]);
        *(u32x4*)(AB + (size_t)r * NUP + DFF + f) = o;
    }
}

constexpr int NPHASES = 20;
#define RUN(k) (lo <= (k) && (k) < hi)
#define SYNC(k) do { if ((k) + 1 < hi) grid.sync(); } while (0)
template <int l>
__device__ __forceinline__ void layer_phases(const Params& P, LAS unsigned char* lds, cg::grid_group& grid) {
    const int lo = P.ph_lo, hi = P.ph_hi;
    const int G = gridDim.x, c = blockIdx.x;
    unsigned char* ws = P.ws;
    const float* MOD = (const float*)(ws + WS_MOD);
    bf16_t* H = (bf16_t*)(ws + WS_H);
    bf16_t* Z = (bf16_t*)(ws + WS_Z);
    constexpr int pb = 1 + 9 * l;
    const unsigned char* wl = ws + WS_W + (size_t)l * WL_SIZE;
    const float* modl = MOD + (size_t)l * 12 * 6144;
    const float* srcp = l == 0 ? P.x_prompt : P.out + O_YP;
    const float* srcs = l == 0 ? P.x_sample : P.out + O_YS;
    if (RUN(pb + 0)) { phase_norm(P, srcp, srcs, P.norm1_g + l * D, modl + 0 * D, modl + 1 * D); SYNC(pb + 0); }
    if (RUN(pb + 1)) {
        pg8::SimpleOrder S{(const char*)H, (const char*)(wl + WL_IN), (size_t)D * 2, (size_t)D * 2, M / 256, NIN / 256, D / 64, G, c};
        EpiZ E{Z, P.out, l};
        pg8::gemm_phase<EpiZ, pg8::SimpleOrder>(lds, (size_t)D * 2, (size_t)D * 2, S, E);
        SYNC(pb + 1);
    }
    if (l == 0 && PROBE == 1) {
        pg8::SimpleOrder S{(const char*)H, (const char*)(wl + WL_IN), (size_t)D * 2, (size_t)D * 2, M / 256, NIN / 256, D / 64, G, c};
        EpiZ E{Z, P.out, l};
        pg8::gemm_phase<EpiZ, pg8::SimpleOrder>(lds, (size_t)D * 2, (size_t)D * 2, S, E);
        grid.sync();
    }
    if (RUN(pb + 2)) { phase_mixers(P, l, lds); SYNC(pb + 2); }
    if (l == 0 && PROBE == 2) {
        pg8::SimpleOrder S{(const char*)H, (const char*)(wl + WL_IN), (size_t)D * 2, (size_t)D * 2, M / 256, NIN / 256, D / 64, G, c};
        EpiZ E{Z, P.out, l};
        pg8::gemm_phase<EpiZ, pg8::SimpleOrder>(lds, (size_t)D * 2, (size_t)D * 2, S, E);
        grid.sync();
        phase_mixers(P, l, lds);
        grid.sync();
    }
    if (RUN(pb + 3)) {
        pg8::MergeOrder S{(const char*)Z, (const char*)(wl + WL_CAT), (size_t)NIN * 2, (size_t)2048 * 2, M / 256, D / 256, G, c};
        EpiMerge E{Z, H};
        pg8::gemm_phase<EpiMerge, pg8::MergeOrder>(lds, (size_t)NIN * 2, (size_t)2048 * 2, S, E);
        SYNC(pb + 3);
    }
    if (RUN(pb + 4)) {
        pg8::SimpleOrder S{(const char*)H, (const char*)(wl + WL_OUT), (size_t)D * 2, (size_t)D * 2, M / 256, D / 256, D / 64, G, c};
        EpiRes E{srcp, srcs, P.out, modl + 2 * D};
        pg8::gemm_phase<EpiRes, pg8::SimpleOrder>(lds, (size_t)D * 2, (size_t)D * 2, S, E);
        SYNC(pb + 4);
    }
    if (RUN(pb + 5)) { phase_norm(P, P.out + O_YP, P.out + O_YS, P.norm2_g + l * D, modl + 3 * D, modl + 4 * D); SYNC(pb + 5); }
    if (RUN(pb + 6)) {
        pg8::SimpleOrder S{(const char*)H, (const char*)(wl + WL_UP), (size_t)D * 2, (size_t)D * 2, M / 256, NUP / 256, D / 64, G, c};
        EpiUp E{Z, P.out, l};
        pg8::gemm_phase<EpiUp, pg8::SimpleOrder>(lds, (size_t)D * 2, (size_t)D * 2, S, E);
        SYNC(pb + 6);
    }
    if (RUN(pb + 7)) { phase_conv(P, l); SYNC(pb + 7); }
    if (l == 0 && PROBE == 3) {
        pg8::SimpleOrder S{(const char*)H, (const char*)(wl + WL_UP), (size_t)D * 2, (size_t)D * 2, M / 256, NUP / 256, D / 64, G, c};
        EpiUp E{Z, P.out, l};
        pg8::gemm_phase<EpiUp, pg8::SimpleOrder>(lds, (size_t)D * 2, (size_t)D * 2, S, E);
        grid.sync();
        phase_conv(P, l);
        grid.sync();
    }
    if (RUN(pb + 8)) {
        pg8::SimpleOrder S{(const char*)(Z + DFF), (const char*)(wl + WL_DN), (size_t)NUP * 2, (size_t)DFF * 2, M / 256, D / 256, DFF / 64, G, c};
        EpiRes E{P.out + O_YP, P.out + O_YS, P.out, modl + 5 * D};
        pg8::gemm_phase<EpiRes, pg8::SimpleOrder>(lds, (size_t)NUP * 2, (size_t)DFF * 2, S, E);
        SYNC(pb + 8);
    }
}
__global__ void __launch_bounds__(NTHREADS) mk_fwd(Params P) {
    extern __shared__ __attribute__((aligned(16))) unsigned char lds_raw[];
    LAS unsigned char* lds = (LAS unsigned char*)lds_raw;
    cg::grid_group grid = cg::this_grid();
    const int lo = P.ph_lo, hi = P.ph_hi;
    if (RUN(0)) { phase_p0(P, lds); SYNC(0); }
    if (PROBE == 4) { phase_p0(P, lds); grid.sync(); phase_norm(P, P.x_prompt, P.x_sample, P.norm1_g, (const float*)(P.ws + WS_MOD), (const float*)(P.ws + WS_MOD) + D); grid.sync(); }
    if (PROBE == 5) { for (int i = 0; i < 20; ++i) grid.sync(); }
    layer_phases<0>(P, lds, grid);
    layer_phases<1>(P, lds, grid);
    if (RUN(19)) phase_final(P);
}
#undef RUN
#undef SYNC

extern "C" void kernel_launch(void* const* d_in, const int* in_sizes, int n_in, void* d_out, int out_size, void* d_ws, size_t ws_size, hipStream_t stream) {
    static int grid = 0;
    if (grid == 0) {
        if (n_in != 28 || ws_size < WS_END) { fprintf(stderr, "kernel_launch: need 28 inputs and %zu B of workspace (got %d, %zu)\n", (size_t)WS_END, n_in, ws_size); grid = -1; return; }
        int dev = 0, cus = 0, per_cu = 0;
        hipGetDevice(&dev);
        hipDeviceGetAttribute(&cus, hipDeviceAttributeMultiprocessorCount, dev);
        if (hipFuncSetAttribute((const void*)mk_fwd, hipFuncAttributeMaxDynamicSharedMemorySize, LDS_BYTES) != hipSuccess) { fprintf(stderr, "kernel_launch: hipFuncSetAttribute failed\n"); grid = -1; return; }
        if (hipOccupancyMaxActiveBlocksPerMultiprocessor(&per_cu, (const void*)mk_fwd, NTHREADS, LDS_BYTES) != hipSuccess || per_cu < 1) { fprintf(stderr, "kernel_launch: occupancy query failed (%d)\n", per_cu); per_cu = 1; }
        (void)hipGetLastError();
        grid = cus * per_cu;
    }
    if (grid < 0) return;
    Params p{};
    const float** ip = (const float**)&p;
    for (int i = 0; i < 28; ++i) ip[i] = (const float*)d_in[i];
    p.out = (float*)d_out; p.ws = (unsigned char*)d_ws;
#if MULTI_LAUNCH
    for (int ph = 0; ph < NPHASES; ++ph) {
        p.ph_lo = ph; p.ph_hi = ph + 1;
        hipLaunchKernelGGL(mk_fwd, dim3(grid), dim3(NTHREADS), LDS_BYTES, stream, p);
    }
#else
    p.ph_lo = 0; p.ph_hi = NPHASES;
    void* args[] = {&p};
    hipError_t e = hipLaunchCooperativeKernel((const void*)mk_fwd, dim3(grid), dim3(NTHREADS), args, LDS_BYTES, stream);
    if (e != hipSuccess) fprintf(stderr, "cooperative launch failed: %s (grid %d)\n", hipGetErrorString(e), grid);
#endif
}
```

```cpp
#include <hip/hip_runtime.h>
#include <hip/hip_cooperative_groups.h>
#include <cstdio>
namespace cg = cooperative_groups;

#ifndef MULTI_LAUNCH
#define MULTI_LAUNCH 0
#endif

#ifndef PROBE
#define PROBE 0
#endif
#define LAS __attribute__((address_space(3)))
typedef unsigned short bf16_t;
typedef short bf16x8 __attribute__((ext_vector_type(8)));
typedef float f32x4 __attribute__((ext_vector_type(4)));
typedef unsigned u32x4 __attribute__((ext_vector_type(4)));
typedef unsigned u32x2 __attribute__((ext_vector_type(2)));

constexpr int D = 1024, SEQ = 8192, NBP = 4, NBS = 8, ST = 32;
constexpr int MP = NBP * SEQ;
constexpr int MS = NBS * ST;
constexpr int M = MP + MS;
constexpr int NIN = 5888, DFF = 2816, NUP = 5632;
constexpr int NTHREADS = 512, NWAVES = 8;
constexpr int ZC_Q = 0, ZC_K = 1024, ZC_V = 1152, ZC_PU = 1280, ZC_SU = 1792, ZC_SV = 2304, ZC_G = 2816;
constexpr size_t O_YP = 0;
constexpr size_t O_YS = O_YP + (size_t)MP * D;
constexpr size_t O_KP = O_YS + (size_t)MS * D;
constexpr size_t O_VP = O_KP + 2 * 4 * 128 * 128;
constexpr size_t O_PP = O_VP + 2 * 4 * 128 * 128;
constexpr size_t O_CP = O_PP + 2 * 4 * 15 * 512;
constexpr size_t O_KS = O_CP + 2 * 4 * 2 * DFF;
constexpr size_t O_VS = O_KS + 2 * 8 * 128 * 128;
constexpr size_t O_PS = O_VS + 2 * 8 * 128 * 128;
constexpr size_t O_CS = O_PS + 2 * 8 * 15 * 512;
constexpr size_t O_SV = O_CS + 2 * 8 * 2 * DFF;
constexpr size_t WS_MOD = 4096;
constexpr size_t WS_W = 1048576;
constexpr size_t WL_IN = 0;
constexpr size_t WL_CAT = WL_IN + (size_t)NIN * D * 2;
constexpr size_t WL_OUT = WL_CAT + (size_t)D * 2048 * 2;
constexpr size_t WL_UP = WL_OUT + (size_t)D * D * 2;
constexpr size_t WL_DN = WL_UP + (size_t)NUP * D * 2;
constexpr size_t WL_PW = WL_DN + (size_t)D * DFF * 2;
constexpr size_t WL_SG = WL_PW + 4 * 128 * 128 * 2;
constexpr size_t WL_SIZE = WL_SG + 4 * 128 * 128 * 2;
constexpr size_t WS_H = WS_W + 2 * WL_SIZE;
constexpr size_t WS_Z = WS_H + (size_t)M * D * 2;
constexpr size_t WS_END = WS_Z + (size_t)M * NIN * 2;
constexpr int LDS_BYTES = 131072 + 8192;

struct Params {
    const float *x_prompt, *x_sample, *c_prompt, *c_sample, *cache_k, *cache_v, *state_pool, *state_conv;
    const float *norm1_g, *norm2_g, *w_ada, *b_ada, *w_in, *attn_sink, *w_o_attn, *pool_w, *pool_scale, *w_o_pool;
    const float *sgu_norm_g, *sgu_w, *sgu_b, *w_o_sgu, *w_out, *ffn_w_up, *ffn_conv_w, *ffn_conv_b, *ffn_w_down, *final_norm_g;
    float* out; unsigned char* ws;
    int ph_lo, ph_hi;
};

typedef __bf16 bf16x2_t __attribute__((ext_vector_type(2)));
typedef float f32x2_t __attribute__((ext_vector_type(2)));
__device__ __forceinline__ unsigned pk2(float lo, float hi) { const f32x2_t v = {lo, hi}; return __builtin_bit_cast(unsigned, __builtin_convertvector(v, bf16x2_t)); }
__device__ __forceinline__ unsigned f2bf(float f) { return pk2(f, 0.f) & 0xffffu; }
__device__ __forceinline__ float bflo(unsigned w) { return __builtin_bit_cast(float, w << 16); }
__device__ __forceinline__ float bfhi(unsigned w) { return __builtin_bit_cast(float, w & 0xffff0000u); }
__device__ __forceinline__ float bf1(bf16_t h) { return __builtin_bit_cast(float, ((unsigned)h) << 16); }
__device__ __forceinline__ float sigmoidf_(float x) { return __builtin_amdgcn_rcpf(1.0f + __builtin_amdgcn_exp2f(-1.4426950408889634f * x)); }
__device__ __forceinline__ float gelu_tanh(float x) { const float e = __builtin_amdgcn_exp2f(x * (-2.3022081985f - 0.1029432347f * x * x)); return x * __builtin_amdgcn_rcpf(1.0f + e); }
__device__ __forceinline__ float wave_sum(float v) {
#pragma unroll
    for (int o = 1; o < 64; o <<= 1) v += __shfl_xor(v, o);
    return v;
}
__device__ __forceinline__ int batch_of_row(int row) { return row < MP ? (row >> 13) : 4 + ((row - MP) >> 5); }

namespace pg8 {
constexpr int BM = 256, BK = 64, HALF = 128, HTB = HALF * BK * 2, NXCD = 8, WGM = 8;
__device__ __forceinline__ int lds_byte(int r, int c) { const int st = (r >> 4) * 2 + (c >> 5), rr = r & 15, cc = c & 31, ob = rr * 64 + cc * 2; return st * 1024 + (ob ^ (((ob >> 9) & 1) << 5)); }
__device__ __forceinline__ void stage_rc(int b, int& R, int& C) { const int st = b / 1024, sb = b % 1024, swz = sb ^ (((sb >> 9) & 1) << 5); R = (st >> 1) * 16 + swz / 64; C = (st & 1) * 32 + (swz % 64) / 2; }
__device__ __forceinline__ int perm32(int rho) { const int n = rho >> 4, i = rho & 15; return 8 * (i >> 2) + 4 * n + (i & 3); }

struct Unit { const char* A; const char* B; int nt, pm, pn, mode; };

__device__ __forceinline__ void tile_of(int wgid, int nM, int nN, int& pm, int& pn) {
    const int nwg = nM * nN;
    { const int q = nwg / NXCD, r = nwg % NXCD, xcd = wgid % NXCD, off = wgid / NXCD; wgid = (xcd < r ? xcd * (q + 1) : r * (q + 1) + (xcd - r) * q) + off; }
    const int nig = WGM * nN, gid = wgid / nig, fm = gid * WGM, gsz = (nM - fm) < WGM ? (nM - fm) : WGM;
    pm = fm + ((wgid % nig) % gsz); pn = (wgid % nig) / gsz;
}

struct SimpleOrder {
    const char* A; const char* B; size_t lda, ldb; int nM, nN, nt, G, c;
    __device__ __forceinline__ bool next(int i, Unit& u) const {
        const long L = (long)i * G + c; if (L >= (long)nM * nN) return false;
        int pm, pn; tile_of((int)L, nM, nN, pm, pn);
        u.pm = pm; u.pn = pn; u.nt = nt; u.mode = 0; u.A = A + (size_t)pm * 256 * lda; u.B = B + (size_t)pn * 256 * ldb; return true;
    }
};
struct MergeOrder {
    const char* A; const char* B; size_t lda, ldb; int nM, nN, G, c;
    __device__ __forceinline__ bool next(int i, Unit& u) const {
        const int ti = i / 3, br = i - ti * 3;
        const long L = (long)ti * G + c; if (L >= (long)nM * nN) return false;
        int pm, pn; tile_of((int)L, nM, nN, pm, pn);
        u.pm = pm; u.pn = pn; u.mode = br;
        const int ak = br == 0 ? ZC_Q : (br == 1 ? ZC_SV : ZC_SU);
        const int bk = br == 0 ? 0 : (br == 1 ? 1024 : 1536);
        u.nt = br == 0 ? 16 : 8;
        u.A = A + (size_t)pm * 256 * lda + (size_t)ak * 2; u.B = B + (size_t)pn * 256 * ldb + (size_t)bk * 2; return true;
    }
};

struct UpOrder {
    const char* A; const char* B; size_t lda, ldb; int nM, nN, nt, G, c;
    __device__ __forceinline__ bool next(int i, Unit& u) const {
        const long L = (long)i * G + c; if (L >= (long)nM * nN) return false;
        int pm, pn; tile_of((int)L, nM, nN, pm, pn);
        u.pm = pm; u.pn = pn; u.nt = nt; u.mode = 0; u.A = A + ((long)pm * 254 - 2) * (long)lda; u.B = B + (size_t)pn * 256 * ldb; return true;
    }
};

template <class Epi, class Sched>
__device__ __forceinline__ void gemm_phase(LAS unsigned char* lds, const size_t lda, const size_t ldb, const Sched& S, const Epi& E) {
    int tid_ = threadIdx.x; asm volatile("" : "+v"(tid_));
    const int tid = tid_, wid = __builtin_amdgcn_readfirstlane(tid >> 6), lane = tid & 63, wr = wid >> 2, wc = wid & 3, fr = lane & 15, fq = lane >> 4;
    unsigned voffA[2], voffB[2];
#pragma unroll
    for (int i = 0; i < 2; ++i) { int R, C; stage_rc(tid * 16 + i * 8192, R, C); const int Rb = Epi::PERM ? ((R & ~31) + perm32(R & 31)) : R;
        voffA[i] = (unsigned)(R * lda + C * 2); voffB[i] = (unsigned)(Rb * ldb + C * 2); }
    const size_t kstep = (size_t)(BK * 2);
    const size_t hstepA = (size_t)HALF * lda, hstepB = (size_t)HALF * ldb;
    const unsigned ldsw = (unsigned)wid * 1024u;
    const int aoff = lds_byte(wr * 64 + fr, fq * 8), boff = lds_byte(wc * 32 + fr, fq * 8);
#define PG8_SA(b, h) (((b) * 2 + (h)) * HTB)
#define PG8_SB(b, h) ((4 + (b) * 2 + (h)) * HTB)
#define PG8_STAGE(bufoff, gbase, voff) do { _Pragma("unroll") for (int _i = 0; _i < 2; ++_i) \
        __builtin_amdgcn_global_load_lds((const unsigned*)((const char*)(gbase) + (voff)[_i]), (LAS unsigned*)(lds + (bufoff) + ldsw + _i * 8192), 16, 0, 0); } while (0)
#define PG8_LDA(dst, b, h) do { _Pragma("unroll") for (int m = 0; m < 4; ++m) _Pragma("unroll") for (int k = 0; k < 2; ++k) dst[m][k] = *(const LAS bf16x8*)(lds + PG8_SA(b, h) + aoff + m * 2048 + k * 1024); } while (0)
#define PG8_LDB(dst, b, h) do { _Pragma("unroll") for (int n = 0; n < 2; ++n) _Pragma("unroll") for (int k = 0; k < 2; ++k) dst[n][k] = *(const LAS bf16x8*)(lds + PG8_SB(b, h) + boff + n * 2048 + k * 1024); } while (0)
#define PG8_MMA(ai, bj, At, Bt) do { __builtin_amdgcn_s_setprio(1); _Pragma("unroll") for (int m = 0; m < 4; ++m) _Pragma("unroll") for (int n = 0; n < 2; ++n) _Pragma("unroll") for (int k = 0; k < 2; ++k) \
        acc[ai][bj][m][n] = __builtin_amdgcn_mfma_f32_16x16x32_bf16(Bt[n][k], At[m][k], acc[ai][bj][m][n], 0, 0, 0); __builtin_amdgcn_s_setprio(0); } while (0)
#define PG8_WAIT_V(n) asm volatile("s_waitcnt vmcnt(" #n ")" ::: "memory")
#define PG8_WAIT_L(n) asm volatile("s_waitcnt lgkmcnt(" #n ")" ::: "memory")
#define PG8_BAR __builtin_amdgcn_s_barrier()
#define PG8_SCHED __builtin_amdgcn_sched_barrier(0)
    Unit cur, nxt; int ui = 0;
    if (!S.next(0, cur)) return;
    f32x4 acc[2][2][4][2];
#pragma unroll
    for (int a = 0; a < 2; ++a)
#pragma unroll
        for (int b = 0; b < 2; ++b)
#pragma unroll
            for (int m = 0; m < 4; ++m)
#pragma unroll
                for (int n = 0; n < 2; ++n) acc[a][b][m][n] = (f32x4){0.f, 0.f, 0.f, 0.f};
    bf16x8 At[4][2], B0[2][2], B1[2][2];
    const char* cA = cur.A; const char* cB = cur.B;
    PG8_STAGE(PG8_SB(0, 0), cB, voffB); PG8_STAGE(PG8_SA(0, 0), cA, voffA); PG8_STAGE(PG8_SB(0, 1), cB + hstepB, voffB); PG8_STAGE(PG8_SA(0, 1), cA + hstepA, voffA);
    if (wr == 1) PG8_BAR;
    PG8_WAIT_V(4); PG8_BAR;
    PG8_STAGE(PG8_SB(1, 0), cB + kstep, voffB); PG8_STAGE(PG8_SA(1, 0), cA + kstep, voffA); PG8_STAGE(PG8_SB(1, 1), cB + hstepB + kstep, voffB);
    PG8_WAIT_V(6); PG8_BAR;
    for (;;) {
        const bool has_next = S.next(ui + 1, nxt);
        const char* nA = has_next ? nxt.A : cA; const char* nB = has_next ? nxt.B : cB;
        const int nt = cur.nt;
        for (int t = 0; t < nt; t += 2) {
            const bool last = (t == nt - 2);
            const char* a1 = cA + (size_t)(t + 1) * kstep;
            const char* a2 = last ? nA : cA + (size_t)(t + 2) * kstep; const char* b2 = last ? nB : cB + (size_t)(t + 2) * kstep;
            const char* a3 = a2 + kstep; const char* b3 = b2 + kstep;
            PG8_LDB(B0, 0, 0); PG8_SCHED; PG8_LDA(At, 0, 0); PG8_STAGE(PG8_SA(1, 1), a1 + hstepA, voffA);
            PG8_WAIT_L(8); PG8_BAR; PG8_WAIT_L(0); PG8_MMA(0, 0, At, B0); PG8_BAR; PG8_SCHED;
            PG8_LDB(B1, 0, 1); PG8_STAGE(PG8_SB(0, 0), b2, voffB);
            PG8_BAR; PG8_WAIT_L(0); PG8_MMA(0, 1, At, B1); PG8_BAR;
            PG8_LDA(At, 0, 1); PG8_STAGE(PG8_SA(0, 0), a2, voffA);
            PG8_BAR; PG8_WAIT_L(0); PG8_MMA(1, 0, At, B0); PG8_BAR; PG8_SCHED;
            PG8_STAGE(PG8_SB(0, 1), b2 + hstepB, voffB);
            PG8_WAIT_V(6); PG8_BAR; PG8_MMA(1, 1, At, B1); PG8_BAR;
            PG8_LDB(B0, 1, 0); PG8_SCHED; PG8_LDA(At, 1, 0); PG8_STAGE(PG8_SA(0, 1), a2 + hstepA, voffA);
            PG8_WAIT_L(8); PG8_BAR; PG8_WAIT_L(0); PG8_MMA(0, 0, At, B0); PG8_BAR; PG8_SCHED;
            PG8_LDB(B1, 1, 1); PG8_STAGE(PG8_SB(1, 0), b3, voffB);
            PG8_BAR; PG8_WAIT_L(0); PG8_MMA(0, 1, At, B1); PG8_BAR;
            PG8_LDA(At, 1, 1); PG8_STAGE(PG8_SA(1, 0), a3, voffA);
            PG8_BAR; PG8_WAIT_L(0); PG8_MMA(1, 0, At, B0); PG8_BAR; PG8_SCHED;
            PG8_STAGE(PG8_SB(1, 1), b3 + hstepB, voffB);
            PG8_WAIT_V(6); PG8_BAR; PG8_MMA(1, 1, At, B1); PG8_BAR;
        }
        if (wr == 0) PG8_BAR;
        E(acc, cur, wr, wc, fr, fq);
        if (!has_next) break;
#pragma unroll
        for (int a = 0; a < 2; ++a)
#pragma unroll
            for (int b = 0; b < 2; ++b)
#pragma unroll
                for (int m = 0; m < 4; ++m)
#pragma unroll
                    for (int n = 0; n < 2; ++n) acc[a][b][m][n] = (f32x4){0.f, 0.f, 0.f, 0.f};
        cur = nxt; cA = nA; cB = nB; ++ui;
        if (wr == 1) PG8_BAR;
    }
    PG8_WAIT_V(0);
    PG8_BAR;
#undef PG8_SA
#undef PG8_SB
#undef PG8_STAGE
#undef PG8_LDA
#undef PG8_LDB
#undef PG8_MMA
#undef PG8_WAIT_V
#undef PG8_WAIT_L
#undef PG8_BAR
#undef PG8_SCHED
}
}

struct EpiZ {
    static constexpr bool PERM = true;
    bf16_t* Z; float* out; int layer;
    __device__ __forceinline__ void operator()(const f32x4 (&acc)[2][2][4][2], const pg8::Unit& u, int wr, int wc, int fr, int fq) const {
        const int pn = u.pn;
#pragma unroll
        for (int ai = 0; ai < 2; ++ai)
#pragma unroll
            for (int m = 0; m < 4; ++m) {
                const int row = u.pm * 256 + ai * 128 + wr * 64 + m * 16 + fr;
                int b, t; const bool samp = row >= MP;
                if (!samp) { b = row >> 13; t = row & 8191; } else { b = (row - MP) >> 5; t = (row - MP) & 31; }
#pragma unroll
                for (int bj = 0; bj < 2; ++bj) {
                    const int col0 = pn * 256 + bj * 128 + wc * 32 + 8 * fq;
                    f32x4 v0 = acc[ai][bj][m][0], v1 = acc[ai][bj][m][1];
                    if (pn == 4) {
                        const int cc = col0 - ZC_K; float* dst = nullptr;
                        if (!samp) { if (t >= SEQ - 128) dst = out + (cc < 128 ? O_KP : O_VP) + ((size_t)((layer * 4 + b) * 128 + (t - (SEQ - 128))) * 128 + (cc & 127)); }
                        else dst = out + (cc < 128 ? O_KS : O_VS) + ((size_t)((layer * 8 + b) * 128 + 96 + t) * 128 + (cc & 127));
                        if (dst) { *(f32x4*)dst = v0; *(f32x4*)(dst + 4) = v1; }
                    } else if (pn == 5 || pn == 6) {
                        const int cc = col0 - ZC_PU; float* dst = nullptr;
                        if (!samp) { if (t >= SEQ - 15) dst = out + O_PP + ((size_t)((layer * 4 + b) * 15 + (t - (SEQ - 15))) * 512 + cc); }
                        else { if (t >= ST - 15) dst = out + O_PS + ((size_t)((layer * 8 + b) * 15 + (t - (ST - 15))) * 512 + cc); }
                        if (dst) { *(f32x4*)dst = v0; *(f32x4*)(dst + 4) = v1; }
                    }
                    if (pn >= 11) {
#pragma unroll
                        for (int j = 0; j < 4; ++j) { v0[j] = sigmoidf_(v0[j]); v1[j] = sigmoidf_(v1[j]); }
                    } else if (pn >= 7) {
#pragma unroll
                        for (int j = 0; j < 4; ++j) { v0[j] = gelu_tanh(v0[j]); v1[j] = gelu_tanh(v1[j]); }
                    }
                    u32x4 w; w.x = pk2(v0[0], v0[1]); w.y = pk2(v0[2], v0[3]); w.z = pk2(v1[0], v1[1]); w.w = pk2(v1[2], v1[3]);
                    *(u32x4*)(Z + (size_t)row * NIN + col0) = w;
                }
            }
    }
};
struct EpiMerge {
    static constexpr bool PERM = true;
    const bf16_t* Z; bf16_t* MG;
    __device__ __forceinline__ void operator()(const f32x4 (&acc)[2][2][4][2], const pg8::Unit& u, int wr, int wc, int fr, int fq) const {
        const int mode = u.mode;
#pragma unroll
        for (int ai = 0; ai < 2; ++ai)
#pragma unroll
            for (int m = 0; m < 4; ++m) {
                const int row = u.pm * 256 + ai * 128 + wr * 64 + m * 16 + fr;
#pragma unroll
                for (int bj = 0; bj < 2; ++bj) {
                    const int col0 = u.pn * 256 + bj * 128 + wc * 32 + 8 * fq;
                    const u32x4 g = *(const u32x4*)(Z + (size_t)row * NIN + ZC_G + mode * 1024 + col0);
                    f32x4 v0 = acc[ai][bj][m][0], v1 = acc[ai][bj][m][1];
                    v0[0] *= bflo(g.x); v0[1] *= bfhi(g.x); v0[2] *= bflo(g.y); v0[3] *= bfhi(g.y);
                    v1[0] *= bflo(g.z); v1[1] *= bfhi(g.z); v1[2] *= bflo(g.w); v1[3] *= bfhi(g.w);
                    bf16_t* mp = MG + (size_t)row * D + col0;
                    if (mode != 0) { const u32x4 o = *(const u32x4*)mp;
                        v0[0] += bflo(o.x); v0[1] += bfhi(o.x); v0[2] += bflo(o.y); v0[3] += bfhi(o.y);
                        v1[0] += bflo(o.z); v1[1] += bfhi(o.z); v1[2] += bflo(o.w); v1[3] += bfhi(o.w); }
                    u32x4 w; w.x = pk2(v0[0], v0[1]); w.y = pk2(v0[2], v0[3]); w.z = pk2(v1[0], v1[1]); w.w = pk2(v1[2], v1[3]);
                    *(u32x4*)mp = w;
                }
            }
    }
};
struct EpiRes {
    static constexpr bool PERM = false;
    const float* srcp; const float* srcs; float* X; const float* gmod;
    __device__ __forceinline__ void operator()(const f32x4 (&acc)[2][2][4][2], const pg8::Unit& u, int wr, int wc, int fr, int fq) const {
#pragma unroll
        for (int ai = 0; ai < 2; ++ai)
#pragma unroll
            for (int m = 0; m < 4; ++m) {
                const int row = u.pm * 256 + ai * 128 + wr * 64 + m * 16 + fr;
                const float* sp = row < MP ? srcp + (size_t)row * D : srcs + (size_t)(row - MP) * D;
                const float* gp = gmod + (size_t)batch_of_row(row) * 6144;
                float* xp = X + (size_t)row * D;
#pragma unroll
                for (int bj = 0; bj < 2; ++bj)
#pragma unroll
                    for (int n = 0; n < 2; ++n) {
                        const int col = u.pn * 256 + bj * 128 + wc * 32 + 16 * n + 4 * fq;
                        const f32x4 s = *(const f32x4*)(sp + col), g = *(const f32x4*)(gp + col);
                        *(f32x4*)(xp + col) = s + g * acc[ai][bj][m][n];
                    }
            }
    }
};
constexpr int XCH_OFF = 131072;
struct EpiUpConv {
    static constexpr bool PERM = true;
    bf16_t* Gb; float* out; const float* cw; const float* cb; const float* pref; int layer; LAS unsigned char* lds;
    __device__ __forceinline__ void operator()(const f32x4 (&acc)[2][2][4][2], const pg8::Unit& u, int wr, int wc, int fr, int fq) const {
        const int lane = fq * 16 + fr;
        LAS float* xch = (LAS float*)(lds + XCH_OFF);
        const int cl = wc * 32 + 8 * fq;
#pragma unroll
        for (int ai = 0; ai < 2; ++ai) {
            const int bnd = 2 * ai + wr;
            if (bnd < 3 && fr >= 14) {
                *(LAS f32x4*)(xch + (bnd * 2 + (fr - 14)) * 128 + cl) = acc[ai][0][3][0];
                *(LAS f32x4*)(xch + (bnd * 2 + (fr - 14)) * 128 + cl + 4) = acc[ai][0][3][1];
            }
        }
        asm volatile("s_waitcnt lgkmcnt(0)" ::: "memory"); __builtin_amdgcn_s_barrier(); asm volatile("" ::: "memory");
        const int rbase = u.pm * 254 - 2;
        const int ad1 = ((lane - 1) & 63) << 2, ad2 = ((lane - 2) & 63) << 2, ad15 = ((lane + 15) & 63) << 2, ad14 = ((lane + 14) & 63) << 2;
#pragma unroll
        for (int n = 0; n < 2; ++n) {
            const int f0 = u.pn * 128 + cl + 4 * n;
            const f32x4 w0 = *(const f32x4*)(cw + f0), w1 = *(const f32x4*)(cw + DFF + f0), w2 = *(const f32x4*)(cw + 2 * DFF + f0), bb = *(const f32x4*)(cb + f0);
#pragma unroll
            for (int ai = 0; ai < 2; ++ai) {
                const int bp = 2 * ai + wr - 1 < 0 ? 0 : 2 * ai + wr - 1;
                const f32x4 x1 = *(const LAS f32x4*)(xch + (bp * 2 + 1) * 128 + cl + 4 * n), x2 = *(const LAS f32x4*)(xch + (bp * 2 + (fr & 1)) * 128 + cl + 4 * n);
#pragma unroll
                for (int m = 0; m < 4; ++m) {
                    const int tl = ai * 128 + wr * 64 + m * 16 + fr, row = rbase + tl;
                    int t, sb = 0; const bool samp = row >= MP;
                    if (!samp) t = row & 8191; else { t = (row - MP) & 31; sb = (row - MP) >> 5; }
                    const bool valid = tl >= 2 && row < M;
                    f32x4 p1 = (f32x4){0.f, 0.f, 0.f, 0.f}, p0 = p1;
                    if (samp && t < 2 && row < M) { const float* pp = pref + (size_t)sb * 2 * DFF + f0; p0 = *(const f32x4*)pp; p1 = *(const f32x4*)(pp + DFF); }
                    float gv[4];
#pragma unroll
                    for (int j = 0; j < 4; ++j) {
                        const float cur = acc[ai][0][m][n][j];
                        const float s1 = __builtin_bit_cast(float, __builtin_amdgcn_ds_bpermute(ad1, __builtin_bit_cast(int, cur)));
                        const float s2 = __builtin_bit_cast(float, __builtin_amdgcn_ds_bpermute(ad2, __builtin_bit_cast(int, cur)));
                        float q1, q2;
                        if (m > 0) {
                            const float prv = acc[ai][0][m > 0 ? m - 1 : 0][n][j];
                            q1 = __builtin_bit_cast(float, __builtin_amdgcn_ds_bpermute(ad15, __builtin_bit_cast(int, prv)));
                            q2 = __builtin_bit_cast(float, __builtin_amdgcn_ds_bpermute(ad14, __builtin_bit_cast(int, prv)));
                        } else { q1 = x1[j]; q2 = x2[j]; }
                        float up1 = fr >= 1 ? s1 : q1, up2 = fr >= 2 ? s2 : q2;
                        if (t == 0) { up1 = p1[j]; up2 = p0[j]; } else if (t == 1) { up2 = p1[j]; }
                        const float cv = up2 * w0[j] + up1 * w1[j] + cur * w2[j] + bb[j];
                        gv[j] = gelu_tanh(cv) * acc[ai][1][m][n][j];
                    }
                    if (valid) {
                        int b, tt; if (!samp) { b = row >> 13; tt = t - (SEQ - 2); } else { b = sb; tt = t - (ST - 2); }
                        if (tt >= 0) *(f32x4*)(out + (samp ? O_CS : O_CP) + ((size_t)((layer * (samp ? 8 : 4) + b) * 2 + tt) * DFF + f0)) = acc[ai][0][m][n];
                        u32x2 w; w.x = pk2(gv[0], gv[1]); w.y = pk2(gv[2], gv[3]);
                        *(u32x2*)(Gb + (size_t)row * DFF + f0) = w;
                    }
                }
            }
        }
    }
};

template <bool UPMAP = false>
__device__ __forceinline__ void p0_transpose_item(const float* W, int N, bf16_t* WT, size_t ldt, int col_off, LAS float* scr, int item, int lane) {
    const int nblk = N / 32, kb = item / nblk, nb = item % nblk, k0 = 64 * kb, n0 = 32 * nb;
    const int r0 = UPMAP ? (n0 < DFF ? 256 * (n0 >> 7) + (n0 & 127) : 256 * ((n0 - DFF) >> 7) + 128 + ((n0 - DFF) & 127)) : n0;
#pragma unroll 8
    for (int i = 0; i < 32; ++i) { const int kk = 2 * i + (lane >> 5); scr[kk * 33 + (lane & 31)] = W[(size_t)(k0 + kk) * N + n0 + (lane & 31)]; }
    asm volatile("s_waitcnt lgkmcnt(0)" ::: "memory");
    const int c = lane & 7;
#pragma unroll
    for (int j = 0; j < 4; ++j) { const int n = (lane >> 3) + 8 * j; const LAS float* s = scr + (8 * c) * 33 + n;
        u32x4 o; o.x = pk2(s[0 * 33], s[1 * 33]); o.y = pk2(s[2 * 33], s[3 * 33]); o.z = pk2(s[4 * 33], s[5 * 33]); o.w = pk2(s[6 * 33], s[7 * 33]);
        *(u32x4*)(WT + (size_t)(r0 + n) * ldt + col_off + k0 + 8 * c) = o; }
    asm volatile("s_waitcnt lgkmcnt(0)" ::: "memory");
}

__device__ __forceinline__ void phase_p0(const Params& P, LAS unsigned char* lds) {
    const int tid = threadIdx.x, lane = tid & 63, wave = tid >> 6;
    const int G = gridDim.x, gw = blockIdx.x * NWAVES + wave, NGW = G * NWAVES;
    LAS float* scr = (LAS float*)(lds + wave * 8704);
    constexpr int I_IN = 16 * (NIN / 32), I_OA = 16 * 32, I_OP = 8 * 32, I_OS = 8 * 32, I_OUT = 16 * 32, I_UP = 16 * (NUP / 32), I_DN = (DFF / 64) * 32, I_PW = 4 * 2 * 4;
    constexpr int I_L = I_IN + I_OA + I_OP + I_OS + I_OUT + I_UP + I_DN + I_PW;
    for (int it = gw; it < 2 * I_L; it += NGW) {
        const int l = it / I_L; int r = it - l * I_L;
        unsigned char* wl = P.ws + WS_W + (size_t)l * WL_SIZE;
        if (r < I_IN) { p0_transpose_item(P.w_in + (size_t)l * D * NIN, NIN, (bf16_t*)(wl + WL_IN), D, 0, scr, r, lane); continue; } r -= I_IN;
        if (r < I_OA) { p0_transpose_item(P.w_o_attn + (size_t)l * D * D, D, (bf16_t*)(wl + WL_CAT), 2048, 0, scr, r, lane); continue; } r -= I_OA;
        if (r < I_OP) { p0_transpose_item(P.w_o_pool + (size_t)l * 512 * D, D, (bf16_t*)(wl + WL_CAT), 2048, 1024, scr, r, lane); continue; } r -= I_OP;
        if (r < I_OS) { p0_transpose_item(P.w_o_sgu + (size_t)l * 512 * D, D, (bf16_t*)(wl + WL_CAT), 2048, 1536, scr, r, lane); continue; } r -= I_OS;
        if (r < I_OUT) { p0_transpose_item(P.w_out + (size_t)l * D * D, D, (bf16_t*)(wl + WL_OUT), D, 0, scr, r, lane); continue; } r -= I_OUT;
        if (r < I_UP) { p0_transpose_item<true>(P.ffn_w_up + (size_t)l * D * NUP, NUP, (bf16_t*)(wl + WL_UP), D, 0, scr, r, lane); continue; } r -= I_UP;
        if (r < I_DN) { p0_transpose_item(P.ffn_w_down + (size_t)l * DFF * D, D, (bf16_t*)(wl + WL_DN), DFF, 0, scr, r, lane); continue; } r -= I_DN;
        { const int g = r >> 3, rr = r & 7;
          p0_transpose_item(P.pool_w + ((size_t)l * 4 + g) * 128 * 128, 128, (bf16_t*)(wl + WL_PW) + (size_t)g * 128 * 128, 128, 0, scr, rr, lane); }
    }
    const int gt = blockIdx.x * NTHREADS + tid, NGT = G * NTHREADS;
    for (int e = gt; e < 2 * 4 * 128 * 128; e += NGT) {
        const int l = e >> 16, r = e & 65535, i = (r >> 7) & 127, j = r & 127;
        const float v = ((j >> 6) <= (i >> 6)) ? P.sgu_w[e] : 0.f;
        ((bf16_t*)(P.ws + WS_W + (size_t)l * WL_SIZE + WL_SG))[r] = (bf16_t)f2bf(v);
    }
    for (int e = gt; e < 2 * 8 * 96 * 128; e += NGT) {
        const int lb = e / (96 * 128), r = e - lb * (96 * 128);
        P.out[O_KS + (size_t)lb * 128 * 128 + r] = P.cache_k[(size_t)lb * 128 * 128 + 32 * 128 + r];
        P.out[O_VS + (size_t)lb * 128 * 128 + r] = P.cache_v[(size_t)lb * 128 * 128 + 32 * 128 + r];
    }
    __syncthreads();
    LAS float* part = (LAS float*)lds;
    for (int it = blockIdx.x; it < 2 * 96; it += G) {
        const int l = it / 96, e0 = (it % 96) * 64;
        float acc[12];
#pragma unroll
        for (int b = 0; b < 12; ++b) acc[b] = 0.f;
        const float* wp = P.w_ada + (size_t)l * D * 6144 + e0 + lane;
        for (int d = wave * 128; d < wave * 128 + 128; ++d) {
            const float wv = wp[(size_t)d * 6144];
#pragma unroll
            for (int b = 0; b < 12; ++b) { const float cv = b < 4 ? P.c_prompt[b * D + d] : P.c_sample[(b - 4) * D + d]; acc[b] += cv * sigmoidf_(cv) * wv; }
        }
#pragma unroll
        for (int b = 0; b < 12; ++b) part[(wave * 12 + b) * 64 + lane] = acc[b];
        __syncthreads();
        for (int o = tid; o < 12 * 64; o += NTHREADS) {
            const int b = o >> 6, c = o & 63; float s = P.b_ada[(size_t)l * 6144 + e0 + c];
#pragma unroll
            for (int w = 0; w < 8; ++w) s += part[(w * 12 + b) * 64 + c];
            ((float*)(P.ws + WS_MOD))[((size_t)l * 12 + b) * 6144 + e0 + c] = s;
        }
        __syncthreads();
    }
}

__device__ __forceinline__ void phase_norm(const Params& P, const float* srcp, const float* srcs, const float* g, const float* mod_sh, const float* mod_sc) {
    const int lane = threadIdx.x & 63, wave = threadIdx.x >> 6;
    const int gw = blockIdx.x * NWAVES + wave, NGW = gridDim.x * NWAVES;
    bf16_t* H = (bf16_t*)(P.ws + WS_H);
    for (int row = gw; row < M; row += NGW) {
        const float* xr = row < MP ? srcp + (size_t)row * D : srcs + (size_t)(row - MP) * D;
        const int b = batch_of_row(row);
        f32x4 v[4]; float s = 0.f;
#pragma unroll
        for (int j = 0; j < 4; ++j) { v[j] = *(const f32x4*)(xr + 4 * lane + 256 * j); s += (v[j][0] * v[j][0] + v[j][1] * v[j][1]) + (v[j][2] * v[j][2] + v[j][3] * v[j][3]); }
        const float rstd = rsqrtf(wave_sum(s) * (1.f / D) + 1e-6f);
#pragma unroll
        for (int j = 0; j < 4; ++j) {
            const int c = 4 * lane + 256 * j;
            const f32x4 gg = *(const f32x4*)(g + c), sc = *(const f32x4*)(mod_sc + (size_t)b * 6144 + c), sh = *(const f32x4*)(mod_sh + (size_t)b * 6144 + c);
            f32x4 h = v[j] * rstd * gg * (sc + 1.0f) + sh;
            u32x2 w; w.x = pk2(h[0], h[1]); w.y = pk2(h[2], h[3]);
            *(u32x2*)(H + (size_t)row * D + c) = w;
        }
    }
}
__device__ __forceinline__ void phase_final(const Params& P) {
    const int lane = threadIdx.x & 63, wave = threadIdx.x >> 6;
    const int gw = blockIdx.x * NWAVES + wave, NGW = gridDim.x * NWAVES;
    for (int row = gw; row < M; row += NGW) {
        float* xr = P.out + (size_t)row * D;
        f32x4 v[4]; float s = 0.f;
#pragma unroll
        for (int j = 0; j < 4; ++j) { v[j] = *(const f32x4*)(xr + 4 * lane + 256 * j); s += (v[j][0] * v[j][0] + v[j][1] * v[j][1]) + (v[j][2] * v[j][2] + v[j][3] * v[j][3]); }
        const float rstd = rsqrtf(wave_sum(s) * (1.f / D) + 1e-6f);
#pragma unroll
        for (int j = 0; j < 4; ++j) { const int c = 4 * lane + 256 * j; const f32x4 gg = *(const f32x4*)(P.final_norm_g + c); *(f32x4*)(xr + c) = v[j] * rstd * gg; }
    }
}

constexpr int KS_STRIDE = 144;
constexpr int VT_STRIDE = 400;
constexpr int ATT_KS = 0, ATT_VT = 192 * KS_STRIDE;

__device__ __forceinline__ void attn_item(const Params& P, int layer, int item, LAS unsigned char* lds) {
    const int tid = threadIdx.x, lane = tid & 63, wave = tid >> 6, fr = lane & 15, fq = lane >> 4;
    bf16_t* Z = (bf16_t*)(P.ws + WS_Z);
    const bool samp = item >= 1024;
    int kvh, c = 0, sb = 0, qrow0, klo, khi, nqt;
    if (!samp) { kvh = item & 1; c = (item >> 1) & 127; const int b = item >> 8; qrow0 = b * SEQ + 64 * c; klo = 128 - 64 * (c < 2 ? c : 2); khi = 192; nqt = 4; }
    else { const int s = item - 1024; kvh = s & 1; sb = s >> 1; qrow0 = MP + sb * ST; klo = 0; khi = 160; nqt = 2; }
    __syncthreads();
    {
        const int ch = tid & 7, key0 = tid >> 3;
#pragma unroll
        for (int p = 0; p < 3; ++p) {
            const int j = key0 + 64 * p;
            u32x4 kk = (u32x4){0u, 0u, 0u, 0u}, vv = (u32x4){0u, 0u, 0u, 0u};
            if (j >= klo && j < khi) {
                if (samp && j < 128) {
                    const float* kp = P.cache_k + ((((size_t)layer * 8 + sb) * 128 + j) * 2 + kvh) * 64 + ch * 8;
                    const float* vp = P.cache_v + ((((size_t)layer * 8 + sb) * 128 + j) * 2 + kvh) * 64 + ch * 8;
                    const f32x4 k0 = *(const f32x4*)kp, k1 = *(const f32x4*)(kp + 4), v0 = *(const f32x4*)vp, v1 = *(const f32x4*)(vp + 4);
                    kk.x = pk2(k0[0], k0[1]); kk.y = pk2(k0[2], k0[3]); kk.z = pk2(k1[0], k1[1]); kk.w = pk2(k1[2], k1[3]);
                    vv.x = pk2(v0[0], v0[1]); vv.y = pk2(v0[2], v0[3]); vv.z = pk2(v1[0], v1[1]); vv.w = pk2(v1[2], v1[3]);
                } else {
                    const int row = samp ? (qrow0 + j - 128) : (qrow0 - 128 + j);
                    const bf16_t* zp = Z + (size_t)row * NIN + kvh * 64 + ch * 8;
                    kk = *(const u32x4*)(zp + ZC_K); vv = *(const u32x4*)(zp + ZC_V);
                }
            }
            *(LAS u32x4*)(lds + ATT_KS + j * KS_STRIDE + ch * 16) = kk;
            LAS bf16_t* vt = (LAS bf16_t*)(lds + ATT_VT + (ch * 8) * VT_STRIDE + j * 2);
            vt[0 * (VT_STRIDE / 2)] = (bf16_t)(vv.x & 0xffff); vt[1 * (VT_STRIDE / 2)] = (bf16_t)(vv.x >> 16);
            vt[2 * (VT_STRIDE / 2)] = (bf16_t)(vv.y & 0xffff); vt[3 * (VT_STRIDE / 2)] = (bf16_t)(vv.y >> 16);
            vt[4 * (VT_STRIDE / 2)] = (bf16_t)(vv.z & 0xffff); vt[5 * (VT_STRIDE / 2)] = (bf16_t)(vv.z >> 16);
            vt[6 * (VT_STRIDE / 2)] = (bf16_t)(vv.w & 0xffff); vt[7 * (VT_STRIDE / 2)] = (bf16_t)(vv.w >> 16);
        }
    }
    __syncthreads();
    const int h = kvh * 8 + wave;
    const float slope = exp2f(-0.5f * (float)(h + 1)) * 1.4426950408889634f;
    const float sink = P.attn_sink[layer * 16 + h] * 1.4426950408889634f;
#pragma unroll 1
    for (int qt = 0; qt < nqt; ++qt) {
        const int qrow = qrow0 + 16 * qt + fr;
        bf16_t* qp = Z + (size_t)qrow * NIN + h * 64;
        const bf16x8 q0 = *(const bf16x8*)(qp + 8 * fq), q1 = *(const bf16x8*)(qp + 32 + 8 * fq);
        f32x4 st[12];
#pragma unroll
        for (int kt = 0; kt < 12; ++kt) {
            const LAS unsigned char* kp = lds + ATT_KS + (16 * kt + fr) * KS_STRIDE + 16 * fq;
            const bf16x8 a0 = *(const LAS bf16x8*)kp, a1 = *(const LAS bf16x8*)(kp + 64);
            f32x4 a = (f32x4){0.f, 0.f, 0.f, 0.f};
            a = __builtin_amdgcn_mfma_f32_16x16x32_bf16(a0, q0, a, 0, 0, 0);
            a = __builtin_amdgcn_mfma_f32_16x16x32_bf16(a1, q1, a, 0, 0, 0);
            st[kt] = a;
            if ((kt & 3) == 3) asm volatile("" ::: "memory");
        }
        const int ql = 16 * qt + fr;
        float mx = -INFINITY;
#pragma unroll
        for (int kt = 0; kt < 12; ++kt)
#pragma unroll
            for (int jj = 0; jj < 4; ++jj) {
                const int key = 16 * kt + 4 * fq + jj;
                const float dist = fabsf((float)(128 + ql - key));
                float lg = st[kt][jj] * (0.125f * 1.4426950408889634f) - slope * dist;
                lg = (key >= klo && key < khi) ? lg : -INFINITY;
                st[kt][jj] = lg; mx = fmaxf(mx, lg);
            }
        mx = fmaxf(mx, __shfl_xor(mx, 16)); mx = fmaxf(mx, __shfl_xor(mx, 32));
        mx = fmaxf(mx, sink);
        float sum = 0.f;
#pragma unroll
        for (int kt = 0; kt < 12; ++kt)
#pragma unroll
            for (int jj = 0; jj < 4; ++jj) { const float p = __builtin_amdgcn_exp2f(st[kt][jj] - mx); st[kt][jj] = p; sum += p; }
        sum += __shfl_xor(sum, 16); sum += __shfl_xor(sum, 32);
        const float inv = __builtin_amdgcn_rcpf(sum + __builtin_amdgcn_exp2f(sink - mx));
        bf16x8 pb[6];
#pragma unroll
        for (int s = 0; s < 6; ++s) {
            u32x4 w; w.x = pk2(st[2 * s][0] * inv, st[2 * s][1] * inv); w.y = pk2(st[2 * s][2] * inv, st[2 * s][3] * inv);
            w.z = pk2(st[2 * s + 1][0] * inv, st[2 * s + 1][1] * inv); w.w = pk2(st[2 * s + 1][2] * inv, st[2 * s + 1][3] * inv);
            pb[s] = __builtin_bit_cast(bf16x8, w);
        }
#pragma unroll 1
        for (int dt = 0; dt < 4; ++dt) {
            f32x4 o = (f32x4){0.f, 0.f, 0.f, 0.f};
#pragma unroll
            for (int s = 0; s < 6; ++s) {
                const LAS unsigned char* vp = lds + ATT_VT + (16 * dt + fr) * VT_STRIDE + (32 * s + 4 * fq) * 2;
                const u32x2 lo = *(const LAS u32x2*)vp, hi = *(const LAS u32x2*)(vp + 32);
                const u32x4 av = (u32x4){lo.x, lo.y, hi.x, hi.y};
                o = __builtin_amdgcn_mfma_f32_16x16x32_bf16(__builtin_bit_cast(bf16x8, av), pb[s], o, 0, 0, 0);
            }
            u32x2 w; w.x = pk2(o[0], o[1]); w.y = pk2(o[2], o[3]);
            *(u32x2*)(qp + 16 * dt + 4 * fq) = w;
        }
    }
}

constexpr int MX_RS = 0, MX_VNT = 1024, MX_U = 36864, MX_DT = 76800, MX_ST = 272;
__device__ __forceinline__ void mix_item(const Params& P, int layer, int item, LAS unsigned char* lds) {
    const int tid = threadIdx.x, lane = tid & 63, wave = tid >> 6, fr = lane & 15, fq = lane >> 4;
    bf16_t* Z = (bf16_t*)(P.ws + WS_Z);
    const unsigned char* wl = P.ws + WS_W + (size_t)layer * WL_SIZE;
    const bool samp = item >= 256;
    int row0, L, t0, sb = 0;
    if (!samp) { const int b = item >> 6, ch = item & 63; row0 = b * SEQ + ch * 128; L = 128; t0 = ch * 128; }
    else { sb = item - 256; row0 = MP + sb * ST; L = ST; t0 = 0; }
    LAS float* RS = (LAS float*)(lds + MX_RS);
    __syncthreads();
    for (int k = 0; k < 16; ++k) {
        const int i = wave * 16 + k;
        if (i < L) {
            const u32x4 w = *(const u32x4*)(Z + (size_t)(row0 + i) * NIN + ZC_SV + lane * 8);
            float s = bflo(w.x) * bflo(w.x) + bfhi(w.x) * bfhi(w.x) + bflo(w.y) * bflo(w.y) + bfhi(w.y) * bfhi(w.y)
                    + bflo(w.z) * bflo(w.z) + bfhi(w.z) * bfhi(w.z) + bflo(w.w) * bflo(w.w) + bfhi(w.w) * bfhi(w.w);
            s = wave_sum(s);
            if (lane == 0) RS[i] = rsqrtf(s * (1.f / 512.f) + 1e-6f);
        }
    }
    __syncthreads();
    for (int g = 0; g < 4; ++g) {
#pragma unroll
        for (int p = 0; p < 4; ++p) {
            const int idx = tid + NTHREADS * p, j = idx >> 4, c8 = idx & 15;
            float vn[8];
            if (j < L) {
                const u32x4 w = *(const u32x4*)(Z + (size_t)(row0 + j) * NIN + ZC_SV + g * 128 + c8 * 8);
                const float rs = RS[j]; const float* ng = P.sgu_norm_g + layer * 512 + g * 128 + c8 * 8;
                vn[0] = bflo(w.x) * rs * ng[0]; vn[1] = bfhi(w.x) * rs * ng[1]; vn[2] = bflo(w.y) * rs * ng[2]; vn[3] = bfhi(w.y) * rs * ng[3];
                vn[4] = bflo(w.z) * rs * ng[4]; vn[5] = bfhi(w.z) * rs * ng[5]; vn[6] = bflo(w.w) * rs * ng[6]; vn[7] = bfhi(w.w) * rs * ng[7];
                if (samp) { float* dst = P.out + O_SV + ((size_t)((layer * 8 + sb) * ST + j)) * 512 + g * 128 + c8 * 8;
                    *(f32x4*)dst = (f32x4){vn[0], vn[1], vn[2], vn[3]}; *(f32x4*)(dst + 4) = (f32x4){vn[4], vn[5], vn[6], vn[7]}; }
            } else {
#pragma unroll
                for (int e = 0; e < 8; ++e) vn[e] = 0.f;
            }
            LAS bf16_t* vt = (LAS bf16_t*)(lds + MX_VNT + (c8 * 8) * MX_ST + j * 2);
#pragma unroll
            for (int e = 0; e < 8; ++e) vt[e * (MX_ST / 2)] = (bf16_t)f2bf(vn[e]);
        }
        __syncthreads();
        if (wave * 16 < L) {
            const int i = wave * 16 + fr;
            const bf16_t* wrow = (const bf16_t*)(wl + WL_SG) + ((size_t)g * 128 + i) * 128 + 8 * fq;
            bf16x8 wf[4];
#pragma unroll
            for (int ks = 0; ks < 4; ++ks) wf[ks] = *(const bf16x8*)(wrow + 32 * ks);
            const float bias = P.sgu_b[(layer * 4 + g) * 128 + i];
            bf16_t* zrow = Z + (size_t)(row0 + i) * NIN + ZC_SU + g * 128 + 4 * fq;
#pragma unroll
            for (int ct = 0; ct < 8; ++ct) {
                f32x4 a = (f32x4){0.f, 0.f, 0.f, 0.f};
#pragma unroll
                for (int ks = 0; ks < 4; ++ks) {
                    const bf16x8 av = *(const LAS bf16x8*)(lds + MX_VNT + (16 * ct + fr) * MX_ST + (32 * ks + 8 * fq) * 2);
                    a = __builtin_amdgcn_mfma_f32_16x16x32_bf16(av, wf[ks], a, 0, 0, 0);
                }
                const u32x2 uu = *(const u32x2*)(zrow + 16 * ct);
                u32x2 w; w.x = pk2(bflo(uu.x) * (a[0] + bias), bfhi(uu.x) * (a[1] + bias)); w.y = pk2(bflo(uu.y) * (a[2] + bias), bfhi(uu.y) * (a[3] + bias));
                *(u32x2*)(zrow + 16 * ct) = w;
            }
        }
        __syncthreads();
    }
    for (int g = 0; g < 4; ++g) {
        const int wlen = 2 << g;
        for (int idx = tid; idx < (15 + L) * 16; idx += NTHREADS) {
            const int hh = idx >> 4, c8 = idx & 15, rel = hh - 15;
            u32x4 w = (u32x4){0u, 0u, 0u, 0u};
            if (rel >= 0 || (!samp && t0 > 0)) w = *(const u32x4*)(Z + (size_t)(row0 + rel) * NIN + ZC_PU + g * 128 + c8 * 8);
            else if (samp) {
                const float* sp = P.state_pool + ((size_t)(layer * 8 + sb) * 15 + hh) * 512 + g * 128 + c8 * 8;
                const f32x4 a = *(const f32x4*)sp, b = *(const f32x4*)(sp + 4);
                w.x = pk2(a[0], a[1]); w.y = pk2(a[2], a[3]); w.z = pk2(b[0], b[1]); w.w = pk2(b[2], b[3]);
            }
            *(LAS u32x4*)(lds + MX_U + hh * MX_ST + c8 * 16) = w;
        }
        __syncthreads();
        for (int idx = tid; idx < L * 16; idx += NTHREADS) {
            const int i = idx >> 4, c8 = idx & 15;
            float s[8];
#pragma unroll
            for (int e = 0; e < 8; ++e) s[e] = 0.f;
            for (int k = 0; k < wlen; ++k) {
                const u32x4 w = *(const LAS u32x4*)(lds + MX_U + (15 + i - k) * MX_ST + c8 * 16);
                s[0] += bflo(w.x); s[1] += bfhi(w.x); s[2] += bflo(w.y); s[3] += bfhi(w.y); s[4] += bflo(w.z); s[5] += bfhi(w.z); s[6] += bflo(w.w); s[7] += bfhi(w.w);
            }
            const u32x4 w = *(const LAS u32x4*)(lds + MX_U + (15 + i) * MX_ST + c8 * 16);
            const int pos1 = samp ? (1024 + i + 1) : (t0 + i + 1);
            const float rc = 1.0f / (float)(pos1 < wlen ? pos1 : wlen);
            u32x4 o;
            o.x = pk2(s[0] * rc - bflo(w.x), s[1] * rc - bfhi(w.x)); o.y = pk2(s[2] * rc - bflo(w.y), s[3] * rc - bfhi(w.y));
            o.z = pk2(s[4] * rc - bflo(w.z), s[5] * rc - bfhi(w.z)); o.w = pk2(s[6] * rc - bflo(w.w), s[7] * rc - bfhi(w.w));
            *(LAS u32x4*)(lds + MX_DT + i * MX_ST + c8 * 16) = o;
        }
        __syncthreads();
        if (wave * 16 < L) {
            const int i = wave * 16 + fr;
            bf16x8 df[4];
#pragma unroll
            for (int ks = 0; ks < 4; ++ks) df[ks] = *(const LAS bf16x8*)(lds + MX_DT + i * MX_ST + (32 * ks + 8 * fq) * 2);
            const bf16_t* pw = (const bf16_t*)(wl + WL_PW) + (size_t)g * 128 * 128;
            bf16_t* zrow = Z + (size_t)(row0 + i) * NIN + ZC_SV + g * 128 + 4 * fq;
            const float* psc = P.pool_scale + layer * 512 + g * 128 + 4 * fq;
#pragma unroll
            for (int nt = 0; nt < 8; ++nt) {
                f32x4 a = (f32x4){0.f, 0.f, 0.f, 0.f};
#pragma unroll
                for (int ks = 0; ks < 4; ++ks) {
                    const bf16x8 wv = *(const bf16x8*)(pw + (size_t)(16 * nt + fr) * 128 + 32 * ks + 8 * fq);
                    a = __builtin_amdgcn_mfma_f32_16x16x32_bf16(wv, df[ks], a, 0, 0, 0);
                }
                const f32x4 sc = *(const f32x4*)(psc + 16 * nt);
                u32x2 w; w.x = pk2(a[0] * sc[0], a[1] * sc[1]); w.y = pk2(a[2] * sc[2], a[3] * sc[3]);
                *(u32x2*)(zrow + 16 * nt) = w;
            }
        }
        __syncthreads();
    }
}

__device__ __forceinline__ void phase_mixers(const Params& P, int layer, LAS unsigned char* lds) {
    for (int it = blockIdx.x; it < 1304; it += gridDim.x) {
        if (it < 256) mix_item(P, layer, it, lds);
        else if (it < 1280) attn_item(P, layer, it - 256, lds);
        else if (it < 1296) attn_item(P, layer, 1024 + (it - 1280), lds);
        else mix_item(P, layer, 256 + (it - 1296), lds);
    }
}

__device__ __forceinline__ void phase_conv(const Params& P, int layer) {
    bf16_t* AB = (bf16_t*)(P.ws + WS_Z);
    const int gt = blockIdx.x * NTHREADS + threadIdx.x, NGT = gridDim.x * NTHREADS;
    const float* cw = P.ffn_conv_w + (size_t)layer * 3 * DFF; const float* cb = P.ffn_conv_b + (size_t)layer * DFF;
    for (int idx = gt; idx < M * (DFF / 8); idx += NGT) {
        const int r = idx / (DFF / 8), f = (idx - r * (DFF / 8)) * 8;
        int t, sb = 0; const bool samp = r >= MP;
        if (!samp) t = r & 8191; else { t = (r - MP) & 31; sb = (r - MP) >> 5; }
        float a0[8], a1[8], a2[8];
        { const u32x4 w = *(const u32x4*)(AB + (size_t)r * NUP + f);
          a0[0] = bflo(w.x); a0[1] = bfhi(w.x); a0[2] = bflo(w.y); a0[3] = bfhi(w.y); a0[4] = bflo(w.z); a0[5] = bfhi(w.z); a0[6] = bflo(w.w); a0[7] = bfhi(w.w); }
        const float* pf = P.state_conv + ((size_t)(layer * 8 + sb) * 2) * DFF + f;
        if (t >= 1) { const u32x4 w = *(const u32x4*)(AB + (size_t)(r - 1) * NUP + f);
          a1[0] = bflo(w.x); a1[1] = bfhi(w.x); a1[2] = bflo(w.y); a1[3] = bfhi(w.y); a1[4] = bflo(w.z); a1[5] = bfhi(w.z); a1[6] = bflo(w.w); a1[7] = bfhi(w.w); }
        else {
#pragma unroll
            for (int e = 0; e < 8; ++e) a1[e] = samp ? pf[DFF + e] : 0.f; }
        if (t >= 2) { const u32x4 w = *(const u32x4*)(AB + (size_t)(r - 2) * NUP + f);
          a2[0] = bflo(w.x); a2[1] = bfhi(w.x); a2[2] = bflo(w.y); a2[3] = bfhi(w.y); a2[4] = bflo(w.z); a2[5] = bfhi(w.z); a2[6] = bflo(w.w); a2[7] = bfhi(w.w); }
        else {
#pragma unroll
            for (int e = 0; e < 8; ++e) a2[e] = samp ? pf[(t == 1 ? DFF : 0) + e] : 0.f; }
        const u32x4 bw = *(const u32x4*)(AB + (size_t)r * NUP + DFF + f);
        float bb[8] = {bflo(bw.x), bfhi(bw.x), bflo(bw.y), bfhi(bw.y), bflo(bw.z), bfhi(bw.z), bflo(bw.w), bfhi(bw.w)};
        float go[8];
#pragma unroll
        for (int e = 0; e < 8; ++e) {
            const float cv = a2[e] * cw[f + e] + a1[e] * cw[DFF + f + e] + a0[e] * cw[2 * DFF + f + e] + cb[f + e];
            go[e] = gelu_tanh(cv) * bb[e];
        }
        u32x4 o; o.x = pk2(go[0], go[1]); o.y = pk2(go[2], go[3]); o.z = pk2(go[4], go[5]); o.w = pk2(go[6], go[7]);
        *(u32x4*)(AB + (size_t)r * NUP + DFF + f) = o;
    }
}

constexpr int NPHASES = 20;
#define RUN(k) (lo <= (k) && (k) < hi)
#define SYNC(k) do { if ((k) + 1 < hi) grid.sync(); } while (0)
template <int l>
__device__ __forceinline__ void layer_phases(const Params& P, LAS unsigned char* lds, cg::grid_group& grid) {
    const int lo = P.ph_lo, hi = P.ph_hi;
    const int G = gridDim.x, c = blockIdx.x;
    unsigned char* ws = P.ws;
    const float* MOD = (const float*)(ws + WS_MOD);
    bf16_t* H = (bf16_t*)(ws + WS_H);
    bf16_t* Z = (bf16_t*)(ws + WS_Z);
    constexpr int pb = 1 + 9 * l;
    const unsigned char* wl = ws + WS_W + (size_t)l * WL_SIZE;
    const float* modl = MOD + (size_t)l * 12 * 6144;
    const float* srcp = l == 0 ? P.x_prompt : P.out + O_YP;
    const float* srcs = l == 0 ? P.x_sample : P.out + O_YS;
    if (RUN(pb + 0)) { phase_norm(P, srcp, srcs, P.norm1_g + l * D, modl + 0 * D, modl + 1 * D); SYNC(pb + 0); }
    if (RUN(pb + 1)) {
        pg8::SimpleOrder S{(const char*)H, (const char*)(wl + WL_IN), (size_t)D * 2, (size_t)D * 2, M / 256, NIN / 256, D / 64, G, c};
        EpiZ E{Z, P.out, l};
        pg8::gemm_phase<EpiZ, pg8::SimpleOrder>(lds, (size_t)D * 2, (size_t)D * 2, S, E);
        SYNC(pb + 1);
    }
    if (l == 0 && PROBE == 1) {
        pg8::SimpleOrder S{(const char*)H, (const char*)(wl + WL_IN), (size_t)D * 2, (size_t)D * 2, M / 256, NIN / 256, D / 64, G, c};
        EpiZ E{Z, P.out, l};
        pg8::gemm_phase<EpiZ, pg8::SimpleOrder>(lds, (size_t)D * 2, (size_t)D * 2, S, E);
        grid.sync();
    }
    if (RUN(pb + 2)) { phase_mixers(P, l, lds); SYNC(pb + 2); }
    if (l == 0 && PROBE == 2) {
        pg8::SimpleOrder S{(const char*)H, (const char*)(wl + WL_IN), (size_t)D * 2, (size_t)D * 2, M / 256, NIN / 256, D / 64, G, c};
        EpiZ E{Z, P.out, l};
        pg8::gemm_phase<EpiZ, pg8::SimpleOrder>(lds, (size_t)D * 2, (size_t)D * 2, S, E);
        grid.sync();
        phase_mixers(P, l, lds);
        grid.sync();
    }
    if (RUN(pb + 3)) {
        pg8::MergeOrder S{(const char*)Z, (const char*)(wl + WL_CAT), (size_t)NIN * 2, (size_t)2048 * 2, M / 256, D / 256, G, c};
        EpiMerge E{Z, H};
        pg8::gemm_phase<EpiMerge, pg8::MergeOrder>(lds, (size_t)NIN * 2, (size_t)2048 * 2, S, E);
        SYNC(pb + 3);
    }
    if (RUN(pb + 4)) {
        pg8::SimpleOrder S{(const char*)H, (const char*)(wl + WL_OUT), (size_t)D * 2, (size_t)D * 2, M / 256, D / 256, D / 64, G, c};
        EpiRes E{srcp, srcs, P.out, modl + 2 * D};
        pg8::gemm_phase<EpiRes, pg8::SimpleOrder>(lds, (size_t)D * 2, (size_t)D * 2, S, E);
        SYNC(pb + 4);
    }
    if (RUN(pb + 5)) { phase_norm(P, P.out + O_YP, P.out + O_YS, P.norm2_g + l * D, modl + 3 * D, modl + 4 * D); SYNC(pb + 5); }
    if (RUN(pb + 6)) {
        pg8::UpOrder S{(const char*)H, (const char*)(wl + WL_UP), (size_t)D * 2, (size_t)D * 2, (M + 253) / 254, NUP / 256, D / 64, G, c};
        EpiUpConv E{Z, P.out, P.ffn_conv_w + (size_t)l * 3 * DFF, P.ffn_conv_b + (size_t)l * DFF, P.state_conv + (size_t)l * 8 * 2 * DFF, l, lds};
        pg8::gemm_phase<EpiUpConv, pg8::UpOrder>(lds, (size_t)D * 2, (size_t)D * 2, S, E);
        SYNC(pb + 6);
    }
    if (RUN(pb + 8)) {
        pg8::SimpleOrder S{(const char*)Z, (const char*)(wl + WL_DN), (size_t)DFF * 2, (size_t)DFF * 2, M / 256, D / 256, DFF / 64, G, c};
        EpiRes E{P.out + O_YP, P.out + O_YS, P.out, modl + 5 * D};
        pg8::gemm_phase<EpiRes, pg8::SimpleOrder>(lds, (size_t)DFF * 2, (size_t)DFF * 2, S, E);
        SYNC(pb + 8);
    }
}
__global__ void __launch_bounds__(NTHREADS) mk_fwd(Params P) {
    extern __shared__ __attribute__((aligned(16))) unsigned char lds_raw[];
    LAS unsigned char* lds = (LAS unsigned char*)lds_raw;
    cg::grid_group grid = cg::this_grid();
    const int lo = P.ph_lo, hi = P.ph_hi;
    if (RUN(0)) { phase_p0(P, lds); SYNC(0); }
    if (PROBE == 4) { phase_p0(P, lds); grid.sync(); phase_norm(P, P.x_prompt, P.x_sample, P.norm1_g, (const float*)(P.ws + WS_MOD), (const float*)(P.ws + WS_MOD) + D); grid.sync(); }
    if (PROBE == 5) { for (int i = 0; i < 20; ++i) grid.sync(); }
    layer_phases<0>(P, lds, grid);
    layer_phases<1>(P, lds, grid);
    if (RUN(19)) phase_final(P);
}
#undef RUN
#undef SYNC

extern "C" void kernel_launch(void* const* d_in, const int* in_sizes, int n_in, void* d_out, int out_size, void* d_ws, size_t ws_size, hipStream_t stream) {
    static int grid = 0;
    if (grid == 0) {
        if (n_in != 28 || ws_size < WS_END) { fprintf(stderr, "kernel_launch: need 28 inputs and %zu B of workspace (got %d, %zu)\n", (size_t)WS_END, n_in, ws_size); grid = -1; return; }
        int dev = 0, cus = 0, per_cu = 0;
        hipGetDevice(&dev);
        hipDeviceGetAttribute(&cus, hipDeviceAttributeMultiprocessorCount, dev);
        if (hipFuncSetAttribute((const void*)mk_fwd, hipFuncAttributeMaxDynamicSharedMemorySize, LDS_BYTES) != hipSuccess) { fprintf(stderr, "kernel_launch: hipFuncSetAttribute failed\n"); grid = -1; return; }
        if (hipOccupancyMaxActiveBlocksPerMultiprocessor(&per_cu, (const void*)mk_fwd, NTHREADS, LDS_BYTES) != hipSuccess || per_cu < 1) { fprintf(stderr, "kernel_launch: occupancy query failed (%d)\n", per_cu); per_cu = 1; }
        (void)hipGetLastError();
        grid = cus * per_cu;
    }
    if (grid < 0) return;
    Params p{};
    const float** ip = (const float**)&p;
    for (int i = 0; i < 28; ++i) ip[i] = (const float*)d_in[i];
    p.out = (float*)d_out; p.ws = (unsigned char*)d_ws;
#if MULTI_LAUNCH
    for (int ph = 0; ph < NPHASES; ++ph) {
        p.ph_lo = ph; p.ph_hi = ph + 1;
        hipLaunchKernelGGL(mk_fwd, dim3(grid), dim3(NTHREADS), LDS_BYTES, stream, p);
    }
#else
    p.ph_lo = 0; p.ph_hi = NPHASES;
    void* args[] = {&p};
    hipError_t e = hipLaunchCooperativeKernel((const void*)mk_fwd, dim3(grid), dim3(NTHREADS), args, LDS_BYTES, stream);
    if (e != hipSuccess) fprintf(stderr, "cooperative launch failed: %s (grid %d)\n", hipGetErrorString(e), grid);
#endif
}
```

```cpp
#include <hip/hip_runtime.h>
#include <hip/hip_cooperative_groups.h>
#include <cstdio>
namespace cg = cooperative_groups;

#ifndef MULTI_LAUNCH
#define MULTI_LAUNCH 0
#endif

#ifndef PROBE
#define PROBE 0
#endif
#define LAS __attribute__((address_space(3)))
typedef unsigned short bf16_t;
typedef short bf16x8 __attribute__((ext_vector_type(8)));
typedef float f32x4 __attribute__((ext_vector_type(4)));
typedef unsigned u32x4 __attribute__((ext_vector_type(4)));
typedef unsigned u32x2 __attribute__((ext_vector_type(2)));

constexpr int D = 1024, SEQ = 8192, NBP = 4, NBS = 8, ST = 32;
constexpr int MP = NBP * SEQ;
constexpr int MS = NBS * ST;
constexpr int M = MP + MS;
constexpr int NIN = 5888, DFF = 2816, NUP = 5632;
constexpr int NTHREADS = 512, NWAVES = 8;
constexpr int ZC_Q = 0, ZC_K = 1024, ZC_V = 1152, ZC_PU = 1280, ZC_SU = 1792, ZC_SV = 2304, ZC_G = 2816;
constexpr size_t O_YP = 0;
constexpr size_t O_YS = O_YP + (size_t)MP * D;
constexpr size_t O_KP = O_YS + (size_t)MS * D;
constexpr size_t O_VP = O_KP + 2 * 4 * 128 * 128;
constexpr size_t O_PP = O_VP + 2 * 4 * 128 * 128;
constexpr size_t O_CP = O_PP + 2 * 4 * 15 * 512;
constexpr size_t O_KS = O_CP + 2 * 4 * 2 * DFF;
constexpr size_t O_VS = O_KS + 2 * 8 * 128 * 128;
constexpr size_t O_PS = O_VS + 2 * 8 * 128 * 128;
constexpr size_t O_CS = O_PS + 2 * 8 * 15 * 512;
constexpr size_t O_SV = O_CS + 2 * 8 * 2 * DFF;
constexpr size_t WS_MOD = 4096;
constexpr size_t WS_BAR = 655360;
constexpr size_t WS_W = 1048576;
constexpr size_t WL_IN = 0;
constexpr size_t WL_CAT = WL_IN + (size_t)NIN * D * 2;
constexpr size_t WL_OUT = WL_CAT + (size_t)D * 2048 * 2;
constexpr size_t WL_UP = WL_OUT + (size_t)D * D * 2;
constexpr size_t WL_DN = WL_UP + (size_t)NUP * D * 2;
constexpr size_t WL_PW = WL_DN + (size_t)D * DFF * 2;
constexpr size_t WL_SG = WL_PW + 4 * 128 * 128 * 2;
constexpr size_t WL_SIZE = WL_SG + 4 * 128 * 128 * 2;
constexpr size_t WS_H = WS_W + 2 * WL_SIZE;
constexpr size_t WS_Z = WS_H + (size_t)M * D * 2;
constexpr size_t WS_END = WS_Z + (size_t)M * NIN * 2;
constexpr int LDS_BYTES = 131072 + 8192;

struct Params {
    const float *x_prompt, *x_sample, *c_prompt, *c_sample, *cache_k, *cache_v, *state_pool, *state_conv;
    const float *norm1_g, *norm2_g, *w_ada, *b_ada, *w_in, *attn_sink, *w_o_attn, *pool_w, *pool_scale, *w_o_pool;
    const float *sgu_norm_g, *sgu_w, *sgu_b, *w_o_sgu, *w_out, *ffn_w_up, *ffn_conv_w, *ffn_conv_b, *ffn_w_down, *final_norm_g;
    float* out; unsigned char* ws;
    int ph_lo, ph_hi;
};

typedef __bf16 bf16x2_t __attribute__((ext_vector_type(2)));
typedef float f32x2_t __attribute__((ext_vector_type(2)));
__device__ __forceinline__ unsigned pk2(float lo, float hi) { const f32x2_t v = {lo, hi}; return __builtin_bit_cast(unsigned, __builtin_convertvector(v, bf16x2_t)); }
__device__ __forceinline__ unsigned f2bf(float f) { return pk2(f, 0.f) & 0xffffu; }
__device__ __forceinline__ float bflo(unsigned w) { return __builtin_bit_cast(float, w << 16); }
__device__ __forceinline__ float bfhi(unsigned w) { return __builtin_bit_cast(float, w & 0xffff0000u); }
__device__ __forceinline__ float bf1(bf16_t h) { return __builtin_bit_cast(float, ((unsigned)h) << 16); }
__device__ __forceinline__ float sigmoidf_(float x) { return __builtin_amdgcn_rcpf(1.0f + __builtin_amdgcn_exp2f(-1.4426950408889634f * x)); }
__device__ __forceinline__ float gelu_tanh(float x) { const float e = __builtin_amdgcn_exp2f(x * (-2.3022081985f - 0.1029432347f * x * x)); return x * __builtin_amdgcn_rcpf(1.0f + e); }
__device__ __forceinline__ float wave_sum(float v) {
#pragma unroll
    for (int o = 1; o < 64; o <<= 1) v += __shfl_xor(v, o);
    return v;
}
__device__ __forceinline__ int batch_of_row(int row) { return row < MP ? (row >> 13) : 4 + ((row - MP) >> 5); }

namespace pg8 {
constexpr int BM = 256, BK = 64, HALF = 128, HTB = HALF * BK * 2, NXCD = 8, WGM = 8;
__device__ __forceinline__ int lds_byte(int r, int c) { const int st = (r >> 4) * 2 + (c >> 5), rr = r & 15, cc = c & 31, ob = rr * 64 + cc * 2; return st * 1024 + (ob ^ (((ob >> 9) & 1) << 5)); }
__device__ __forceinline__ void stage_rc(int b, int& R, int& C) { const int st = b / 1024, sb = b % 1024, swz = sb ^ (((sb >> 9) & 1) << 5); R = (st >> 1) * 16 + swz / 64; C = (st & 1) * 32 + (swz % 64) / 2; }
__device__ __forceinline__ int perm32(int rho) { const int n = rho >> 4, i = rho & 15; return 8 * (i >> 2) + 4 * n + (i & 3); }

struct Unit { const char* A; const char* B; int nt, pm, pn, mode; };

__device__ __forceinline__ void tile_of(int wgid, int nM, int nN, int& pm, int& pn) {
    const int nwg = nM * nN;
    { const int q = nwg / NXCD, r = nwg % NXCD, xcd = wgid % NXCD, off = wgid / NXCD; wgid = (xcd < r ? xcd * (q + 1) : r * (q + 1) + (xcd - r) * q) + off; }
    const int nig = WGM * nN, gid = wgid / nig, fm = gid * WGM, gsz = (nM - fm) < WGM ? (nM - fm) : WGM;
    pm = fm + ((wgid % nig) % gsz); pn = (wgid % nig) / gsz;
}

struct SimpleOrder {
    const char* A; const char* B; size_t lda, ldb; int nM, nN, nt, G, c;
    __device__ __forceinline__ bool next(int i, Unit& u) const {
        const long L = (long)i * G + c; if (L >= (long)nM * nN) return false;
        int pm, pn; tile_of((int)L, nM, nN, pm, pn);
        u.pm = pm; u.pn = pn; u.nt = nt; u.mode = 0; u.A = A + (size_t)pm * 256 * lda; u.B = B + (size_t)pn * 256 * ldb; return true;
    }
};
struct MergeOrder {
    const char* A; const char* B; size_t lda, ldb; int nM, nN, G, c;
    __device__ __forceinline__ bool next(int i, Unit& u) const {
        const int ti = i / 3, br = i - ti * 3;
        const long L = (long)ti * G + c; if (L >= (long)nM * nN) return false;
        int pm, pn; tile_of((int)L, nM, nN, pm, pn);
        u.pm = pm; u.pn = pn; u.mode = br;
        const int ak = br == 0 ? ZC_Q : (br == 1 ? ZC_SV : ZC_SU);
        const int bk = br == 0 ? 0 : (br == 1 ? 1024 : 1536);
        u.nt = br == 0 ? 16 : 8;
        u.A = A + (size_t)pm * 256 * lda + (size_t)ak * 2; u.B = B + (size_t)pn * 256 * ldb + (size_t)bk * 2; return true;
    }
};

struct UpOrder {
    const char* A; const char* B; size_t lda, ldb; int nM, nN, nt, G, c;
    __device__ __forceinline__ bool next(int i, Unit& u) const {
        const long L = (long)i * G + c; if (L >= (long)nM * nN) return false;
        int pm, pn; tile_of((int)L, nM, nN, pm, pn);
        u.pm = pm; u.pn = pn; u.nt = nt; u.mode = 0; u.A = A + ((long)pm * 254 - 2) * (long)lda; u.B = B + (size_t)pn * 256 * ldb; return true;
    }
};

template <class Epi, class Sched>
__device__ __forceinline__ void gemm_phase(LAS unsigned char* lds, const size_t lda, const size_t ldb, const Sched& S, const Epi& E) {
    int tid_ = threadIdx.x; asm volatile("" : "+v"(tid_));
    const int tid = tid_, wid = __builtin_amdgcn_readfirstlane(tid >> 6), lane = tid & 63, wr = wid >> 2, wc = wid & 3, fr = lane & 15, fq = lane >> 4;
    unsigned voffA[2], voffB[2];
#pragma unroll
    for (int i = 0; i < 2; ++i) { int R, C; stage_rc(tid * 16 + i * 8192, R, C); const int Rb = Epi::PERM ? ((R & ~31) + perm32(R & 31)) : R;
        voffA[i] = (unsigned)(R * lda + C * 2); voffB[i] = (unsigned)(Rb * ldb + C * 2); }
    const size_t kstep = (size_t)(BK * 2);
    const size_t hstepA = (size_t)HALF * lda, hstepB = (size_t)HALF * ldb;
    const unsigned ldsw = (unsigned)wid * 1024u;
    const int aoff = lds_byte(wr * 64 + fr, fq * 8), boff = lds_byte(wc * 32 + fr, fq * 8);
#define PG8_SA(b, h) (((b) * 2 + (h)) * HTB)
#define PG8_SB(b, h) ((4 + (b) * 2 + (h)) * HTB)
#define PG8_STAGE(bufoff, gbase, voff) do { _Pragma("unroll") for (int _i = 0; _i < 2; ++_i) \
        __builtin_amdgcn_global_load_lds((const unsigned*)((const char*)(gbase) + (voff)[_i]), (LAS unsigned*)(lds + (bufoff) + ldsw + _i * 8192), 16, 0, 0); } while (0)
#define PG8_LDA(dst, b, h) do { _Pragma("unroll") for (int m = 0; m < 4; ++m) _Pragma("unroll") for (int k = 0; k < 2; ++k) dst[m][k] = *(const LAS bf16x8*)(lds + PG8_SA(b, h) + aoff + m * 2048 + k * 1024); } while (0)
#define PG8_LDB(dst, b, h) do { _Pragma("unroll") for (int n = 0; n < 2; ++n) _Pragma("unroll") for (int k = 0; k < 2; ++k) dst[n][k] = *(const LAS bf16x8*)(lds + PG8_SB(b, h) + boff + n * 2048 + k * 1024); } while (0)
#define PG8_MMA(ai, bj, At, Bt) do { __builtin_amdgcn_s_setprio(1); _Pragma("unroll") for (int m = 0; m < 4; ++m) _Pragma("unroll") for (int n = 0; n < 2; ++n) _Pragma("unroll") for (int k = 0; k < 2; ++k) \
        acc[ai][bj][m][n] = __builtin_amdgcn_mfma_f32_16x16x32_bf16(Bt[n][k], At[m][k], acc[ai][bj][m][n], 0, 0, 0); __builtin_amdgcn_s_setprio(0); } while (0)
#define PG8_WAIT_V(n) asm volatile("s_waitcnt vmcnt(" #n ")" ::: "memory")
#define PG8_WAIT_L(n) asm volatile("s_waitcnt lgkmcnt(" #n ")" ::: "memory")
#define PG8_BAR __builtin_amdgcn_s_barrier()
#define PG8_SCHED __builtin_amdgcn_sched_barrier(0)
    Unit cur, nxt; int ui = 0;
    if (!S.next(0, cur)) return;
    f32x4 acc[2][2][4][2];
#pragma unroll
    for (int a = 0; a < 2; ++a)
#pragma unroll
        for (int b = 0; b < 2; ++b)
#pragma unroll
            for (int m = 0; m < 4; ++m)
#pragma unroll
                for (int n = 0; n < 2; ++n) acc[a][b][m][n] = (f32x4){0.f, 0.f, 0.f, 0.f};
    bf16x8 At[4][2], B0[2][2], B1[2][2];
    const char* cA = cur.A; const char* cB = cur.B;
    PG8_STAGE(PG8_SB(0, 0), cB, voffB); PG8_STAGE(PG8_SA(0, 0), cA, voffA); PG8_STAGE(PG8_SB(0, 1), cB + hstepB, voffB); PG8_STAGE(PG8_SA(0, 1), cA + hstepA, voffA);
    if (wr == 1) PG8_BAR;
    PG8_WAIT_V(4); PG8_BAR;
    PG8_STAGE(PG8_SB(1, 0), cB + kstep, voffB); PG8_STAGE(PG8_SA(1, 0), cA + kstep, voffA); PG8_STAGE(PG8_SB(1, 1), cB + hstepB + kstep, voffB);
    PG8_WAIT_V(6); PG8_BAR;
    for (;;) {
        const bool has_next = S.next(ui + 1, nxt);
        const char* nA = has_next ? nxt.A : cA; const char* nB = has_next ? nxt.B : cB;
        const int nt = cur.nt;
        for (int t = 0; t < nt; t += 2) {
            const bool last = (t == nt - 2);
            const char* a1 = cA + (size_t)(t + 1) * kstep;
            const char* a2 = last ? nA : cA + (size_t)(t + 2) * kstep; const char* b2 = last ? nB : cB + (size_t)(t + 2) * kstep;
            const char* a3 = a2 + kstep; const char* b3 = b2 + kstep;
            PG8_LDB(B0, 0, 0); PG8_SCHED; PG8_LDA(At, 0, 0); PG8_STAGE(PG8_SA(1, 1), a1 + hstepA, voffA);
            PG8_WAIT_L(8); PG8_BAR; PG8_WAIT_L(0); PG8_MMA(0, 0, At, B0); PG8_BAR; PG8_SCHED;
            PG8_LDB(B1, 0, 1); PG8_STAGE(PG8_SB(0, 0), b2, voffB);
            PG8_BAR; PG8_WAIT_L(0); PG8_MMA(0, 1, At, B1); PG8_BAR;
            PG8_LDA(At, 0, 1); PG8_STAGE(PG8_SA(0, 0), a2, voffA);
            PG8_BAR; PG8_WAIT_L(0); PG8_MMA(1, 0, At, B0); PG8_BAR; PG8_SCHED;
            PG8_STAGE(PG8_SB(0, 1), b2 + hstepB, voffB);
            PG8_WAIT_V(6); PG8_BAR; PG8_MMA(1, 1, At, B1); PG8_BAR;
            PG8_LDB(B0, 1, 0); PG8_SCHED; PG8_LDA(At, 1, 0); PG8_STAGE(PG8_SA(0, 1), a2 + hstepA, voffA);
            PG8_WAIT_L(8); PG8_BAR; PG8_WAIT_L(0); PG8_MMA(0, 0, At, B0); PG8_BAR; PG8_SCHED;
            PG8_LDB(B1, 1, 1); PG8_STAGE(PG8_SB(1, 0), b3, voffB);
            PG8_BAR; PG8_WAIT_L(0); PG8_MMA(0, 1, At, B1); PG8_BAR;
            PG8_LDA(At, 1, 1); PG8_STAGE(PG8_SA(1, 0), a3, voffA);
            PG8_BAR; PG8_WAIT_L(0); PG8_MMA(1, 0, At, B0); PG8_BAR; PG8_SCHED;
            PG8_STAGE(PG8_SB(1, 1), b3 + hstepB, voffB);
            PG8_WAIT_V(6); PG8_BAR; PG8_MMA(1, 1, At, B1); PG8_BAR;
        }
        if (wr == 0) PG8_BAR;
        E(acc, cur, wr, wc, fr, fq);
        if (!has_next) break;
#pragma unroll
        for (int a = 0; a < 2; ++a)
#pragma unroll
            for (int b = 0; b < 2; ++b)
#pragma unroll
                for (int m = 0; m < 4; ++m)
#pragma unroll
                    for (int n = 0; n < 2; ++n) acc[a][b][m][n] = (f32x4){0.f, 0.f, 0.f, 0.f};
        cur = nxt; cA = nA; cB = nB; ++ui;
        if (wr == 1) PG8_BAR;
    }
    PG8_WAIT_V(0);
    PG8_BAR;
#undef PG8_SA
#undef PG8_SB
#undef PG8_STAGE
#undef PG8_LDA
#undef PG8_LDB
#undef PG8_MMA
#undef PG8_WAIT_V
#undef PG8_WAIT_L
#undef PG8_BAR
#undef PG8_SCHED
}
}

struct EpiZ {
    static constexpr bool PERM = true;
    bf16_t* Z; float* out; int layer;
    __device__ __forceinline__ void operator()(const f32x4 (&acc)[2][2][4][2], const pg8::Unit& u, int wr, int wc, int fr, int fq) const {
        const int pn = u.pn;
#pragma unroll
        for (int ai = 0; ai < 2; ++ai)
#pragma unroll
            for (int m = 0; m < 4; ++m) {
                const int row = u.pm * 256 + ai * 128 + wr * 64 + m * 16 + fr;
                int b, t; const bool samp = row >= MP;
                if (!samp) { b = row >> 13; t = row & 8191; } else { b = (row - MP) >> 5; t = (row - MP) & 31; }
#pragma unroll
                for (int bj = 0; bj < 2; ++bj) {
                    const int col0 = pn * 256 + bj * 128 + wc * 32 + 8 * fq;
                    f32x4 v0 = acc[ai][bj][m][0], v1 = acc[ai][bj][m][1];
                    if (pn == 4) {
                        const int cc = col0 - ZC_K; float* dst = nullptr;
                        if (!samp) { if (t >= SEQ - 128) dst = out + (cc < 128 ? O_KP : O_VP) + ((size_t)((layer * 4 + b) * 128 + (t - (SEQ - 128))) * 128 + (cc & 127)); }
                        else dst = out + (cc < 128 ? O_KS : O_VS) + ((size_t)((layer * 8 + b) * 128 + 96 + t) * 128 + (cc & 127));
                        if (dst) { *(f32x4*)dst = v0; *(f32x4*)(dst + 4) = v1; }
                    } else if (pn == 5 || pn == 6) {
                        const int cc = col0 - ZC_PU; float* dst = nullptr;
                        if (!samp) { if (t >= SEQ - 15) dst = out + O_PP + ((size_t)((layer * 4 + b) * 15 + (t - (SEQ - 15))) * 512 + cc); }
                        else { if (t >= ST - 15) dst = out + O_PS + ((size_t)((layer * 8 + b) * 15 + (t - (ST - 15))) * 512 + cc); }
                        if (dst) { *(f32x4*)dst = v0; *(f32x4*)(dst + 4) = v1; }
                    }
                    if (pn >= 11) {
#pragma unroll
                        for (int j = 0; j < 4; ++j) { v0[j] = sigmoidf_(v0[j]); v1[j] = sigmoidf_(v1[j]); }
                    } else if (pn >= 7) {
#pragma unroll
                        for (int j = 0; j < 4; ++j) { v0[j] = gelu_tanh(v0[j]); v1[j] = gelu_tanh(v1[j]); }
                    }
                    u32x4 w; w.x = pk2(v0[0], v0[1]); w.y = pk2(v0[2], v0[3]); w.z = pk2(v1[0], v1[1]); w.w = pk2(v1[2], v1[3]);
                    *(u32x4*)(Z + (size_t)row * NIN + col0) = w;
                }
            }
    }
};
struct EpiMerge {
    static constexpr bool PERM = true;
    const bf16_t* Z; bf16_t* MG;
    __device__ __forceinline__ void operator()(const f32x4 (&acc)[2][2][4][2], const pg8::Unit& u, int wr, int wc, int fr, int fq) const {
        const int mode = u.mode;
#pragma unroll
        for (int ai = 0; ai < 2; ++ai)
#pragma unroll
            for (int m = 0; m < 4; ++m) {
                const int row = u.pm * 256 + ai * 128 + wr * 64 + m * 16 + fr;
#pragma unroll
                for (int bj = 0; bj < 2; ++bj) {
                    const int col0 = u.pn * 256 + bj * 128 + wc * 32 + 8 * fq;
                    const u32x4 g = *(const u32x4*)(Z + (size_t)row * NIN + ZC_G + mode * 1024 + col0);
                    f32x4 v0 = acc[ai][bj][m][0], v1 = acc[ai][bj][m][1];
                    v0[0] *= bflo(g.x); v0[1] *= bfhi(g.x); v0[2] *= bflo(g.y); v0[3] *= bfhi(g.y);
                    v1[0] *= bflo(g.z); v1[1] *= bfhi(g.z); v1[2] *= bflo(g.w); v1[3] *= bfhi(g.w);
                    bf16_t* mp = MG + (size_t)row * D + col0;
                    if (mode != 0) { const u32x4 o = *(const u32x4*)mp;
                        v0[0] += bflo(o.x); v0[1] += bfhi(o.x); v0[2] += bflo(o.y); v0[3] += bfhi(o.y);
                        v1[0] += bflo(o.z); v1[1] += bfhi(o.z); v1[2] += bflo(o.w); v1[3] += bfhi(o.w); }
                    u32x4 w; w.x = pk2(v0[0], v0[1]); w.y = pk2(v0[2], v0[3]); w.z = pk2(v1[0], v1[1]); w.w = pk2(v1[2], v1[3]);
                    *(u32x4*)mp = w;
                }
            }
    }
};
struct EpiRes {
    static constexpr bool PERM = false;
    const float* srcp; const float* srcs; float* X; const float* gmod;
    __device__ __forceinline__ void operator()(const f32x4 (&acc)[2][2][4][2], const pg8::Unit& u, int wr, int wc, int fr, int fq) const {
#pragma unroll
        for (int ai = 0; ai < 2; ++ai)
#pragma unroll
            for (int m = 0; m < 4; ++m) {
                const int row = u.pm * 256 + ai * 128 + wr * 64 + m * 16 + fr;
                const float* sp = row < MP ? srcp + (size_t)row * D : srcs + (size_t)(row - MP) * D;
                const float* gp = gmod + (size_t)batch_of_row(row) * 6144;
                float* xp = X + (size_t)row * D;
#pragma unroll
                for (int bj = 0; bj < 2; ++bj)
#pragma unroll
                    for (int n = 0; n < 2; ++n) {
                        const int col = u.pn * 256 + bj * 128 + wc * 32 + 16 * n + 4 * fq;
                        const f32x4 s = *(const f32x4*)(sp + col), g = *(const f32x4*)(gp + col);
                        *(f32x4*)(xp + col) = s + g * acc[ai][bj][m][n];
                    }
            }
    }
};
constexpr int XCH_OFF = 131072;
struct EpiUpConv {
    static constexpr bool PERM = true;
    bf16_t* Gb; float* out; const float* cw; const float* cb; const float* pref; int layer; LAS unsigned char* lds;
    __device__ __forceinline__ void operator()(const f32x4 (&acc)[2][2][4][2], const pg8::Unit& u, int wr, int wc, int fr, int fq) const {
        const int lane = fq * 16 + fr;
        LAS float* xch = (LAS float*)(lds + XCH_OFF);
        const int cl = wc * 32 + 8 * fq;
#pragma unroll
        for (int ai = 0; ai < 2; ++ai) {
            const int bnd = 2 * ai + wr;
            if (bnd < 3 && fr >= 14) {
                *(LAS f32x4*)(xch + (bnd * 2 + (fr - 14)) * 128 + cl) = acc[ai][0][3][0];
                *(LAS f32x4*)(xch + (bnd * 2 + (fr - 14)) * 128 + cl + 4) = acc[ai][0][3][1];
            }
        }
        asm volatile("s_waitcnt lgkmcnt(0)" ::: "memory"); __builtin_amdgcn_s_barrier(); asm volatile("" ::: "memory");
        const int rbase = u.pm * 254 - 2;
        const int ad1 = ((lane - 1) & 63) << 2, ad2 = ((lane - 2) & 63) << 2, ad15 = ((lane + 15) & 63) << 2, ad14 = ((lane + 14) & 63) << 2;
#pragma unroll
        for (int n = 0; n < 2; ++n) {
            const int f0 = u.pn * 128 + cl + 4 * n;
            const f32x4 w0 = *(const f32x4*)(cw + f0), w1 = *(const f32x4*)(cw + DFF + f0), w2 = *(const f32x4*)(cw + 2 * DFF + f0), bb = *(const f32x4*)(cb + f0);
#pragma unroll
            for (int ai = 0; ai < 2; ++ai) {
                const int bp = 2 * ai + wr - 1 < 0 ? 0 : 2 * ai + wr - 1;
                const f32x4 x1 = *(const LAS f32x4*)(xch + (bp * 2 + 1) * 128 + cl + 4 * n), x2 = *(const LAS f32x4*)(xch + (bp * 2 + (fr & 1)) * 128 + cl + 4 * n);
#pragma unroll
                for (int m = 0; m < 4; ++m) {
                    const int tl = ai * 128 + wr * 64 + m * 16 + fr, row = rbase + tl;
                    int t, sb = 0; const bool samp = row >= MP;
                    if (!samp) t = row & 8191; else { t = (row - MP) & 31; sb = (row - MP) >> 5; }
                    const bool valid = tl >= 2 && row < M;
                    f32x4 p1 = (f32x4){0.f, 0.f, 0.f, 0.f}, p0 = p1;
                    if (samp && t < 2 && row < M) { const float* pp = pref + (size_t)sb * 2 * DFF + f0; p0 = *(const f32x4*)pp; p1 = *(const f32x4*)(pp + DFF); }
                    float gv[4];
#pragma unroll
                    for (int j = 0; j < 4; ++j) {
                        const float cur = acc[ai][0][m][n][j];
                        const float s1 = __builtin_bit_cast(float, __builtin_amdgcn_ds_bpermute(ad1, __builtin_bit_cast(int, cur)));
                        const float s2 = __builtin_bit_cast(float, __builtin_amdgcn_ds_bpermute(ad2, __builtin_bit_cast(int, cur)));
                        float q1, q2;
                        if (m > 0) {
                            const float prv = acc[ai][0][m > 0 ? m - 1 : 0][n][j];
                            q1 = __builtin_bit_cast(float, __builtin_amdgcn_ds_bpermute(ad15, __builtin_bit_cast(int, prv)));
                            q2 = __builtin_bit_cast(float, __builtin_amdgcn_ds_bpermute(ad14, __builtin_bit_cast(int, prv)));
                        } else { q1 = x1[j]; q2 = x2[j]; }
                        float up1 = fr >= 1 ? s1 : q1, up2 = fr >= 2 ? s2 : q2;
                        if (t == 0) { up1 = p1[j]; up2 = p0[j]; } else if (t == 1) { up2 = p1[j]; }
                        const float cv = up2 * w0[j] + up1 * w1[j] + cur * w2[j] + bb[j];
                        gv[j] = gelu_tanh(cv) * acc[ai][1][m][n][j];
                    }
                    if (valid) {
                        int b, tt; if (!samp) { b = row >> 13; tt = t - (SEQ - 2); } else { b = sb; tt = t - (ST - 2); }
                        if (tt >= 0) *(f32x4*)(out + (samp ? O_CS : O_CP) + ((size_t)((layer * (samp ? 8 : 4) + b) * 2 + tt) * DFF + f0)) = acc[ai][0][m][n];
                        u32x2 w; w.x = pk2(gv[0], gv[1]); w.y = pk2(gv[2], gv[3]);
                        *(u32x2*)(Gb + (size_t)row * DFF + f0) = w;
                    }
                }
            }
        }
    }
};

template <bool UPMAP = false>
__device__ __forceinline__ void p0_transpose_item(const float* W, int N, bf16_t* WT, size_t ldt, int col_off, LAS float* scr, int item, int lane) {
    const int nblk = N / 32, kb = item / nblk, nb = item % nblk, k0 = 64 * kb, n0 = 32 * nb;
    const int r0 = UPMAP ? (n0 < DFF ? 256 * (n0 >> 7) + (n0 & 127) : 256 * ((n0 - DFF) >> 7) + 128 + ((n0 - DFF) & 127)) : n0;
#pragma unroll 8
    for (int i = 0; i < 32; ++i) { const int kk = 2 * i + (lane >> 5); scr[kk * 33 + (lane & 31)] = W[(size_t)(k0 + kk) * N + n0 + (lane & 31)]; }
    asm volatile("s_waitcnt lgkmcnt(0)" ::: "memory");
    const int c = lane & 7;
#pragma unroll
    for (int j = 0; j < 4; ++j) { const int n = (lane >> 3) + 8 * j; const LAS float* s = scr + (8 * c) * 33 + n;
        u32x4 o; o.x = pk2(s[0 * 33], s[1 * 33]); o.y = pk2(s[2 * 33], s[3 * 33]); o.z = pk2(s[4 * 33], s[5 * 33]); o.w = pk2(s[6 * 33], s[7 * 33]);
        *(u32x4*)(WT + (size_t)(r0 + n) * ldt + col_off + k0 + 8 * c) = o; }
    asm volatile("s_waitcnt lgkmcnt(0)" ::: "memory");
}

__device__ __forceinline__ void phase_p0(const Params& P, LAS unsigned char* lds) {
    const int tid = threadIdx.x, lane = tid & 63, wave = tid >> 6;
    const int G = gridDim.x, gw = blockIdx.x * NWAVES + wave, NGW = G * NWAVES;
    LAS float* scr = (LAS float*)(lds + wave * 8704);
    constexpr int I_IN = 16 * (NIN / 32), I_OA = 16 * 32, I_OP = 8 * 32, I_OS = 8 * 32, I_OUT = 16 * 32, I_UP = 16 * (NUP / 32), I_DN = (DFF / 64) * 32, I_PW = 4 * 2 * 4;
    constexpr int I_L = I_IN + I_OA + I_OP + I_OS + I_OUT + I_UP + I_DN + I_PW;
    for (int it = gw; it < 2 * I_L; it += NGW) {
        const int l = it / I_L; int r = it - l * I_L;
        unsigned char* wl = P.ws + WS_W + (size_t)l * WL_SIZE;
        if (r < I_IN) { p0_transpose_item(P.w_in + (size_t)l * D * NIN, NIN, (bf16_t*)(wl + WL_IN), D, 0, scr, r, lane); continue; } r -= I_IN;
        if (r < I_OA) { p0_transpose_item(P.w_o_attn + (size_t)l * D * D, D, (bf16_t*)(wl + WL_CAT), 2048, 0, scr, r, lane); continue; } r -= I_OA;
        if (r < I_OP) { p0_transpose_item(P.w_o_pool + (size_t)l * 512 * D, D, (bf16_t*)(wl + WL_CAT), 2048, 1024, scr, r, lane); continue; } r -= I_OP;
        if (r < I_OS) { p0_transpose_item(P.w_o_sgu + (size_t)l * 512 * D, D, (bf16_t*)(wl + WL_CAT), 2048, 1536, scr, r, lane); continue; } r -= I_OS;
        if (r < I_OUT) { p0_transpose_item(P.w_out + (size_t)l * D * D, D, (bf16_t*)(wl + WL_OUT), D, 0, scr, r, lane); continue; } r -= I_OUT;
        if (r < I_UP) { p0_transpose_item<true>(P.ffn_w_up + (size_t)l * D * NUP, NUP, (bf16_t*)(wl + WL_UP), D, 0, scr, r, lane); continue; } r -= I_UP;
        if (r < I_DN) { p0_transpose_item(P.ffn_w_down + (size_t)l * DFF * D, D, (bf16_t*)(wl + WL_DN), DFF, 0, scr, r, lane); continue; } r -= I_DN;
        { const int g = r >> 3, rr = r & 7;
          p0_transpose_item(P.pool_w + ((size_t)l * 4 + g) * 128 * 128, 128, (bf16_t*)(wl + WL_PW) + (size_t)g * 128 * 128, 128, 0, scr, rr, lane); }
    }
    const int gt = blockIdx.x * NTHREADS + tid, NGT = G * NTHREADS;
    for (int e = gt; e < 2 * 4 * 128 * 128; e += NGT) {
        const int l = e >> 16, r = e & 65535, i = (r >> 7) & 127, j = r & 127;
        const float v = ((j >> 6) <= (i >> 6)) ? P.sgu_w[e] : 0.f;
        ((bf16_t*)(P.ws + WS_W + (size_t)l * WL_SIZE + WL_SG))[r] = (bf16_t)f2bf(v);
    }
    for (int e = gt; e < 2 * 8 * 96 * 128; e += NGT) {
        const int lb = e / (96 * 128), r = e - lb * (96 * 128);
        P.out[O_KS + (size_t)lb * 128 * 128 + r] = P.cache_k[(size_t)lb * 128 * 128 + 32 * 128 + r];
        P.out[O_VS + (size_t)lb * 128 * 128 + r] = P.cache_v[(size_t)lb * 128 * 128 + 32 * 128 + r];
    }
    __syncthreads();
    LAS float* part = (LAS float*)lds;
    for (int it = blockIdx.x; it < 2 * 96; it += G) {
        const int l = it / 96, e0 = (it % 96) * 64;
        float acc[12];
#pragma unroll
        for (int b = 0; b < 12; ++b) acc[b] = 0.f;
        const float* wp = P.w_ada + (size_t)l * D * 6144 + e0 + lane;
        for (int d = wave * 128; d < wave * 128 + 128; ++d) {
            const float wv = wp[(size_t)d * 6144];
#pragma unroll
            for (int b = 0; b < 12; ++b) { const float cv = b < 4 ? P.c_prompt[b * D + d] : P.c_sample[(b - 4) * D + d]; acc[b] += cv * sigmoidf_(cv) * wv; }
        }
#pragma unroll
        for (int b = 0; b < 12; ++b) part[(wave * 12 + b) * 64 + lane] = acc[b];
        __syncthreads();
        for (int o = tid; o < 12 * 64; o += NTHREADS) {
            const int b = o >> 6, c = o & 63; float s = P.b_ada[(size_t)l * 6144 + e0 + c];
#pragma unroll
            for (int w = 0; w < 8; ++w) s += part[(w * 12 + b) * 64 + c];
            ((float*)(P.ws + WS_MOD))[((size_t)l * 12 + b) * 6144 + e0 + c] = s;
        }
        __syncthreads();
    }
}

__device__ __forceinline__ void phase_norm(const Params& P, const float* srcp, const float* srcs, const float* g, const float* mod_sh, const float* mod_sc) {
    const int lane = threadIdx.x & 63, wave = threadIdx.x >> 6;
    const int gw = blockIdx.x * NWAVES + wave, NGW = gridDim.x * NWAVES;
    bf16_t* H = (bf16_t*)(P.ws + WS_H);
    for (int row = gw; row < M; row += NGW) {
        const float* xr = row < MP ? srcp + (size_t)row * D : srcs + (size_t)(row - MP) * D;
        const int b = batch_of_row(row);
        f32x4 v[4]; float s = 0.f;
#pragma unroll
        for (int j = 0; j < 4; ++j) { v[j] = *(const f32x4*)(xr + 4 * lane + 256 * j); s += (v[j][0] * v[j][0] + v[j][1] * v[j][1]) + (v[j][2] * v[j][2] + v[j][3] * v[j][3]); }
        const float rstd = rsqrtf(wave_sum(s) * (1.f / D) + 1e-6f);
#pragma unroll
        for (int j = 0; j < 4; ++j) {
            const int c = 4 * lane + 256 * j;
            const f32x4 gg = *(const f32x4*)(g + c), sc = *(const f32x4*)(mod_sc + (size_t)b * 6144 + c), sh = *(const f32x4*)(mod_sh + (size_t)b * 6144 + c);
            f32x4 h = v[j] * rstd * gg * (sc + 1.0f) + sh;
            u32x2 w; w.x = pk2(h[0], h[1]); w.y = pk2(h[2], h[3]);
            *(u32x2*)(H + (size_t)row * D + c) = w;
        }
    }
}
__device__ __forceinline__ void phase_final(const Params& P) {
    const int lane = threadIdx.x & 63, wave = threadIdx.x >> 6;
    const int gw = blockIdx.x * NWAVES + wave, NGW = gridDim.x * NWAVES;
    for (int row = gw; row < M; row += NGW) {
        float* xr = P.out + (size_t)row * D;
        f32x4 v[4]; float s = 0.f;
#pragma unroll
        for (int j = 0; j < 4; ++j) { v[j] = *(const f32x4*)(xr + 4 * lane + 256 * j); s += (v[j][0] * v[j][0] + v[j][1] * v[j][1]) + (v[j][2] * v[j][2] + v[j][3] * v[j][3]); }
        const float rstd = rsqrtf(wave_sum(s) * (1.f / D) + 1e-6f);
#pragma unroll
        for (int j = 0; j < 4; ++j) { const int c = 4 * lane + 256 * j; const f32x4 gg = *(const f32x4*)(P.final_norm_g + c); *(f32x4*)(xr + c) = v[j] * rstd * gg; }
    }
}

constexpr int KS_STRIDE = 144;
constexpr int VT_STRIDE = 400;
constexpr int ATT_KS = 0, ATT_VT = 192 * KS_STRIDE;

__device__ __forceinline__ void attn_item(const Params& P, int layer, int item, LAS unsigned char* lds) {
    const int tid = threadIdx.x, lane = tid & 63, wave = tid >> 6, fr = lane & 15, fq = lane >> 4;
    bf16_t* Z = (bf16_t*)(P.ws + WS_Z);
    const bool samp = item >= 1024;
    int kvh, c = 0, sb = 0, qrow0, klo, khi, nqt;
    if (!samp) { kvh = item & 1; c = (item >> 1) & 127; const int b = item >> 8; qrow0 = b * SEQ + 64 * c; klo = 128 - 64 * (c < 2 ? c : 2); khi = 192; nqt = 4; }
    else { const int s = item - 1024; kvh = s & 1; sb = s >> 1; qrow0 = MP + sb * ST; klo = 0; khi = 160; nqt = 2; }
    __syncthreads();
    {
        const int ch = tid & 7, key0 = tid >> 3;
#pragma unroll
        for (int p = 0; p < 3; ++p) {
            const int j = key0 + 64 * p;
            u32x4 kk = (u32x4){0u, 0u, 0u, 0u}, vv = (u32x4){0u, 0u, 0u, 0u};
            if (j >= klo && j < khi) {
                if (samp && j < 128) {
                    const float* kp = P.cache_k + ((((size_t)layer * 8 + sb) * 128 + j) * 2 + kvh) * 64 + ch * 8;
                    const float* vp = P.cache_v + ((((size_t)layer * 8 + sb) * 128 + j) * 2 + kvh) * 64 + ch * 8;
                    const f32x4 k0 = *(const f32x4*)kp, k1 = *(const f32x4*)(kp + 4), v0 = *(const f32x4*)vp, v1 = *(const f32x4*)(vp + 4);
                    kk.x = pk2(k0[0], k0[1]); kk.y = pk2(k0[2], k0[3]); kk.z = pk2(k1[0], k1[1]); kk.w = pk2(k1[2], k1[3]);
                    vv.x = pk2(v0[0], v0[1]); vv.y = pk2(v0[2], v0[3]); vv.z = pk2(v1[0], v1[1]); vv.w = pk2(v1[2], v1[3]);
                } else {
                    const int row = samp ? (qrow0 + j - 128) : (qrow0 - 128 + j);
                    const bf16_t* zp = Z + (size_t)row * NIN + kvh * 64 + ch * 8;
                    kk = *(const u32x4*)(zp + ZC_K); vv = *(const u32x4*)(zp + ZC_V);
                }
            }
            *(LAS u32x4*)(lds + ATT_KS + j * KS_STRIDE + ch * 16) = kk;
            LAS bf16_t* vt = (LAS bf16_t*)(lds + ATT_VT + (ch * 8) * VT_STRIDE + j * 2);
            vt[0 * (VT_STRIDE / 2)] = (bf16_t)(vv.x & 0xffff); vt[1 * (VT_STRIDE / 2)] = (bf16_t)(vv.x >> 16);
            vt[2 * (VT_STRIDE / 2)] = (bf16_t)(vv.y & 0xffff); vt[3 * (VT_STRIDE / 2)] = (bf16_t)(vv.y >> 16);
            vt[4 * (VT_STRIDE / 2)] = (bf16_t)(vv.z & 0xffff); vt[5 * (VT_STRIDE / 2)] = (bf16_t)(vv.z >> 16);
            vt[6 * (VT_STRIDE / 2)] = (bf16_t)(vv.w & 0xffff); vt[7 * (VT_STRIDE / 2)] = (bf16_t)(vv.w >> 16);
        }
    }
    __syncthreads();
    const int h = kvh * 8 + wave;
    const float slope = exp2f(-0.5f * (float)(h + 1)) * 1.4426950408889634f;
    const float sink = P.attn_sink[layer * 16 + h] * 1.4426950408889634f;
#pragma unroll 1
    for (int qt = 0; qt < nqt; ++qt) {
        const int qrow = qrow0 + 16 * qt + fr;
        bf16_t* qp = Z + (size_t)qrow * NIN + h * 64;
        const bf16x8 q0 = *(const bf16x8*)(qp + 8 * fq), q1 = *(const bf16x8*)(qp + 32 + 8 * fq);
        f32x4 st[12];
#pragma unroll
        for (int kt = 0; kt < 12; ++kt) {
            const LAS unsigned char* kp = lds + ATT_KS + (16 * kt + fr) * KS_STRIDE + 16 * fq;
            const bf16x8 a0 = *(const LAS bf16x8*)kp, a1 = *(const LAS bf16x8*)(kp + 64);
            f32x4 a = (f32x4){0.f, 0.f, 0.f, 0.f};
            a = __builtin_amdgcn_mfma_f32_16x16x32_bf16(a0, q0, a, 0, 0, 0);
            a = __builtin_amdgcn_mfma_f32_16x16x32_bf16(a1, q1, a, 0, 0, 0);
            st[kt] = a;
            if ((kt & 3) == 3) asm volatile("" ::: "memory");
        }
        const int ql = 16 * qt + fr;
        float mx = -INFINITY;
#pragma unroll
        for (int kt = 0; kt < 12; ++kt)
#pragma unroll
            for (int jj = 0; jj < 4; ++jj) {
                const int key = 16 * kt + 4 * fq + jj;
                const float dist = fabsf((float)(128 + ql - key));
                float lg = st[kt][jj] * (0.125f * 1.4426950408889634f) - slope * dist;
                lg = (key >= klo && key < khi) ? lg : -INFINITY;
                st[kt][jj] = lg; mx = fmaxf(mx, lg);
            }
        mx = fmaxf(mx, __shfl_xor(mx, 16)); mx = fmaxf(mx, __shfl_xor(mx, 32));
        mx = fmaxf(mx, sink);
        float sum = 0.f;
#pragma unroll
        for (int kt = 0; kt < 12; ++kt)
#pragma unroll
            for (int jj = 0; jj < 4; ++jj) { const float p = __builtin_amdgcn_exp2f(st[kt][jj] - mx); st[kt][jj] = p; sum += p; }
        sum += __shfl_xor(sum, 16); sum += __shfl_xor(sum, 32);
        const float inv = __builtin_amdgcn_rcpf(sum + __builtin_amdgcn_exp2f(sink - mx));
        bf16x8 pb[6];
#pragma unroll
        for (int s = 0; s < 6; ++s) {
            u32x4 w; w.x = pk2(st[2 * s][0] * inv, st[2 * s][1] * inv); w.y = pk2(st[2 * s][2] * inv, st[2 * s][3] * inv);
            w.z = pk2(st[2 * s + 1][0] * inv, st[2 * s + 1][1] * inv); w.w = pk2(st[2 * s + 1][2] * inv, st[2 * s + 1][3] * inv);
            pb[s] = __builtin_bit_cast(bf16x8, w);
        }
#pragma unroll 1
        for (int dt = 0; dt < 4; ++dt) {
            f32x4 o = (f32x4){0.f, 0.f, 0.f, 0.f};
#pragma unroll
            for (int s = 0; s < 6; ++s) {
                const LAS unsigned char* vp = lds + ATT_VT + (16 * dt + fr) * VT_STRIDE + (32 * s + 4 * fq) * 2;
                const u32x2 lo = *(const LAS u32x2*)vp, hi = *(const LAS u32x2*)(vp + 32);
                const u32x4 av = (u32x4){lo.x, lo.y, hi.x, hi.y};
                o = __builtin_amdgcn_mfma_f32_16x16x32_bf16(__builtin_bit_cast(bf16x8, av), pb[s], o, 0, 0, 0);
            }
            u32x2 w; w.x = pk2(o[0], o[1]); w.y = pk2(o[2], o[3]);
            *(u32x2*)(qp + 16 * dt + 4 * fq) = w;
        }
    }
}

constexpr int MX_RS = 0, MX_VNT = 1024, MX_U = 36864, MX_DT = 76800, MX_ST = 272;
__device__ __forceinline__ void mix_item(const Params& P, int layer, int item, LAS unsigned char* lds) {
    const int tid = threadIdx.x, lane = tid & 63, wave = tid >> 6, fr = lane & 15, fq = lane >> 4;
    bf16_t* Z = (bf16_t*)(P.ws + WS_Z);
    const unsigned char* wl = P.ws + WS_W + (size_t)layer * WL_SIZE;
    const bool samp = item >= 256;
    int row0, L, t0, sb = 0;
    if (!samp) { const int b = item >> 6, ch = item & 63; row0 = b * SEQ + ch * 128; L = 128; t0 = ch * 128; }
    else { sb = item - 256; row0 = MP + sb * ST; L = ST; t0 = 0; }
    LAS float* RS = (LAS float*)(lds + MX_RS);
    __syncthreads();
    for (int k = 0; k < 16; ++k) {
        const int i = wave * 16 + k;
        if (i < L) {
            const u32x4 w = *(const u32x4*)(Z + (size_t)(row0 + i) * NIN + ZC_SV + lane * 8);
            float s = bflo(w.x) * bflo(w.x) + bfhi(w.x) * bfhi(w.x) + bflo(w.y) * bflo(w.y) + bfhi(w.y) * bfhi(w.y)
                    + bflo(w.z) * bflo(w.z) + bfhi(w.z) * bfhi(w.z) + bflo(w.w) * bflo(w.w) + bfhi(w.w) * bfhi(w.w);
            s = wave_sum(s);
            if (lane == 0) RS[i] = rsqrtf(s * (1.f / 512.f) + 1e-6f);
        }
    }
    __syncthreads();
    for (int g = 0; g < 4; ++g) {
#pragma unroll
        for (int p = 0; p < 4; ++p) {
            const int idx = tid + NTHREADS * p, j = idx >> 4, c8 = idx & 15;
            float vn[8];
            if (j < L) {
                const u32x4 w = *(const u32x4*)(Z + (size_t)(row0 + j) * NIN + ZC_SV + g * 128 + c8 * 8);
                const float rs = RS[j]; const float* ng = P.sgu_norm_g + layer * 512 + g * 128 + c8 * 8;
                vn[0] = bflo(w.x) * rs * ng[0]; vn[1] = bfhi(w.x) * rs * ng[1]; vn[2] = bflo(w.y) * rs * ng[2]; vn[3] = bfhi(w.y) * rs * ng[3];
                vn[4] = bflo(w.z) * rs * ng[4]; vn[5] = bfhi(w.z) * rs * ng[5]; vn[6] = bflo(w.w) * rs * ng[6]; vn[7] = bfhi(w.w) * rs * ng[7];
                if (samp) { float* dst = P.out + O_SV + ((size_t)((layer * 8 + sb) * ST + j)) * 512 + g * 128 + c8 * 8;
                    *(f32x4*)dst = (f32x4){vn[0], vn[1], vn[2], vn[3]}; *(f32x4*)(dst + 4) = (f32x4){vn[4], vn[5], vn[6], vn[7]}; }
            } else {
#pragma unroll
                for (int e = 0; e < 8; ++e) vn[e] = 0.f;
            }
            LAS bf16_t* vt = (LAS bf16_t*)(lds + MX_VNT + (c8 * 8) * MX_ST + j * 2);
#pragma unroll
            for (int e = 0; e < 8; ++e) vt[e * (MX_ST / 2)] = (bf16_t)f2bf(vn[e]);
        }
        __syncthreads();
        if (wave * 16 < L) {
            const int i = wave * 16 + fr;
            const bf16_t* wrow = (const bf16_t*)(wl + WL_SG) + ((size_t)g * 128 + i) * 128 + 8 * fq;
            bf16x8 wf[4];
#pragma unroll
            for (int ks = 0; ks < 4; ++ks) wf[ks] = *(const bf16x8*)(wrow + 32 * ks);
            const float bias = P.sgu_b[(layer * 4 + g) * 128 + i];
            bf16_t* zrow = Z + (size_t)(row0 + i) * NIN + ZC_SU + g * 128 + 4 * fq;
#pragma unroll
            for (int ct = 0; ct < 8; ++ct) {
                f32x4 a = (f32x4){0.f, 0.f, 0.f, 0.f};
#pragma unroll
                for (int ks = 0; ks < 4; ++ks) {
                    const bf16x8 av = *(const LAS bf16x8*)(lds + MX_VNT + (16 * ct + fr) * MX_ST + (32 * ks + 8 * fq) * 2);
                    a = __builtin_amdgcn_mfma_f32_16x16x32_bf16(av, wf[ks], a, 0, 0, 0);
                }
                const u32x2 uu = *(const u32x2*)(zrow + 16 * ct);
                u32x2 w; w.x = pk2(bflo(uu.x) * (a[0] + bias), bfhi(uu.x) * (a[1] + bias)); w.y = pk2(bflo(uu.y) * (a[2] + bias), bfhi(uu.y) * (a[3] + bias));
                *(u32x2*)(zrow + 16 * ct) = w;
            }
        }
        __syncthreads();
    }
    for (int g = 0; g < 4; ++g) {
        const int wlen = 2 << g;
        for (int idx = tid; idx < (15 + L) * 16; idx += NTHREADS) {
            const int hh = idx >> 4, c8 = idx & 15, rel = hh - 15;
            u32x4 w = (u32x4){0u, 0u, 0u, 0u};
            if (rel >= 0 || (!samp && t0 > 0)) w = *(const u32x4*)(Z + (size_t)(row0 + rel) * NIN + ZC_PU + g * 128 + c8 * 8);
            else if (samp) {
                const float* sp = P.state_pool + ((size_t)(layer * 8 + sb) * 15 + hh) * 512 + g * 128 + c8 * 8;
                const f32x4 a = *(const f32x4*)sp, b = *(const f32x4*)(sp + 4);
                w.x = pk2(a[0], a[1]); w.y = pk2(a[2], a[3]); w.z = pk2(b[0], b[1]); w.w = pk2(b[2], b[3]);
            }
            *(LAS u32x4*)(lds + MX_U + hh * MX_ST + c8 * 16) = w;
        }
        __syncthreads();
        for (int idx = tid; idx < L * 16; idx += NTHREADS) {
            const int i = idx >> 4, c8 = idx & 15;
            float s[8];
#pragma unroll
            for (int e = 0; e < 8; ++e) s[e] = 0.f;
            for (int k = 0; k < wlen; ++k) {
                const u32x4 w = *(const LAS u32x4*)(lds + MX_U + (15 + i - k) * MX_ST + c8 * 16);
                s[0] += bflo(w.x); s[1] += bfhi(w.x); s[2] += bflo(w.y); s[3] += bfhi(w.y); s[4] += bflo(w.z); s[5] += bfhi(w.z); s[6] += bflo(w.w); s[7] += bfhi(w.w);
            }
            const u32x4 w = *(const LAS u32x4*)(lds + MX_U + (15 + i) * MX_ST + c8 * 16);
            const int pos1 = samp ? (1024 + i + 1) : (t0 + i + 1);
            const float rc = 1.0f / (float)(pos1 < wlen ? pos1 : wlen);
            u32x4 o;
            o.x = pk2(s[0] * rc - bflo(w.x), s[1] * rc - bfhi(w.x)); o.y = pk2(s[2] * rc - bflo(w.y), s[3] * rc - bfhi(w.y));
            o.z = pk2(s[4] * rc - bflo(w.z), s[5] * rc - bfhi(w.z)); o.w = pk2(s[6] * rc - bflo(w.w), s[7] * rc - bfhi(w.w));
            *(LAS u32x4*)(lds + MX_DT + i * MX_ST + c8 * 16) = o;
        }
        __syncthreads();
        if (wave * 16 < L) {
            const int i = wave * 16 + fr;
            bf16x8 df[4];
#pragma unroll
            for (int ks = 0; ks < 4; ++ks) df[ks] = *(const LAS bf16x8*)(lds + MX_DT + i * MX_ST + (32 * ks + 8 * fq) * 2);
            const bf16_t* pw = (const bf16_t*)(wl + WL_PW) + (size_t)g * 128 * 128;
            bf16_t* zrow = Z + (size_t)(row0 + i) * NIN + ZC_SV + g * 128 + 4 * fq;
            const float* psc = P.pool_scale + layer * 512 + g * 128 + 4 * fq;
#pragma unroll
            for (int nt = 0; nt < 8; ++nt) {
                f32x4 a = (f32x4){0.f, 0.f, 0.f, 0.f};
#pragma unroll
                for (int ks = 0; ks < 4; ++ks) {
                    const bf16x8 wv = *(const bf16x8*)(pw + (size_t)(16 * nt + fr) * 128 + 32 * ks + 8 * fq);
                    a = __builtin_amdgcn_mfma_f32_16x16x32_bf16(wv, df[ks], a, 0, 0, 0);
                }
                const f32x4 sc = *(const f32x4*)(psc + 16 * nt);
                u32x2 w; w.x = pk2(a[0] * sc[0], a[1] * sc[1]); w.y = pk2(a[2] * sc[2], a[3] * sc[3]);
                *(u32x2*)(zrow + 16 * nt) = w;
            }
        }
        __syncthreads();
    }
}

__device__ __forceinline__ void phase_mixers(const Params& P, int layer, LAS unsigned char* lds) {
    for (int it = blockIdx.x; it < 1304; it += gridDim.x) {
        if (it < 256) mix_item(P, layer, it, lds);
        else if (it < 1280) attn_item(P, layer, it - 256, lds);
        else if (it < 1296) attn_item(P, layer, 1024 + (it - 1280), lds);
        else mix_item(P, layer, 256 + (it - 1296), lds);
    }
}

__device__ __forceinline__ void phase_conv(const Params& P, int layer) {
    bf16_t* AB = (bf16_t*)(P.ws + WS_Z);
    const int gt = blockIdx.x * NTHREADS + threadIdx.x, NGT = gridDim.x * NTHREADS;
    const float* cw = P.ffn_conv_w + (size_t)layer * 3 * DFF; const float* cb = P.ffn_conv_b + (size_t)layer * DFF;
    for (int idx = gt; idx < M * (DFF / 8); idx += NGT) {
        const int r = idx / (DFF / 8), f = (idx - r * (DFF / 8)) * 8;
        int t, sb = 0; const bool samp = r >= MP;
        if (!samp) t = r & 8191; else { t = (r - MP) & 31; sb = (r - MP) >> 5; }
        float a0[8], a1[8], a2[8];
        { const u32x4 w = *(const u32x4*)(AB + (size_t)r * NUP + f);
          a0[0] = bflo(w.x); a0[1] = bfhi(w.x); a0[2] = bflo(w.y); a0[3] = bfhi(w.y); a0[4] = bflo(w.z); a0[5] = bfhi(w.z); a0[6] = bflo(w.w); a0[7] = bfhi(w.w); }
        const float* pf = P.state_conv + ((size_t)(layer * 8 + sb) * 2) * DFF + f;
        if (t >= 1) { const u32x4 w = *(const u32x4*)(AB + (size_t)(r - 1) * NUP + f);
          a1[0] = bflo(w.x); a1[1] = bfhi(w.x); a1[2] = bflo(w.y); a1[3] = bfhi(w.y); a1[4] = bflo(w.z); a1[5] = bfhi(w.z); a1[6] = bflo(w.w); a1[7] = bfhi(w.w); }
        else {
#pragma unroll
            for (int e = 0; e < 8; ++e) a1[e] = samp ? pf[DFF + e] : 0.f; }
        if (t >= 2) { const u32x4 w = *(const u32x4*)(AB + (size_t)(r - 2) * NUP + f);
          a2[0] = bflo(w.x); a2[1] = bfhi(w.x); a2[2] = bflo(w.y); a2[3] = bfhi(w.y); a2[4] = bflo(w.z); a2[5] = bfhi(w.z); a2[6] = bflo(w.w); a2[7] = bfhi(w.w); }
        else {
#pragma unroll
            for (int e = 0; e < 8; ++e) a2[e] = samp ? pf[(t == 1 ? DFF : 0) + e] : 0.f; }
        const u32x4 bw = *(const u32x4*)(AB + (size_t)r * NUP + DFF + f);
        float bb[8] = {bflo(bw.x), bfhi(bw.x), bflo(bw.y), bfhi(bw.y), bflo(bw.z), bfhi(bw.z), bflo(bw.w), bfhi(bw.w)};
        float go[8];
#pragma unroll
        for (int e = 0; e < 8; ++e) {
            const float cv = a2[e] * cw[f + e] + a1[e] * cw[DFF + f + e] + a0[e] * cw[2 * DFF + f + e] + cb[f + e];
            go[e] = gelu_tanh(cv) * bb[e];
        }
        u32x4 o; o.x = pk2(go[0], go[1]); o.y = pk2(go[2], go[3]); o.z = pk2(go[4], go[5]); o.w = pk2(go[6], go[7]);
        *(u32x4*)(AB + (size_t)r * NUP + DFF + f) = o;
    }
}

constexpr int NPHASES = 20;
#define XB_TMO      128
#define XB_XCNT(j)  (256  + 64 * (j))
#define XB_XSUB(j)  (1280 + 64 * (j))
#define XB_XGEN(j)  (2304 + 64 * (j))
#define XB_TOP      3328
#define XB_TOPGEN   3392
#define XCD_BAR_WORDS 3456
#define XB_SPIN_CAP (1u << 18)

__device__ __forceinline__ unsigned xb_ld(unsigned* p)              { return __hip_atomic_load(p, __ATOMIC_RELAXED, __HIP_MEMORY_SCOPE_AGENT); }
__device__ __forceinline__ unsigned xb_add(unsigned* p, unsigned v) { return __hip_atomic_fetch_add(p, v, __ATOMIC_RELAXED, __HIP_MEMORY_SCOPE_AGENT); }
__device__ __forceinline__ unsigned xb_xcc_id() { return (unsigned)__builtin_amdgcn_s_getreg((3 << 11) | 20) & 0xFu; }
#define XB_SPIN(cond, bar) do { unsigned _sp = 0; while (cond) { __builtin_amdgcn_s_sleep(1); \
    if ((++_sp & 255u) == 0u) { if (xb_ld(&(bar)[XB_TMO])) break; if (_sp > XB_SPIN_CAP) { atomicAdd(&(bar)[XB_TMO], 1u); break; } } } } while (0)

struct XcdBarrier {
    unsigned* bar; unsigned x;
    volatile LAS unsigned* st;
};

__device__ __forceinline__ XcdBarrier xcd_barrier_post(unsigned* bar, volatile LAS unsigned* st) {
    XcdBarrier b; b.bar = bar; b.x = xb_xcc_id(); b.st = st;
    if (threadIdx.x == 0) (void)xb_add(&bar[XB_XCNT(b.x)], 1u);
    return b;
}
__device__ __forceinline__ void xcd_barrier_complete(unsigned* bar, unsigned x, unsigned& nloc, unsigned& nx) {
    const unsigned G = gridDim.x * gridDim.y * gridDim.z;
    unsigned sum, cnt, mine, sp = 0u;
    for (;;) {
        sum = 0u; cnt = 0u; mine = 0u;
#pragma unroll
        for (unsigned j = 0; j < 16; ++j) { const unsigned c = xb_ld(&bar[XB_XCNT(j)]); sum += c; cnt += (c > 0u) ? 1u : 0u; mine = (j == x) ? c : mine; }
        if (sum == G) break;
        __builtin_amdgcn_s_sleep(1);
        if ((++sp & 255u) == 0u) { if (xb_ld(&bar[XB_TMO])) break; if (sp > XB_SPIN_CAP) { atomicAdd(&bar[XB_TMO], 1u); break; } }
    }
    nloc = mine > 0u ? mine : 1u; nx = cnt > 0u ? cnt : 1u;
}

__device__ __forceinline__ void xcd_barrier(const XcdBarrier& b) {
    asm volatile("s_waitcnt vmcnt(0)" ::: "memory");
    __syncthreads();
    if (threadIdx.x == 0) {
        unsigned* bar = b.bar;
        __builtin_amdgcn_s_waitcnt(0);
        unsigned nloc = b.st[0], nx = b.st[1];
        if (nloc == 0u) { xcd_barrier_complete(bar, b.x, nloc, nx); b.st[0] = nloc; b.st[1] = nx; }
        const unsigned old = xb_add(&bar[XB_XSUB(b.x)], 1u);
        const unsigned gen = old / nloc;
        if (old + 1u == (gen + 1u) * nloc) {
            __builtin_amdgcn_fence(__ATOMIC_RELEASE, "agent");
            asm volatile("s_waitcnt vmcnt(0)" ::: "memory");
            const unsigned og = xb_add(&bar[XB_TOP], 1u);
            const unsigned tg = og / nx;
            if (og + 1u == (tg + 1u) * nx) xb_add(&bar[XB_TOPGEN], 1u);
            else XB_SPIN(xb_ld(&bar[XB_TOPGEN]) == tg, bar);
            __builtin_amdgcn_fence(__ATOMIC_ACQUIRE, "agent");
            xb_add(&bar[XB_XGEN(b.x)], 1u);
            asm volatile("s_waitcnt vmcnt(0)" ::: "memory");
        } else {
            XB_SPIN(xb_ld(&bar[XB_XGEN(b.x)]) == gen, bar);
            __builtin_amdgcn_fence(__ATOMIC_ACQUIRE, "agent");
            asm volatile("s_waitcnt vmcnt(0)" ::: "memory");
        }
    }
    __syncthreads();
}


#define RUN(k) (lo <= (k) && (k) < hi)
#define SYNC(k) do { if ((k) + 1 < hi) xcd_barrier(bar); } while (0)
template <int l>
__device__ __forceinline__ void layer_phases(const Params& P, LAS unsigned char* lds, const XcdBarrier& bar) {
    const int lo = P.ph_lo, hi = P.ph_hi;
    const int G = gridDim.x, c = blockIdx.x;
    unsigned char* ws = P.ws;
    const float* MOD = (const float*)(ws + WS_MOD);
    bf16_t* H = (bf16_t*)(ws + WS_H);
    bf16_t* Z = (bf16_t*)(ws + WS_Z);
    constexpr int pb = 1 + 9 * l;
    const unsigned char* wl = ws + WS_W + (size_t)l * WL_SIZE;
    const float* modl = MOD + (size_t)l * 12 * 6144;
    const float* srcp = l == 0 ? P.x_prompt : P.out + O_YP;
    const float* srcs = l == 0 ? P.x_sample : P.out + O_YS;
    if (RUN(pb + 0)) { phase_norm(P, srcp, srcs, P.norm1_g + l * D, modl + 0 * D, modl + 1 * D); SYNC(pb + 0); }
    if (RUN(pb + 1)) {
        pg8::SimpleOrder S{(const char*)H, (const char*)(wl + WL_IN), (size_t)D * 2, (size_t)D * 2, M / 256, NIN / 256, D / 64, G, c};
        EpiZ E{Z, P.out, l};
        pg8::gemm_phase<EpiZ, pg8::SimpleOrder>(lds, (size_t)D * 2, (size_t)D * 2, S, E);
        SYNC(pb + 1);
    }
    if (l == 0 && PROBE == 1) {
        pg8::SimpleOrder S{(const char*)H, (const char*)(wl + WL_IN), (size_t)D * 2, (size_t)D * 2, M / 256, NIN / 256, D / 64, G, c};
        EpiZ E{Z, P.out, l};
        pg8::gemm_phase<EpiZ, pg8::SimpleOrder>(lds, (size_t)D * 2, (size_t)D * 2, S, E);
        xcd_barrier(bar);
    }
    if (RUN(pb + 2)) { phase_mixers(P, l, lds); SYNC(pb + 2); }
    if (l == 0 && PROBE == 2) {
        pg8::SimpleOrder S{(const char*)H, (const char*)(wl + WL_IN), (size_t)D * 2, (size_t)D * 2, M / 256, NIN / 256, D / 64, G, c};
        EpiZ E{Z, P.out, l};
        pg8::gemm_phase<EpiZ, pg8::SimpleOrder>(lds, (size_t)D * 2, (size_t)D * 2, S, E);
        xcd_barrier(bar);
        phase_mixers(P, l, lds);
        xcd_barrier(bar);
    }
    if (RUN(pb + 3)) {
        pg8::MergeOrder S{(const char*)Z, (const char*)(wl + WL_CAT), (size_t)NIN * 2, (size_t)2048 * 2, M / 256, D / 256, G, c};
        EpiMerge E{Z, H};
        pg8::gemm_phase<EpiMerge, pg8::MergeOrder>(lds, (size_t)NIN * 2, (size_t)2048 * 2, S, E);
        SYNC(pb + 3);
    }
    if (RUN(pb + 4)) {
        pg8::SimpleOrder S{(const char*)H, (const char*)(wl + WL_OUT), (size_t)D * 2, (size_t)D * 2, M / 256, D / 256, D / 64, G, c};
        EpiRes E{srcp, srcs, P.out, modl + 2 * D};
        pg8::gemm_phase<EpiRes, pg8::SimpleOrder>(lds, (size_t)D * 2, (size_t)D * 2, S, E);
        SYNC(pb + 4);
    }
    if (RUN(pb + 5)) { phase_norm(P, P.out + O_YP, P.out + O_YS, P.norm2_g + l * D, modl + 3 * D, modl + 4 * D); SYNC(pb + 5); }
    if (RUN(pb + 6)) {
        pg8::UpOrder S{(const char*)H, (const char*)(wl + WL_UP), (size_t)D * 2, (size_t)D * 2, (M + 253) / 254, NUP / 256, D / 64, G, c};
        EpiUpConv E{Z, P.out, P.ffn_conv_w + (size_t)l * 3 * DFF, P.ffn_conv_b + (size_t)l * DFF, P.state_conv + (size_t)l * 8 * 2 * DFF, l, lds};
        pg8::gemm_phase<EpiUpConv, pg8::UpOrder>(lds, (size_t)D * 2, (size_t)D * 2, S, E);
        SYNC(pb + 6);
    }
    if (RUN(pb + 8)) {
        pg8::SimpleOrder S{(const char*)Z, (const char*)(wl + WL_DN), (size_t)DFF * 2, (size_t)DFF * 2, M / 256, D / 256, DFF / 64, G, c};
        EpiRes E{P.out + O_YP, P.out + O_YS, P.out, modl + 5 * D};
        pg8::gemm_phase<EpiRes, pg8::SimpleOrder>(lds, (size_t)DFF * 2, (size_t)DFF * 2, S, E);
        SYNC(pb + 8);
    }
}
__global__ void __launch_bounds__(NTHREADS) mk_fwd(Params P) {
    extern __shared__ __attribute__((aligned(16))) unsigned char lds_raw[];
    LAS unsigned char* lds = (LAS unsigned char*)lds_raw;
    cg::grid_group grid = cg::this_grid();
    const int lo = P.ph_lo, hi = P.ph_hi;
    unsigned* barw = (unsigned*)(P.ws + WS_BAR);
    volatile LAS unsigned* st = (volatile LAS unsigned*)(lds + XCH_OFF + 4096);
    if (threadIdx.x < 2) st[threadIdx.x] = 0u;
    if (lo == 0 && blockIdx.x == 0) for (int i = threadIdx.x; i < XCD_BAR_WORDS; i += NTHREADS) barw[i] = 0u;
    __syncthreads();
    if (RUN(0)) { phase_p0(P, lds); if (1 < hi) grid.sync(); }
    XcdBarrier bar = xcd_barrier_post(barw, st);
    if (PROBE == 4) { phase_p0(P, lds); xcd_barrier(bar); phase_norm(P, P.x_prompt, P.x_sample, P.norm1_g, (const float*)(P.ws + WS_MOD), (const float*)(P.ws + WS_MOD) + D); xcd_barrier(bar); }
    if (PROBE == 5) { for (int i = 0; i < 20; ++i) xcd_barrier(bar); }
    layer_phases<0>(P, lds, bar);
    layer_phases<1>(P, lds, bar);
    if (RUN(19)) phase_final(P);
}
#undef RUN
#undef SYNC

extern "C" void kernel_launch(void* const* d_in, const int* in_sizes, int n_in, void* d_out, int out_size, void* d_ws, size_t ws_size, hipStream_t stream) {
    static int grid = 0;
    if (grid == 0) {
        if (n_in != 28 || ws_size < WS_END) { fprintf(stderr, "kernel_launch: need 28 inputs and %zu B of workspace (got %d, %zu)\n", (size_t)WS_END, n_in, ws_size); grid = -1; return; }
        int dev = 0, cus = 0, per_cu = 0;
        hipGetDevice(&dev);
        hipDeviceGetAttribute(&cus, hipDeviceAttributeMultiprocessorCount, dev);
        if (hipFuncSetAttribute((const void*)mk_fwd, hipFuncAttributeMaxDynamicSharedMemorySize, LDS_BYTES) != hipSuccess) { fprintf(stderr, "kernel_launch: hipFuncSetAttribute failed\n"); grid = -1; return; }
        if (hipOccupancyMaxActiveBlocksPerMultiprocessor(&per_cu, (const void*)mk_fwd, NTHREADS, LDS_BYTES) != hipSuccess || per_cu < 1) { fprintf(stderr, "kernel_launch: occupancy query failed (%d)\n", per_cu); per_cu = 1; }
        (void)hipGetLastError();
        grid = cus * per_cu;
    }
    if (grid < 0) return;
    Params p{};
    const float** ip = (const float**)&p;
    for (int i = 0; i < 28; ++i) ip[i] = (const float*)d_in[i];
    p.out = (float*)d_out; p.ws = (unsigned char*)d_ws;
#if MULTI_LAUNCH
    for (int ph = 0; ph < NPHASES; ++ph) {
        p.ph_lo = ph; p.ph_hi = ph + 1;
        hipLaunchKernelGGL(mk_fwd, dim3(grid), dim3(NTHREADS), LDS_BYTES, stream, p);
    }
#else
    p.ph_lo = 0; p.ph_hi = NPHASES;
    void* args[] = {&p};
    hipError_t e = hipLaunchCooperativeKernel((const void*)mk_fwd, dim3(grid), dim3(NTHREADS), args, LDS_BYTES, stream);
    if (e != hipSuccess) fprintf(stderr, "cooperative launch failed: %s (grid %d)\n", hipGetErrorString(e), grid);
#endif
}
```

```cpp
#include <hip/hip_runtime.h>
#include <hip/hip_cooperative_groups.h>
#include <cstdio>
namespace cg = cooperative_groups;

#ifndef MULTI_LAUNCH
#define MULTI_LAUNCH 0
#endif

#ifndef PROBE
#define PROBE 0
#endif
#define LAS __attribute__((address_space(3)))
typedef unsigned short bf16_t;
typedef short bf16x8 __attribute__((ext_vector_type(8)));
typedef float f32x4 __attribute__((ext_vector_type(4)));
typedef unsigned u32x4 __attribute__((ext_vector_type(4)));
typedef unsigned u32x2 __attribute__((ext_vector_type(2)));

constexpr int D = 1024, SEQ = 8192, NBP = 4, NBS = 8, ST = 32;
constexpr int MP = NBP * SEQ;
constexpr int MS = NBS * ST;
constexpr int M = MP + MS;
constexpr int NIN = 5888, DFF = 2816, NUP = 5632;
constexpr int NTHREADS = 512, NWAVES = 8;
constexpr int ZC_Q = 0, ZC_K = 1024, ZC_V = 1152, ZC_PU = 1280, ZC_SU = 1792, ZC_SV = 2304, ZC_G = 2816;
constexpr size_t O_YP = 0;
constexpr size_t O_YS = O_YP + (size_t)MP * D;
constexpr size_t O_KP = O_YS + (size_t)MS * D;
constexpr size_t O_VP = O_KP + 2 * 4 * 128 * 128;
constexpr size_t O_PP = O_VP + 2 * 4 * 128 * 128;
constexpr size_t O_CP = O_PP + 2 * 4 * 15 * 512;
constexpr size_t O_KS = O_CP + 2 * 4 * 2 * DFF;
constexpr size_t O_VS = O_KS + 2 * 8 * 128 * 128;
constexpr size_t O_PS = O_VS + 2 * 8 * 128 * 128;
constexpr size_t O_CS = O_PS + 2 * 8 * 15 * 512;
constexpr size_t O_SV = O_CS + 2 * 8 * 2 * DFF;
constexpr size_t WS_MOD = 4096;
constexpr size_t WS_BAR = 655360;
constexpr size_t WS_W = 1048576;
constexpr size_t WL_IN = 0;
constexpr size_t WL_CAT = WL_IN + (size_t)NIN * D * 2;
constexpr size_t WL_OUT = WL_CAT + (size_t)D * 2048 * 2;
constexpr size_t WL_UP = WL_OUT + (size_t)D * D * 2;
constexpr size_t WL_DN = WL_UP + (size_t)NUP * D * 2;
constexpr size_t WL_PW = WL_DN + (size_t)D * DFF * 2;
constexpr size_t WL_SG = WL_PW + 4 * 128 * 128 * 2;
constexpr size_t WL_SIZE = WL_SG + 4 * 128 * 128 * 2;
constexpr size_t WS_H = WS_W + 2 * WL_SIZE;
constexpr size_t WS_Z = WS_H + (size_t)M * D * 2;
constexpr size_t WS_END = WS_Z + (size_t)M * NIN * 2;
constexpr int LDS_BYTES = 131072 + 8192;

struct Params {
    const float *x_prompt, *x_sample, *c_prompt, *c_sample, *cache_k, *cache_v, *state_pool, *state_conv;
    const float *norm1_g, *norm2_g, *w_ada, *b_ada, *w_in, *attn_sink, *w_o_attn, *pool_w, *pool_scale, *w_o_pool;
    const float *sgu_norm_g, *sgu_w, *sgu_b, *w_o_sgu, *w_out, *ffn_w_up, *ffn_conv_w, *ffn_conv_b, *ffn_w_down, *final_norm_g;
    float* out; unsigned char* ws;
    int ph_lo, ph_hi;
};

typedef __bf16 bf16x2_t __attribute__((ext_vector_type(2)));
typedef float f32x2_t __attribute__((ext_vector_type(2)));
__device__ __forceinline__ unsigned pk2(float lo, float hi) { const f32x2_t v = {lo, hi}; return __builtin_bit_cast(unsigned, __builtin_convertvector(v, bf16x2_t)); }
__device__ __forceinline__ unsigned f2bf(float f) { return pk2(f, 0.f) & 0xffffu; }
__device__ __forceinline__ float bflo(unsigned w) { return __builtin_bit_cast(float, w << 16); }
__device__ __forceinline__ float bfhi(unsigned w) { return __builtin_bit_cast(float, w & 0xffff0000u); }
__device__ __forceinline__ float bf1(bf16_t h) { return __builtin_bit_cast(float, ((unsigned)h) << 16); }
__device__ __forceinline__ float sigmoidf_(float x) { return __builtin_amdgcn_rcpf(1.0f + __builtin_amdgcn_exp2f(-1.4426950408889634f * x)); }
__device__ __forceinline__ float gelu_tanh(float x) { const float e = __builtin_amdgcn_exp2f(x * (-2.3022081985f - 0.1029432347f * x * x)); return x * __builtin_amdgcn_rcpf(1.0f + e); }
__device__ __forceinline__ float wave_sum(float v) {
#pragma unroll
    for (int o = 1; o < 64; o <<= 1) v += __shfl_xor(v, o);
    return v;
}
__device__ __forceinline__ int batch_of_row(int row) { return row < MP ? (row >> 13) : 4 + ((row - MP) >> 5); }

namespace pg8 {
constexpr int BM = 256, BK = 64, HALF = 128, HTB = HALF * BK * 2, NXCD = 8, WGM = 8;
__device__ __forceinline__ int lds_byte(int r, int c) { const int st = (r >> 4) * 2 + (c >> 5), rr = r & 15, cc = c & 31, ob = rr * 64 + cc * 2; return st * 1024 + (ob ^ (((ob >> 9) & 1) << 5)); }
__device__ __forceinline__ void stage_rc(int b, int& R, int& C) { const int st = b / 1024, sb = b % 1024, swz = sb ^ (((sb >> 9) & 1) << 5); R = (st >> 1) * 16 + swz / 64; C = (st & 1) * 32 + (swz % 64) / 2; }
__device__ __forceinline__ int perm32(int rho) { const int n = rho >> 4, i = rho & 15; return 8 * (i >> 2) + 4 * n + (i & 3); }

struct Unit { const char* A; const char* B; int nt, pm, pn, mode; };

__device__ __forceinline__ void tile_of(int wgid, int nM, int nN, int& pm, int& pn) {
    const int nwg = nM * nN;
    { const int q = nwg / NXCD, r = nwg % NXCD, xcd = wgid % NXCD, off = wgid / NXCD; wgid = (xcd < r ? xcd * (q + 1) : r * (q + 1) + (xcd - r) * q) + off; }
    const int nig = WGM * nN, gid = wgid / nig, fm = gid * WGM, gsz = (nM - fm) < WGM ? (nM - fm) : WGM;
    pm = fm + ((wgid % nig) % gsz); pn = (wgid % nig) / gsz;
}

struct SimpleOrder {
    const char* A; const char* B; size_t lda, ldb; int nM, nN, nt, G, c;
    __device__ __forceinline__ bool next(int i, Unit& u) const {
        const long L = (long)i * G + c; if (L >= (long)nM * nN) return false;
        int pm, pn; tile_of((int)L, nM, nN, pm, pn);
        u.pm = pm; u.pn = pn; u.nt = nt; u.mode = 0; u.A = A + (size_t)pm * 256 * lda; u.B = B + (size_t)pn * 256 * ldb; return true;
    }
};
struct MergeOrder {
    const char* A; const char* B; size_t lda, ldb; int nM, nN, G, c;
    __device__ __forceinline__ bool next(int i, Unit& u) const {
        const int ti = i / 3, br = i - ti * 3;
        const long L = (long)ti * G + c; if (L >= (long)nM * nN) return false;
        int pm, pn; tile_of((int)L, nM, nN, pm, pn);
        u.pm = pm; u.pn = pn; u.mode = br;
        const int ak = br == 0 ? ZC_Q : (br == 1 ? ZC_SV : ZC_SU);
        const int bk = br == 0 ? 0 : (br == 1 ? 1024 : 1536);
        u.nt = br == 0 ? 16 : 8;
        u.A = A + (size_t)pm * 256 * lda + (size_t)ak * 2; u.B = B + (size_t)pn * 256 * ldb + (size_t)bk * 2; return true;
    }
};

struct UpOrder {
    const char* A; const char* B; size_t lda, ldb; int nM, nN, nt, G, c;
    __device__ __forceinline__ bool next(int i, Unit& u) const {
        const long L = (long)i * G + c; if (L >= (long)nM * nN) return false;
        int pm, pn; tile_of((int)L, nM, nN, pm, pn);
        u.pm = pm; u.pn = pn; u.nt = nt; u.mode = 0; u.A = A + ((long)pm * 254 - 2) * (long)lda; u.B = B + (size_t)pn * 256 * ldb; return true;
    }
};

template <class Epi, class Sched>
__device__ __forceinline__ void gemm_phase(LAS unsigned char* lds, const size_t lda, const size_t ldb, const Sched& S, const Epi& E) {
    int tid_ = threadIdx.x; asm volatile("" : "+v"(tid_));
    const int tid = tid_, wid = __builtin_amdgcn_readfirstlane(tid >> 6), lane = tid & 63, wr = wid >> 2, wc = wid & 3, fr = lane & 15, fq = lane >> 4;
    unsigned voffA[2], voffB[2];
#pragma unroll
    for (int i = 0; i < 2; ++i) { int R, C; stage_rc(tid * 16 + i * 8192, R, C); const int Rb = Epi::PERM ? ((R & ~31) + perm32(R & 31)) : R;
        voffA[i] = (unsigned)(R * lda + C * 2); voffB[i] = (unsigned)(Rb * ldb + C * 2); }
    const size_t kstep = (size_t)(BK * 2);
    const size_t hstepA = (size_t)HALF * lda, hstepB = (size_t)HALF * ldb;
    const unsigned ldsw = (unsigned)wid * 1024u;
    const int aoff = lds_byte(wr * 64 + fr, fq * 8), boff = lds_byte(wc * 32 + fr, fq * 8);
#define PG8_SA(b, h) (((b) * 2 + (h)) * HTB)
#define PG8_SB(b, h) ((4 + (b) * 2 + (h)) * HTB)
#define PG8_STAGE(bufoff, gbase, voff) do { _Pragma("unroll") for (int _i = 0; _i < 2; ++_i) \
        __builtin_amdgcn_global_load_lds((const unsigned*)((const char*)(gbase) + (voff)[_i]), (LAS unsigned*)(lds + (bufoff) + ldsw + _i * 8192), 16, 0, 0); } while (0)
#define PG8_LDA(dst, b, h) do { _Pragma("unroll") for (int m = 0; m < 4; ++m) _Pragma("unroll") for (int k = 0; k < 2; ++k) dst[m][k] = *(const LAS bf16x8*)(lds + PG8_SA(b, h) + aoff + m * 2048 + k * 1024); } while (0)
#define PG8_LDB(dst, b, h) do { _Pragma("unroll") for (int n = 0; n < 2; ++n) _Pragma("unroll") for (int k = 0; k < 2; ++k) dst[n][k] = *(const LAS bf16x8*)(lds + PG8_SB(b, h) + boff + n * 2048 + k * 1024); } while (0)
#define PG8_MMA(ai, bj, At, Bt) do { __builtin_amdgcn_s_setprio(1); _Pragma("unroll") for (int m = 0; m < 4; ++m) _Pragma("unroll") for (int n = 0; n < 2; ++n) _Pragma("unroll") for (int k = 0; k < 2; ++k) \
        acc[ai][bj][m][n] = __builtin_amdgcn_mfma_f32_16x16x32_bf16(Bt[n][k], At[m][k], acc[ai][bj][m][n], 0, 0, 0); __builtin_amdgcn_s_setprio(0); } while (0)
#define PG8_WAIT_V(n) asm volatile("s_waitcnt vmcnt(" #n ")" ::: "memory")
#define PG8_WAIT_L(n) asm volatile("s_waitcnt lgkmcnt(" #n ")" ::: "memory")
#define PG8_BAR __builtin_amdgcn_s_barrier()
#define PG8_SCHED __builtin_amdgcn_sched_barrier(0)
    Unit cur, nxt; int ui = 0;
    if (!S.next(0, cur)) return;
    f32x4 acc[2][2][4][2];
#pragma unroll
    for (int a = 0; a < 2; ++a)
#pragma unroll
        for (int b = 0; b < 2; ++b)
#pragma unroll
            for (int m = 0; m < 4; ++m)
#pragma unroll
                for (int n = 0; n < 2; ++n) acc[a][b][m][n] = (f32x4){0.f, 0.f, 0.f, 0.f};
    bf16x8 At[4][2], B0[2][2], B1[2][2];
    const char* cA = cur.A; const char* cB = cur.B;
    PG8_STAGE(PG8_SB(0, 0), cB, voffB); PG8_STAGE(PG8_SA(0, 0), cA, voffA); PG8_STAGE(PG8_SB(0, 1), cB + hstepB, voffB); PG8_STAGE(PG8_SA(0, 1), cA + hstepA, voffA);
    if (wr == 1) PG8_BAR;
    PG8_WAIT_V(4); PG8_BAR;
    PG8_STAGE(PG8_SB(1, 0), cB + kstep, voffB); PG8_STAGE(PG8_SA(1, 0), cA + kstep, voffA); PG8_STAGE(PG8_SB(1, 1), cB + hstepB + kstep, voffB);
    PG8_WAIT_V(6); PG8_BAR;
    for (;;) {
        const bool has_next = S.next(ui + 1, nxt);
        const char* nA = has_next ? nxt.A : cA; const char* nB = has_next ? nxt.B : cB;
        const int nt = cur.nt;
        for (int t = 0; t < nt; t += 2) {
            const bool last = (t == nt - 2);
            const char* a1 = cA + (size_t)(t + 1) * kstep;
            const char* a2 = last ? nA : cA + (size_t)(t + 2) * kstep; const char* b2 = last ? nB : cB + (size_t)(t + 2) * kstep;
            const char* a3 = a2 + kstep; const char* b3 = b2 + kstep;
            PG8_LDB(B0, 0, 0); PG8_SCHED; PG8_LDA(At, 0, 0); PG8_STAGE(PG8_SA(1, 1), a1 + hstepA, voffA);
            PG8_WAIT_L(8); PG8_BAR; PG8_WAIT_L(0); PG8_MMA(0, 0, At, B0); PG8_BAR; PG8_SCHED;
            PG8_LDB(B1, 0, 1); PG8_STAGE(PG8_SB(0, 0), b2, voffB);
            PG8_BAR; PG8_WAIT_L(0); PG8_MMA(0, 1, At, B1); PG8_BAR;
            PG8_LDA(At, 0, 1); PG8_STAGE(PG8_SA(0, 0), a2, voffA);
            PG8_BAR; PG8_WAIT_L(0); PG8_MMA(1, 0, At, B0); PG8_BAR; PG8_SCHED;
            PG8_STAGE(PG8_SB(0, 1), b2 + hstepB, voffB);
            PG8_WAIT_V(6); PG8_BAR; PG8_MMA(1, 1, At, B1); PG8_BAR;
            PG8_LDB(B0, 1, 0); PG8_SCHED; PG8_LDA(At, 1, 0); PG8_STAGE(PG8_SA(0, 1), a2 + hstepA, voffA);
            PG8_WAIT_L(8); PG8_BAR; PG8_WAIT_L(0); PG8_MMA(0, 0, At, B0); PG8_BAR; PG8_SCHED;
            PG8_LDB(B1, 1, 1); PG8_STAGE(PG8_SB(1, 0), b3, voffB);
            PG8_BAR; PG8_WAIT_L(0); PG8_MMA(0, 1, At, B1); PG8_BAR;
            PG8_LDA(At, 1, 1); PG8_STAGE(PG8_SA(1, 0), a3, voffA);
            PG8_BAR; PG8_WAIT_L(0); PG8_MMA(1, 0, At, B0); PG8_BAR; PG8_SCHED;
            PG8_STAGE(PG8_SB(1, 1), b3 + hstepB, voffB);
            PG8_WAIT_V(6); PG8_BAR; PG8_MMA(1, 1, At, B1); PG8_BAR;
        }
        if (wr == 0) PG8_BAR;
        E(acc, cur, wr, wc, fr, fq);
        if (!has_next) break;
#pragma unroll
        for (int a = 0; a < 2; ++a)
#pragma unroll
            for (int b = 0; b < 2; ++b)
#pragma unroll
                for (int m = 0; m < 4; ++m)
#pragma unroll
                    for (int n = 0; n < 2; ++n) acc[a][b][m][n] = (f32x4){0.f, 0.f, 0.f, 0.f};
        cur = nxt; cA = nA; cB = nB; ++ui;
        if (wr == 1) PG8_BAR;
    }
    PG8_WAIT_V(0);
    PG8_BAR;
#undef PG8_SA
#undef PG8_SB
#undef PG8_STAGE
#undef PG8_LDA
#undef PG8_LDB
#undef PG8_MMA
#undef PG8_WAIT_V
#undef PG8_WAIT_L
#undef PG8_BAR
#undef PG8_SCHED
}
}

struct EpiZ {
    static constexpr bool PERM = true;
    bf16_t* Z; float* out; int layer;
    __device__ __forceinline__ void operator()(const f32x4 (&acc)[2][2][4][2], const pg8::Unit& u, int wr, int wc, int fr, int fq) const {
        const int pn = u.pn;
#pragma unroll
        for (int ai = 0; ai < 2; ++ai)
#pragma unroll
            for (int m = 0; m < 4; ++m) {
                const int row = u.pm * 256 + ai * 128 + wr * 64 + m * 16 + fr;
                int b, t; const bool samp = row >= MP;
                if (!samp) { b = row >> 13; t = row & 8191; } else { b = (row - MP) >> 5; t = (row - MP) & 31; }
#pragma unroll
                for (int bj = 0; bj < 2; ++bj) {
                    const int col0 = pn * 256 + bj * 128 + wc * 32 + 8 * fq;
                    f32x4 v0 = acc[ai][bj][m][0], v1 = acc[ai][bj][m][1];
                    if (pn == 4) {
                        const int cc = col0 - ZC_K; float* dst = nullptr;
                        if (!samp) { if (t >= SEQ - 128) dst = out + (cc < 128 ? O_KP : O_VP) + ((size_t)((layer * 4 + b) * 128 + (t - (SEQ - 128))) * 128 + (cc & 127)); }
                        else dst = out + (cc < 128 ? O_KS : O_VS) + ((size_t)((layer * 8 + b) * 128 + 96 + t) * 128 + (cc & 127));
                        if (dst) { *(f32x4*)dst = v0; *(f32x4*)(dst + 4) = v1; }
                    } else if (pn == 5 || pn == 6) {
                        const int cc = col0 - ZC_PU; float* dst = nullptr;
                        if (!samp) { if (t >= SEQ - 15) dst = out + O_PP + ((size_t)((layer * 4 + b) * 15 + (t - (SEQ - 15))) * 512 + cc); }
                        else { if (t >= ST - 15) dst = out + O_PS + ((size_t)((layer * 8 + b) * 15 + (t - (ST - 15))) * 512 + cc); }
                        if (dst) { *(f32x4*)dst = v0; *(f32x4*)(dst + 4) = v1; }
                    }
                    if (pn >= 11) {
#pragma unroll
                        for (int j = 0; j < 4; ++j) { v0[j] = sigmoidf_(v0[j]); v1[j] = sigmoidf_(v1[j]); }
                    } else if (pn >= 7) {
#pragma unroll
                        for (int j = 0; j < 4; ++j) { v0[j] = gelu_tanh(v0[j]); v1[j] = gelu_tanh(v1[j]); }
                    }
                    u32x4 w; w.x = pk2(v0[0], v0[1]); w.y = pk2(v0[2], v0[3]); w.z = pk2(v1[0], v1[1]); w.w = pk2(v1[2], v1[3]);
                    *(u32x4*)(Z + (size_t)row * NIN + col0) = w;
                }
            }
    }
};
struct EpiMerge {
    static constexpr bool PERM = true;
    const bf16_t* Z; bf16_t* MG;
    __device__ __forceinline__ void operator()(const f32x4 (&acc)[2][2][4][2], const pg8::Unit& u, int wr, int wc, int fr, int fq) const {
        const int mode = u.mode;
#pragma unroll
        for (int ai = 0; ai < 2; ++ai)
#pragma unroll
            for (int m = 0; m < 4; ++m) {
                const int row = u.pm * 256 + ai * 128 + wr * 64 + m * 16 + fr;
#pragma unroll
                for (int bj = 0; bj < 2; ++bj) {
                    const int col0 = u.pn * 256 + bj * 128 + wc * 32 + 8 * fq;
                    const u32x4 g = *(const u32x4*)(Z + (size_t)row * NIN + ZC_G + mode * 1024 + col0);
                    f32x4 v0 = acc[ai][bj][m][0], v1 = acc[ai][bj][m][1];
                    v0[0] *= bflo(g.x); v0[1] *= bfhi(g.x); v0[2] *= bflo(g.y); v0[3] *= bfhi(g.y);
                    v1[0] *= bflo(g.z); v1[1] *= bfhi(g.z); v1[2] *= bflo(g.w); v1[3] *= bfhi(g.w);
                    bf16_t* mp = MG + (size_t)row * D + col0;
                    if (mode != 0) { const u32x4 o = *(const u32x4*)mp;
                        v0[0] += bflo(o.x); v0[1] += bfhi(o.x); v0[2] += bflo(o.y); v0[3] += bfhi(o.y);
                        v1[0] += bflo(o.z); v1[1] += bfhi(o.z); v1[2] += bflo(o.w); v1[3] += bfhi(o.w); }
                    u32x4 w; w.x = pk2(v0[0], v0[1]); w.y = pk2(v0[2], v0[3]); w.z = pk2(v1[0], v1[1]); w.w = pk2(v1[2], v1[3]);
                    *(u32x4*)mp = w;
                }
            }
    }
};
struct EpiRes {
    static constexpr bool PERM = false;
    const float* srcp; const float* srcs; float* X; const float* gmod;
    __device__ __forceinline__ void operator()(const f32x4 (&acc)[2][2][4][2], const pg8::Unit& u, int wr, int wc, int fr, int fq) const {
#pragma unroll
        for (int ai = 0; ai < 2; ++ai)
#pragma unroll
            for (int m = 0; m < 4; ++m) {
                const int row = u.pm * 256 + ai * 128 + wr * 64 + m * 16 + fr;
                const float* sp = row < MP ? srcp + (size_t)row * D : srcs + (size_t)(row - MP) * D;
                const float* gp = gmod + (size_t)batch_of_row(row) * 6144;
                float* xp = X + (size_t)row * D;
#pragma unroll
                for (int bj = 0; bj < 2; ++bj)
#pragma unroll
                    for (int n = 0; n < 2; ++n) {
                        const int col = u.pn * 256 + bj * 128 + wc * 32 + 16 * n + 4 * fq;
                        const f32x4 s = *(const f32x4*)(sp + col), g = *(const f32x4*)(gp + col);
                        *(f32x4*)(xp + col) = s + g * acc[ai][bj][m][n];
                    }
            }
    }
};
constexpr int XCH_OFF = 131072;
struct EpiUpConv {
    static constexpr bool PERM = true;
    bf16_t* Gb; float* out; const float* cw; const float* cb; const float* pref; int layer; LAS unsigned char* lds;
    __device__ __forceinline__ void operator()(const f32x4 (&acc)[2][2][4][2], const pg8::Unit& u, int wr, int wc, int fr, int fq) const {
        const int lane = fq * 16 + fr;
        LAS float* xch = (LAS float*)(lds + XCH_OFF);
        const int cl = wc * 32 + 8 * fq;
#pragma unroll
        for (int ai = 0; ai < 2; ++ai) {
            const int bnd = 2 * ai + wr;
            if (bnd < 3 && fr >= 14) {
                *(LAS f32x4*)(xch + (bnd * 2 + (fr - 14)) * 128 + cl) = acc[ai][0][3][0];
                *(LAS f32x4*)(xch + (bnd * 2 + (fr - 14)) * 128 + cl + 4) = acc[ai][0][3][1];
            }
        }
        asm volatile("s_waitcnt lgkmcnt(0)" ::: "memory"); __builtin_amdgcn_s_barrier(); asm volatile("" ::: "memory");
        const int rbase = u.pm * 254 - 2;
#pragma unroll
        for (int n = 0; n < 2; ++n) {
            const int f0 = u.pn * 128 + cl + 4 * n;
            const f32x4 w0 = *(const f32x4*)(cw + f0), w1 = *(const f32x4*)(cw + DFF + f0), w2 = *(const f32x4*)(cw + 2 * DFF + f0), bb = *(const f32x4*)(cb + f0);
#pragma unroll
            for (int ai = 0; ai < 2; ++ai) {
                const int bp = 2 * ai + wr - 1 < 0 ? 0 : 2 * ai + wr - 1;
                const f32x4 x1 = *(const LAS f32x4*)(xch + (bp * 2 + 1) * 128 + cl + 4 * n), x2 = *(const LAS f32x4*)(xch + (bp * 2 + (fr & 1)) * 128 + cl + 4 * n);
#pragma unroll
                for (int m = 0; m < 4; ++m) {
                    const int tl = ai * 128 + wr * 64 + m * 16 + fr, row = rbase + tl;
                    int t, sb = 0; const bool samp = row >= MP;
                    if (!samp) t = row & 8191; else { t = (row - MP) & 31; sb = (row - MP) >> 5; }
                    const bool valid = tl >= 2 && row < M;
                    f32x4 p1 = (f32x4){0.f, 0.f, 0.f, 0.f}, p0 = p1;
                    if (samp && t < 2 && row < M) { const float* pp = pref + (size_t)sb * 2 * DFF + f0; p0 = *(const f32x4*)pp; p1 = *(const f32x4*)(pp + DFF); }
                    float gv[4];
#pragma unroll
                    for (int j = 0; j < 4; ++j) {
                        const float cur = acc[ai][0][m][n][j];
                        const int curi = __float_as_int(cur);
                        int q1i, q2i;
                        if (m > 0) {
                            const float prvf = acc[ai][0][m > 0 ? m - 1 : 0][n][j]; const int prv = __float_as_int(prvf);
                            q1i = __builtin_amdgcn_update_dpp(0, prv, 0x121, 0xf, 0xf, false);
                            q2i = __builtin_amdgcn_update_dpp(0, prv, 0x122, 0xf, 0xf, false);
                        } else { const float x1f = x1[j], x2f = x2[j]; q1i = __float_as_int(x1f); q2i = __float_as_int(x2f); }
                        float up1 = __int_as_float(__builtin_amdgcn_update_dpp(q1i, curi, 0x111, 0xf, 0xf, false));
                        float up2 = __int_as_float(__builtin_amdgcn_update_dpp(q2i, curi, 0x112, 0xf, 0xf, false));
                        if (t < 2) { if (t == 0) { up1 = p1[j]; up2 = p0[j]; } else { up2 = p1[j]; } }
                        const float cv = up2 * w0[j] + up1 * w1[j] + cur * w2[j] + bb[j];
                        gv[j] = gelu_tanh(cv) * acc[ai][1][m][n][j];
                    }
                    if (valid) {
                        int b, tt; if (!samp) { b = row >> 13; tt = t - (SEQ - 2); } else { b = sb; tt = t - (ST - 2); }
                        if (tt >= 0) *(f32x4*)(out + (samp ? O_CS : O_CP) + ((size_t)((layer * (samp ? 8 : 4) + b) * 2 + tt) * DFF + f0)) = acc[ai][0][m][n];
                        u32x2 w; w.x = pk2(gv[0], gv[1]); w.y = pk2(gv[2], gv[3]);
                        *(u32x2*)(Gb + (size_t)row * DFF + f0) = w;
                    }
                }
            }
        }
    }
};

template <bool UPMAP = false>
__device__ __forceinline__ void p0_transpose_item(const float* W, int N, bf16_t* WT, size_t ldt, int col_off, LAS float* scr, int item, int lane) {
    const int nblk = N / 32, kb = item / nblk, nb = item % nblk, k0 = 64 * kb, n0 = 32 * nb;
    const int r0 = UPMAP ? (n0 < DFF ? 256 * (n0 >> 7) + (n0 & 127) : 256 * ((n0 - DFF) >> 7) + 128 + ((n0 - DFF) & 127)) : n0;
#pragma unroll 8
    for (int i = 0; i < 32; ++i) { const int kk = 2 * i + (lane >> 5); scr[kk * 33 + (lane & 31)] = W[(size_t)(k0 + kk) * N + n0 + (lane & 31)]; }
    asm volatile("s_waitcnt lgkmcnt(0)" ::: "memory");
    const int c = lane & 7;
#pragma unroll
    for (int j = 0; j < 4; ++j) { const int n = (lane >> 3) + 8 * j; const LAS float* s = scr + (8 * c) * 33 + n;
        u32x4 o; o.x = pk2(s[0 * 33], s[1 * 33]); o.y = pk2(s[2 * 33], s[3 * 33]); o.z = pk2(s[4 * 33], s[5 * 33]); o.w = pk2(s[6 * 33], s[7 * 33]);
        *(u32x4*)(WT + (size_t)(r0 + n) * ldt + col_off + k0 + 8 * c) = o; }
    asm volatile("s_waitcnt lgkmcnt(0)" ::: "memory");
}

__device__ __forceinline__ void phase_p0(const Params& P, LAS unsigned char* lds) {
    const int tid = threadIdx.x, lane = tid & 63, wave = tid >> 6;
    const int G = gridDim.x, gw = blockIdx.x * NWAVES + wave, NGW = G * NWAVES;
    LAS float* scr = (LAS float*)(lds + wave * 8704);
    constexpr int I_IN = 16 * (NIN / 32), I_OA = 16 * 32, I_OP = 8 * 32, I_OS = 8 * 32, I_OUT = 16 * 32, I_UP = 16 * (NUP / 32), I_DN = (DFF / 64) * 32, I_PW = 4 * 2 * 4;
    constexpr int I_L = I_IN + I_OA + I_OP + I_OS + I_OUT + I_UP + I_DN + I_PW;
    for (int it = gw; it < 2 * I_L; it += NGW) {
        const int l = it / I_L; int r = it - l * I_L;
        unsigned char* wl = P.ws + WS_W + (size_t)l * WL_SIZE;
        if (r < I_IN) { p0_transpose_item(P.w_in + (size_t)l * D * NIN, NIN, (bf16_t*)(wl + WL_IN), D, 0, scr, r, lane); continue; } r -= I_IN;
        if (r < I_OA) { p0_transpose_item(P.w_o_attn + (size_t)l * D * D, D, (bf16_t*)(wl + WL_CAT), 2048, 0, scr, r, lane); continue; } r -= I_OA;
        if (r < I_OP) { p0_transpose_item(P.w_o_pool + (size_t)l * 512 * D, D, (bf16_t*)(wl + WL_CAT), 2048, 1024, scr, r, lane); continue; } r -= I_OP;
        if (r < I_OS) { p0_transpose_item(P.w_o_sgu + (size_t)l * 512 * D, D, (bf16_t*)(wl + WL_CAT), 2048, 1536, scr, r, lane); continue; } r -= I_OS;
        if (r < I_OUT) { p0_transpose_item(P.w_out + (size_t)l * D * D, D, (bf16_t*)(wl + WL_OUT), D, 0, scr, r, lane); continue; } r -= I_OUT;
        if (r < I_UP) { p0_transpose_item<true>(P.ffn_w_up + (size_t)l * D * NUP, NUP, (bf16_t*)(wl + WL_UP), D, 0, scr, r, lane); continue; } r -= I_UP;
        if (r < I_DN) { p0_transpose_item(P.ffn_w_down + (size_t)l * DFF * D, D, (bf16_t*)(wl + WL_DN), DFF, 0, scr, r, lane); continue; } r -= I_DN;
        { const int g = r >> 3, rr = r & 7;
          p0_transpose_item(P.pool_w + ((size_t)l * 4 + g) * 128 * 128, 128, (bf16_t*)(wl + WL_PW) + (size_t)g * 128 * 128, 128, 0, scr, rr, lane); }
    }
    const int gt = blockIdx.x * NTHREADS + tid, NGT = G * NTHREADS;
    for (int e = gt; e < 2 * 4 * 128 * 128; e += NGT) {
        const int l = e >> 16, r = e & 65535, i = (r >> 7) & 127, j = r & 127;
        const float v = ((j >> 6) <= (i >> 6)) ? P.sgu_w[e] : 0.f;
        ((bf16_t*)(P.ws + WS_W + (size_t)l * WL_SIZE + WL_SG))[r] = (bf16_t)f2bf(v);
    }
    for (int e = gt; e < 2 * 8 * 96 * 128; e += NGT) {
        const int lb = e / (96 * 128), r = e - lb * (96 * 128);
        P.out[O_KS + (size_t)lb * 128 * 128 + r] = P.cache_k[(size_t)lb * 128 * 128 + 32 * 128 + r];
        P.out[O_VS + (size_t)lb * 128 * 128 + r] = P.cache_v[(size_t)lb * 128 * 128 + 32 * 128 + r];
    }
    __syncthreads();
    LAS float* part = (LAS float*)lds;
    for (int it = blockIdx.x; it < 2 * 96; it += G) {
        const int l = it / 96, e0 = (it % 96) * 64;
        float acc[12];
#pragma unroll
        for (int b = 0; b < 12; ++b) acc[b] = 0.f;
        const float* wp = P.w_ada + (size_t)l * D * 6144 + e0 + lane;
        for (int d = wave * 128; d < wave * 128 + 128; ++d) {
            const float wv = wp[(size_t)d * 6144];
#pragma unroll
            for (int b = 0; b < 12; ++b) { const float cv = b < 4 ? P.c_prompt[b * D + d] : P.c_sample[(b - 4) * D + d]; acc[b] += cv * sigmoidf_(cv) * wv; }
        }
#pragma unroll
        for (int b = 0; b < 12; ++b) part[(wave * 12 + b) * 64 + lane] = acc[b];
        __syncthreads();
        for (int o = tid; o < 12 * 64; o += NTHREADS) {
            const int b = o >> 6, c = o & 63; float s = P.b_ada[(size_t)l * 6144 + e0 + c];
#pragma unroll
            for (int w = 0; w < 8; ++w) s += part[(w * 12 + b) * 64 + c];
            ((float*)(P.ws + WS_MOD))[((size_t)l * 12 + b) * 6144 + e0 + c] = s;
        }
        __syncthreads();
    }
}

__device__ __forceinline__ void phase_norm(const Params& P, const float* srcp, const float* srcs, const float* g, const float* mod_sh, const float* mod_sc) {
    const int lane = threadIdx.x & 63, wave = threadIdx.x >> 6;
    const int gw = blockIdx.x * NWAVES + wave, NGW = gridDim.x * NWAVES;
    bf16_t* H = (bf16_t*)(P.ws + WS_H);
    for (int row = gw; row < M; row += NGW) {
        const float* xr = row < MP ? srcp + (size_t)row * D : srcs + (size_t)(row - MP) * D;
        const int b = batch_of_row(row);
        f32x4 v[4]; float s = 0.f;
#pragma unroll
        for (int j = 0; j < 4; ++j) { v[j] = *(const f32x4*)(xr + 4 * lane + 256 * j); s += (v[j][0] * v[j][0] + v[j][1] * v[j][1]) + (v[j][2] * v[j][2] + v[j][3] * v[j][3]); }
        const float rstd = rsqrtf(wave_sum(s) * (1.f / D) + 1e-6f);
#pragma unroll
        for (int j = 0; j < 4; ++j) {
            const int c = 4 * lane + 256 * j;
            const f32x4 gg = *(const f32x4*)(g + c), sc = *(const f32x4*)(mod_sc + (size_t)b * 6144 + c), sh = *(const f32x4*)(mod_sh + (size_t)b * 6144 + c);
            f32x4 h = v[j] * rstd * gg * (sc + 1.0f) + sh;
            u32x2 w; w.x = pk2(h[0], h[1]); w.y = pk2(h[2], h[3]);
            *(u32x2*)(H + (size_t)row * D + c) = w;
        }
    }
}
__device__ __forceinline__ void phase_final(const Params& P) {
    const int lane = threadIdx.x & 63, wave = threadIdx.x >> 6;
    const int gw = blockIdx.x * NWAVES + wave, NGW = gridDim.x * NWAVES;
    for (int row = gw; row < M; row += NGW) {
        float* xr = P.out + (size_t)row * D;
        f32x4 v[4]; float s = 0.f;
#pragma unroll
        for (int j = 0; j < 4; ++j) { v[j] = *(const f32x4*)(xr + 4 * lane + 256 * j); s += (v[j][0] * v[j][0] + v[j][1] * v[j][1]) + (v[j][2] * v[j][2] + v[j][3] * v[j][3]); }
        const float rstd = rsqrtf(wave_sum(s) * (1.f / D) + 1e-6f);
#pragma unroll
        for (int j = 0; j < 4; ++j) { const int c = 4 * lane + 256 * j; const f32x4 gg = *(const f32x4*)(P.final_norm_g + c); *(f32x4*)(xr + c) = v[j] * rstd * gg; }
    }
}

constexpr int KS_STRIDE = 144;
constexpr int VT_STRIDE = 400;
constexpr int ATT_KS = 0, ATT_VT = 192 * KS_STRIDE;

__device__ __forceinline__ void attn_item(const Params& P, int layer, int item, LAS unsigned char* lds, const bool dry = false) {
    const int tid = threadIdx.x, lane = tid & 63, wave = tid >> 6, fr = lane & 15, fq = lane >> 4;
    bf16_t* Z = (bf16_t*)(P.ws + WS_Z);
    const bool samp = item >= 1024;
    int kvh, c = 0, sb = 0, qrow0, klo, khi, nqt;
    if (!samp) { kvh = item & 1; c = (item >> 1) & 127; const int b = item >> 8; qrow0 = b * SEQ + 64 * c; klo = 128 - 64 * (c < 2 ? c : 2); khi = 192; nqt = 4; }
    else { const int s = item - 1024; kvh = s & 1; sb = s >> 1; qrow0 = MP + sb * ST; klo = 0; khi = 160; nqt = 2; }
    __syncthreads();
    const int h = kvh * 8 + wave;
    bf16x8 qc0, qc1;
    { const bf16_t* qp = Z + (size_t)(qrow0 + fr) * NIN + h * 64; qc0 = *(const bf16x8*)(qp + 8 * fq); qc1 = *(const bf16x8*)(qp + 32 + 8 * fq); }
    {
        const int ch = tid & 7, key0 = tid >> 3;
#pragma unroll
        for (int p = 0; p < 3; ++p) {
            const int j = key0 + 64 * p;
            u32x4 kk = (u32x4){0u, 0u, 0u, 0u}, vv = (u32x4){0u, 0u, 0u, 0u};
            if (j >= klo && j < khi) {
                if (samp && j < 128) {
                    const float* kp = P.cache_k + ((((size_t)layer * 8 + sb) * 128 + j) * 2 + kvh) * 64 + ch * 8;
                    const float* vp = P.cache_v + ((((size_t)layer * 8 + sb) * 128 + j) * 2 + kvh) * 64 + ch * 8;
                    const f32x4 k0 = *(const f32x4*)kp, k1 = *(const f32x4*)(kp + 4), v0 = *(const f32x4*)vp, v1 = *(const f32x4*)(vp + 4);
                    kk.x = pk2(k0[0], k0[1]); kk.y = pk2(k0[2], k0[3]); kk.z = pk2(k1[0], k1[1]); kk.w = pk2(k1[2], k1[3]);
                    vv.x = pk2(v0[0], v0[1]); vv.y = pk2(v0[2], v0[3]); vv.z = pk2(v1[0], v1[1]); vv.w = pk2(v1[2], v1[3]);
                } else {
                    const int row = samp ? (qrow0 + j - 128) : (qrow0 - 128 + j);
                    const bf16_t* zp = Z + (size_t)row * NIN + kvh * 64 + ch * 8;
                    kk = *(const u32x4*)(zp + ZC_K); vv = *(const u32x4*)(zp + ZC_V);
                }
            }
            *(LAS u32x4*)(lds + ATT_KS + j * KS_STRIDE + ch * 16) = kk;
            LAS bf16_t* vt = (LAS bf16_t*)(lds + ATT_VT + (ch * 8) * VT_STRIDE + j * 2);
            vt[0 * (VT_STRIDE / 2)] = (bf16_t)(vv.x & 0xffff); vt[1 * (VT_STRIDE / 2)] = (bf16_t)(vv.x >> 16);
            vt[2 * (VT_STRIDE / 2)] = (bf16_t)(vv.y & 0xffff); vt[3 * (VT_STRIDE / 2)] = (bf16_t)(vv.y >> 16);
            vt[4 * (VT_STRIDE / 2)] = (bf16_t)(vv.z & 0xffff); vt[5 * (VT_STRIDE / 2)] = (bf16_t)(vv.z >> 16);
            vt[6 * (VT_STRIDE / 2)] = (bf16_t)(vv.w & 0xffff); vt[7 * (VT_STRIDE / 2)] = (bf16_t)(vv.w >> 16);
        }
    }
    __syncthreads();
    const float slope = exp2f(-0.5f * (float)(h + 1)) * 1.4426950408889634f;
    const float sink = P.attn_sink[layer * 16 + h] * 1.4426950408889634f;
    const bool need_mask = klo > 0 || khi < 192;
#pragma unroll 1
    for (int qt = 0; qt < nqt; ++qt) {
        const int qrow = qrow0 + 16 * qt + fr;
        bf16_t* qp = Z + (size_t)qrow * NIN + h * 64;
        const bf16x8 q0 = qc0, q1 = qc1;
        { const bf16_t* qn = Z + (size_t)(qrow0 + 16 * (qt + 1 < nqt ? qt + 1 : qt) + fr) * NIN + h * 64;
          qc0 = *(const bf16x8*)(qn + 8 * fq); qc1 = *(const bf16x8*)(qn + 32 + 8 * fq); }
        f32x4 st[12];
#pragma unroll
        for (int kt = 0; kt < 12; ++kt) {
            const LAS unsigned char* kp = lds + ATT_KS + (16 * kt + fr) * KS_STRIDE + 16 * fq;
            const bf16x8 a0 = *(const LAS bf16x8*)kp, a1 = *(const LAS bf16x8*)(kp + 64);
            f32x4 a = (f32x4){0.f, 0.f, 0.f, 0.f};
            a = __builtin_amdgcn_mfma_f32_16x16x32_bf16(a0, q0, a, 0, 0, 0);
            a = __builtin_amdgcn_mfma_f32_16x16x32_bf16(a1, q1, a, 0, 0, 0);
            st[kt] = a;
            if ((kt & 3) == 3) asm volatile("" ::: "memory");
        }
        const float d0 = (float)(128 + 16 * qt + fr - 4 * fq);
        float mx = -INFINITY;
#pragma unroll
        for (int kt = 0; kt < 12; ++kt)
#pragma unroll
            for (int jj = 0; jj < 4; ++jj) {
                const float t = slope * fabsf(d0 - (float)(16 * kt + jj));
                float lg = st[kt][jj] * (0.125f * 1.4426950408889634f) - t;
                if (need_mask) { const int key = 16 * kt + 4 * fq + jj; lg = (key >= klo && key < khi) ? lg : -INFINITY; }
                st[kt][jj] = lg; mx = fmaxf(mx, lg);
            }
        mx = fmaxf(mx, __shfl_xor(mx, 16)); mx = fmaxf(mx, __shfl_xor(mx, 32));
        mx = fmaxf(mx, sink);
        float sum = 0.f;
#pragma unroll
        for (int kt = 0; kt < 12; ++kt)
#pragma unroll
            for (int jj = 0; jj < 4; ++jj) { const float p = __builtin_amdgcn_exp2f(st[kt][jj] - mx); st[kt][jj] = p; sum += p; }
        sum += __shfl_xor(sum, 16); sum += __shfl_xor(sum, 32);
        const float inv = __builtin_amdgcn_rcpf(sum + __builtin_amdgcn_exp2f(sink - mx));
        bf16x8 pb[6];
#pragma unroll
        for (int s = 0; s < 6; ++s) {
            u32x4 w; w.x = pk2(st[2 * s][0], st[2 * s][1]); w.y = pk2(st[2 * s][2], st[2 * s][3]);
            w.z = pk2(st[2 * s + 1][0], st[2 * s + 1][1]); w.w = pk2(st[2 * s + 1][2], st[2 * s + 1][3]);
            pb[s] = __builtin_bit_cast(bf16x8, w);
        }
#pragma unroll 1
        for (int dt = 0; dt < 4; ++dt) {
            f32x4 o = (f32x4){0.f, 0.f, 0.f, 0.f};
#pragma unroll
            for (int s = 0; s < 6; ++s) {
                const LAS unsigned char* vp = lds + ATT_VT + (16 * dt + fr) * VT_STRIDE + (32 * s + 4 * fq) * 2;
                const u32x2 lo = *(const LAS u32x2*)vp, hi = *(const LAS u32x2*)(vp + 32);
                const u32x4 av = (u32x4){lo.x, lo.y, hi.x, hi.y};
                o = __builtin_amdgcn_mfma_f32_16x16x32_bf16(__builtin_bit_cast(bf16x8, av), pb[s], o, 0, 0, 0);
            }
            u32x2 w; w.x = pk2(o[0] * inv, o[1] * inv); w.y = pk2(o[2] * inv, o[3] * inv);
            if (!dry) *(u32x2*)(qp + 16 * dt + 4 * fq) = w;
        }
    }
}

constexpr int MX_RS = 0, MX_VNT = 1024, MX_U = 36864, MX_DT = 76800, MX_ST = 272;
__device__ __forceinline__ void mix_item(const Params& P, int layer, int item, LAS unsigned char* lds, const bool dry = false) {
    const int tid = threadIdx.x, lane = tid & 63, wave = tid >> 6, fr = lane & 15, fq = lane >> 4;
    bf16_t* Z = (bf16_t*)(P.ws + WS_Z);
    const unsigned char* wl = P.ws + WS_W + (size_t)layer * WL_SIZE;
    const bool samp = item >= 256;
    int row0, L, t0, sb = 0;
    if (!samp) { const int b = item >> 6, ch = item & 63; row0 = b * SEQ + ch * 128; L = 128; t0 = ch * 128; }
    else { sb = item - 256; row0 = MP + sb * ST; L = ST; t0 = 0; }
    LAS float* RS = (LAS float*)(lds + MX_RS);
    const bool act = wave * 16 < L;
    __syncthreads();
    {
        u32x4 rw[16];
#pragma unroll
        for (int k = 0; k < 16; ++k) { const int i = wave * 16 + k; rw[k] = (u32x4){0u, 0u, 0u, 0u}; if (i < L) rw[k] = *(const u32x4*)(Z + (size_t)(row0 + i) * NIN + ZC_SV + lane * 8); }
#pragma unroll
        for (int k = 0; k < 16; ++k) {
            const u32x4 w = rw[k];
            float s = bflo(w.x) * bflo(w.x) + bfhi(w.x) * bfhi(w.x) + bflo(w.y) * bflo(w.y) + bfhi(w.y) * bfhi(w.y)
                    + bflo(w.z) * bflo(w.z) + bfhi(w.z) * bfhi(w.z) + bflo(w.w) * bflo(w.w) + bfhi(w.w) * bfhi(w.w);
            s = wave_sum(s);
            if (lane == 0) RS[wave * 16 + k] = rsqrtf(s * (1.f / 512.f) + 1e-6f);
        }
    }
    u32x4 svr[4];
#pragma unroll
    for (int p = 0; p < 4; ++p) { const int idx = tid + NTHREADS * p, j = idx >> 4, c8 = idx & 15; svr[p] = (u32x4){0u, 0u, 0u, 0u};
        if (j < L) svr[p] = *(const u32x4*)(Z + (size_t)(row0 + j) * NIN + ZC_SV + c8 * 8); }
    __syncthreads();
#pragma unroll 1
    for (int g = 0; g < 4; ++g) {
#pragma unroll
        for (int p = 0; p < 4; ++p) {
            const int idx = tid + NTHREADS * p, j = idx >> 4, c8 = idx & 15;
            float vn[8];
            if (j < L) {
                const u32x4 w = svr[p];
                const float rs = RS[j]; const float* ng = P.sgu_norm_g + layer * 512 + g * 128 + c8 * 8;
                const f32x4 n0 = *(const f32x4*)ng, n1 = *(const f32x4*)(ng + 4);
                vn[0] = bflo(w.x) * rs * n0[0]; vn[1] = bfhi(w.x) * rs * n0[1]; vn[2] = bflo(w.y) * rs * n0[2]; vn[3] = bfhi(w.y) * rs * n0[3];
                vn[4] = bflo(w.z) * rs * n1[0]; vn[5] = bfhi(w.z) * rs * n1[1]; vn[6] = bflo(w.w) * rs * n1[2]; vn[7] = bfhi(w.w) * rs * n1[3];
                if (samp) { float* dst = P.out + O_SV + ((size_t)((layer * 8 + sb) * ST + j)) * 512 + g * 128 + c8 * 8;
                    *(f32x4*)dst = (f32x4){vn[0], vn[1], vn[2], vn[3]}; *(f32x4*)(dst + 4) = (f32x4){vn[4], vn[5], vn[6], vn[7]}; }
            } else {
#pragma unroll
                for (int e = 0; e < 8; ++e) vn[e] = 0.f;
            }
            LAS bf16_t* vt = (LAS bf16_t*)(lds + MX_VNT + (c8 * 8) * MX_ST + j * 2);
#pragma unroll
            for (int e = 0; e < 8; ++e) vt[e * (MX_ST / 2)] = (bf16_t)f2bf(vn[e]);
        }
        const int i = wave * 16 + fr;
        bf16_t* zrow = Z + (size_t)(row0 + (act ? i : 0)) * NIN + ZC_SU + g * 128 + 4 * fq;
        bf16x8 wf[4]; u32x2 uu[8];
        {
            const bf16_t* wrow = (const bf16_t*)(wl + WL_SG) + ((size_t)g * 128 + (act ? i : 0)) * 128 + 8 * fq;
#pragma unroll
            for (int ks = 0; ks < 4; ++ks) wf[ks] = *(const bf16x8*)(wrow + 32 * ks);
#pragma unroll
            for (int ct = 0; ct < 8; ++ct) uu[ct] = *(const u32x2*)(zrow + 16 * ct);
        }
        const float bias = P.sgu_b[(layer * 4 + g) * 128 + (act ? i : 0)];
        if (g < 3) {
#pragma unroll
            for (int p = 0; p < 4; ++p) { const int idx = tid + NTHREADS * p, j = idx >> 4, c8 = idx & 15;
                if (j < L) svr[p] = *(const u32x4*)(Z + (size_t)(row0 + j) * NIN + ZC_SV + (g + 1) * 128 + c8 * 8); }
        }
        __syncthreads();
        if (act) {
#pragma unroll
            for (int ct = 0; ct < 8; ++ct) {
                f32x4 a = (f32x4){0.f, 0.f, 0.f, 0.f};
#pragma unroll
                for (int ks = 0; ks < 4; ++ks) {
                    const bf16x8 av = *(const LAS bf16x8*)(lds + MX_VNT + (16 * ct + fr) * MX_ST + (32 * ks + 8 * fq) * 2);
                    a = __builtin_amdgcn_mfma_f32_16x16x32_bf16(av, wf[ks], a, 0, 0, 0);
                }
                u32x2 w; w.x = pk2(bflo(uu[ct].x) * (a[0] + bias), bfhi(uu[ct].x) * (a[1] + bias)); w.y = pk2(bflo(uu[ct].y) * (a[2] + bias), bfhi(uu[ct].y) * (a[3] + bias));
                if (!dry) *(u32x2*)(zrow + 16 * ct) = w;
            }
        }
        __syncthreads();
    }
    u32x4 ur[5], wq[4];
#define MIX_LOAD_U(gg) do { _Pragma("unroll") for (int p = 0; p < 5; ++p) { const int idx = tid + NTHREADS * p, hh = idx >> 4, c8 = idx & 15, rel = hh - 15; \
            ur[p] = (u32x4){0u, 0u, 0u, 0u}; \
            if (idx < (15 + L) * 16) { \
                if (rel >= 0 || (!samp && t0 > 0)) ur[p] = *(const u32x4*)(Z + (size_t)(row0 + rel) * NIN + ZC_PU + (gg) * 128 + c8 * 8); \
                else if (samp) { const float* sp = P.state_pool + ((size_t)(layer * 8 + sb) * 15 + hh) * 512 + (gg) * 128 + c8 * 8; \
                    const f32x4 a_ = *(const f32x4*)sp, b_ = *(const f32x4*)(sp + 4); \
                    ur[p].x = pk2(a_[0], a_[1]); ur[p].y = pk2(a_[2], a_[3]); ur[p].z = pk2(b_[0], b_[1]); ur[p].w = pk2(b_[2], b_[3]); } } } \
        _Pragma("unroll") for (int p = 0; p < 4; ++p) { const int idx = tid + NTHREADS * p; \
            wq[p] = *(const u32x4*)((const bf16_t*)(wl + WL_PW) + (size_t)(gg) * 128 * 128 + (size_t)(idx >> 4) * 128 + (idx & 15) * 8); } } while (0)
    MIX_LOAD_U(0);
#pragma unroll 1
    for (int g = 0; g < 4; ++g) {
        const int wlen = 2 << g;
#pragma unroll
        for (int p = 0; p < 5; ++p) { const int idx = tid + NTHREADS * p; if (idx < (15 + L) * 16) *(LAS u32x4*)(lds + MX_U + (idx >> 4) * MX_ST + (idx & 15) * 16) = ur[p]; }
#pragma unroll
        for (int p = 0; p < 4; ++p) { const int idx = tid + NTHREADS * p; *(LAS u32x4*)(lds + MX_VNT + (idx >> 4) * MX_ST + (idx & 15) * 16) = wq[p]; }
        if (g < 3) MIX_LOAD_U(g + 1);
        __syncthreads();
        for (int idx = tid; idx < L * 16; idx += NTHREADS) {
            const int i = idx >> 4, c8 = idx & 15;
            float sm[8];
#pragma unroll
            for (int e = 0; e < 8; ++e) sm[e] = 0.f;
            for (int k = 0; k < wlen; ++k) {
                const u32x4 w = *(const LAS u32x4*)(lds + MX_U + (15 + i - k) * MX_ST + c8 * 16);
                sm[0] += bflo(w.x); sm[1] += bfhi(w.x); sm[2] += bflo(w.y); sm[3] += bfhi(w.y); sm[4] += bflo(w.z); sm[5] += bfhi(w.z); sm[6] += bflo(w.w); sm[7] += bfhi(w.w);
            }
            const u32x4 w = *(const LAS u32x4*)(lds + MX_U + (15 + i) * MX_ST + c8 * 16);
            const int pos1 = samp ? (1024 + i + 1) : (t0 + i + 1);
            const float rc = 1.0f / (float)(pos1 < wlen ? pos1 : wlen);
            u32x4 o;
            o.x = pk2(sm[0] * rc - bflo(w.x), sm[1] * rc - bfhi(w.x)); o.y = pk2(sm[2] * rc - bflo(w.y), sm[3] * rc - bfhi(w.y));
            o.z = pk2(sm[4] * rc - bflo(w.z), sm[5] * rc - bfhi(w.z)); o.w = pk2(sm[6] * rc - bflo(w.w), sm[7] * rc - bfhi(w.w));
            *(LAS u32x4*)(lds + MX_DT + i * MX_ST + c8 * 16) = o;
        }
        __syncthreads();
        if (act) {
            const int i = wave * 16 + fr;
            bf16x8 df[4];
#pragma unroll
            for (int ks = 0; ks < 4; ++ks) df[ks] = *(const LAS bf16x8*)(lds + MX_DT + i * MX_ST + (32 * ks + 8 * fq) * 2);
            bf16_t* zrow = Z + (size_t)(row0 + i) * NIN + ZC_SV + g * 128 + 4 * fq;
            const float* psc = P.pool_scale + layer * 512 + g * 128 + 4 * fq;
#pragma unroll
            for (int nt = 0; nt < 8; ++nt) {
                f32x4 a = (f32x4){0.f, 0.f, 0.f, 0.f};
#pragma unroll
                for (int ks = 0; ks < 4; ++ks) {
                    const bf16x8 wv = *(const LAS bf16x8*)(lds + MX_VNT + (16 * nt + fr) * MX_ST + (32 * ks + 8 * fq) * 2);
                    a = __builtin_amdgcn_mfma_f32_16x16x32_bf16(wv, df[ks], a, 0, 0, 0);
                }
                const f32x4 sc = *(const f32x4*)(psc + 16 * nt);
                u32x2 w; w.x = pk2(a[0] * sc[0], a[1] * sc[1]); w.y = pk2(a[2] * sc[2], a[3] * sc[3]);
                if (!dry) *(u32x2*)(zrow + 16 * nt) = w;
            }
        }
        __syncthreads();
    }
#undef MIX_LOAD_U
}

__device__ __forceinline__ void phase_mixers(const Params& P, int layer, LAS unsigned char* lds) {
    for (int it = blockIdx.x; it < 1304; it += gridDim.x) {
        if (it < 256) mix_item(P, layer, it, lds);
        else if (it < 1280) attn_item(P, layer, it - 256, lds);
        else if (it < 1296) attn_item(P, layer, 1024 + (it - 1280), lds);
        else mix_item(P, layer, 256 + (it - 1296), lds);
    }
}

__device__ __forceinline__ void phase_conv(const Params& P, int layer) {
    bf16_t* AB = (bf16_t*)(P.ws + WS_Z);
    const int gt = blockIdx.x * NTHREADS + threadIdx.x, NGT = gridDim.x * NTHREADS;
    const float* cw = P.ffn_conv_w + (size_t)layer * 3 * DFF; const float* cb = P.ffn_conv_b + (size_t)layer * DFF;
    for (int idx = gt; idx < M * (DFF / 8); idx += NGT) {
        const int r = idx / (DFF / 8), f = (idx - r * (DFF / 8)) * 8;
        int t, sb = 0; const bool samp = r >= MP;
        if (!samp) t = r & 8191; else { t = (r - MP) & 31; sb = (r - MP) >> 5; }
        float a0[8], a1[8], a2[8];
        { const u32x4 w = *(const u32x4*)(AB + (size_t)r * NUP + f);
          a0[0] = bflo(w.x); a0[1] = bfhi(w.x); a0[2] = bflo(w.y); a0[3] = bfhi(w.y); a0[4] = bflo(w.z); a0[5] = bfhi(w.z); a0[6] = bflo(w.w); a0[7] = bfhi(w.w); }
        const float* pf = P.state_conv + ((size_t)(layer * 8 + sb) * 2) * DFF + f;
        if (t >= 1) { const u32x4 w = *(const u32x4*)(AB + (size_t)(r - 1) * NUP + f);
          a1[0] = bflo(w.x); a1[1] = bfhi(w.x); a1[2] = bflo(w.y); a1[3] = bfhi(w.y); a1[4] = bflo(w.z); a1[5] = bfhi(w.z); a1[6] = bflo(w.w); a1[7] = bfhi(w.w); }
        else {
#pragma unroll
            for (int e = 0; e < 8; ++e) a1[e] = samp ? pf[DFF + e] : 0.f; }
        if (t >= 2) { const u32x4 w = *(const u32x4*)(AB + (size_t)(r - 2) * NUP + f);
          a2[0] = bflo(w.x); a2[1] = bfhi(w.x); a2[2] = bflo(w.y); a2[3] = bfhi(w.y); a2[4] = bflo(w.z); a2[5] = bfhi(w.z); a2[6] = bflo(w.w); a2[7] = bfhi(w.w); }
        else {
#pragma unroll
            for (int e = 0; e < 8; ++e) a2[e] = samp ? pf[(t == 1 ? DFF : 0) + e] : 0.f; }
        const u32x4 bw = *(const u32x4*)(AB + (size_t)r * NUP + DFF + f);
        float bb[8] = {bflo(bw.x), bfhi(bw.x), bflo(bw.y), bfhi(bw.y), bflo(bw.z), bfhi(bw.z), bflo(bw.w), bfhi(bw.w)};
        float go[8];
#pragma unroll
        for (int e = 0; e < 8; ++e) {
            const float cv = a2[e] * cw[f + e] + a1[e] * cw[DFF + f + e] + a0[e] * cw[2 * DFF + f + e] + cb[f + e];
            go[e] = gelu_tanh(cv) * bb[e];
        }
        u32x4 o; o.x = pk2(go[0], go[1]); o.y = pk2(go[2], go[3]); o.z = pk2(go[4], go[5]); o.w = pk2(go[6], go[7]);
        *(u32x4*)(AB + (size_t)r * NUP + DFF + f) = o;
    }
}

constexpr int NPHASES = 20;
#define XB_TMO      128
#define XB_XCNT(j)  (256  + 64 * (j))
#define XB_XSUB(j)  (1280 + 64 * (j))
#define XB_XGEN(j)  (2304 + 64 * (j))
#define XB_TOP      3328
#define XB_TOPGEN   3392
#define XCD_BAR_WORDS 3456
#define XB_SPIN_CAP (1u << 18)

__device__ __forceinline__ unsigned xb_ld(unsigned* p)              { return __hip_atomic_load(p, __ATOMIC_RELAXED, __HIP_MEMORY_SCOPE_AGENT); }
__device__ __forceinline__ unsigned xb_add(unsigned* p, unsigned v) { return __hip_atomic_fetch_add(p, v, __ATOMIC_RELAXED, __HIP_MEMORY_SCOPE_AGENT); }
__device__ __forceinline__ unsigned xb_xcc_id() { return (unsigned)__builtin_amdgcn_s_getreg((3 << 11) | 20) & 0xFu; }
#define XB_SPIN(cond, bar) do { unsigned _sp = 0; while (cond) { __builtin_amdgcn_s_sleep(1); \
    if ((++_sp & 255u) == 0u) { if (xb_ld(&(bar)[XB_TMO])) break; if (_sp > XB_SPIN_CAP) { atomicAdd(&(bar)[XB_TMO], 1u); break; } } } } while (0)

struct XcdBarrier {
    unsigned* bar; unsigned x;
    volatile LAS unsigned* st;
};

__device__ __forceinline__ XcdBarrier xcd_barrier_post(unsigned* bar, volatile LAS unsigned* st) {
    XcdBarrier b; b.bar = bar; b.x = xb_xcc_id(); b.st = st;
    if (threadIdx.x == 0) (void)xb_add(&bar[XB_XCNT(b.x)], 1u);
    return b;
}
__device__ __forceinline__ void xcd_barrier_complete(unsigned* bar, unsigned x, unsigned& nloc, unsigned& nx) {
    const unsigned G = gridDim.x * gridDim.y * gridDim.z;
    unsigned sum, cnt, mine, sp = 0u;
    for (;;) {
        sum = 0u; cnt = 0u; mine = 0u;
#pragma unroll
        for (unsigned j = 0; j < 16; ++j) { const unsigned c = xb_ld(&bar[XB_XCNT(j)]); sum += c; cnt += (c > 0u) ? 1u : 0u; mine = (j == x) ? c : mine; }
        if (sum == G) break;
        __builtin_amdgcn_s_sleep(1);
        if ((++sp & 255u) == 0u) { if (xb_ld(&bar[XB_TMO])) break; if (sp > XB_SPIN_CAP) { atomicAdd(&bar[XB_TMO], 1u); break; } }
    }
    nloc = mine > 0u ? mine : 1u; nx = cnt > 0u ? cnt : 1u;
}

__device__ __forceinline__ void xcd_barrier(const XcdBarrier& b) {
    asm volatile("s_waitcnt vmcnt(0)" ::: "memory");
    __syncthreads();
    if (threadIdx.x == 0) {
        unsigned* bar = b.bar;
        __builtin_amdgcn_s_waitcnt(0);
        unsigned nloc = b.st[0], nx = b.st[1];
        if (nloc == 0u) { xcd_barrier_complete(bar, b.x, nloc, nx); b.st[0] = nloc; b.st[1] = nx; }
        const unsigned old = xb_add(&bar[XB_XSUB(b.x)], 1u);
        const unsigned gen = old / nloc;
        if (old + 1u == (gen + 1u) * nloc) {
            __builtin_amdgcn_fence(__ATOMIC_RELEASE, "agent");
            asm volatile("s_waitcnt vmcnt(0)" ::: "memory");
            const unsigned og = xb_add(&bar[XB_TOP], 1u);
            const unsigned tg = og / nx;
            if (og + 1u == (tg + 1u) * nx) xb_add(&bar[XB_TOPGEN], 1u);
            else XB_SPIN(xb_ld(&bar[XB_TOPGEN]) == tg, bar);
            __builtin_amdgcn_fence(__ATOMIC_ACQUIRE, "agent");
            xb_add(&bar[XB_XGEN(b.x)], 1u);
            asm volatile("s_waitcnt vmcnt(0)" ::: "memory");
        } else {
            XB_SPIN(xb_ld(&bar[XB_XGEN(b.x)]) == gen, bar);
            __builtin_amdgcn_fence(__ATOMIC_ACQUIRE, "agent");
            asm volatile("s_waitcnt vmcnt(0)" ::: "memory");
        }
    }
    __syncthreads();
}


#define RUN(k) (lo <= (k) && (k) < hi)
#define SYNC(k) do { if ((k) + 1 < hi) xcd_barrier(bar); } while (0)
template <int l>
__device__ __forceinline__ void layer_phases(const Params& P, LAS unsigned char* lds, const XcdBarrier& bar) {
    const int lo = P.ph_lo, hi = P.ph_hi;
    const int G = gridDim.x, c = blockIdx.x;
    unsigned char* ws = P.ws;
    const float* MOD = (const float*)(ws + WS_MOD);
    bf16_t* H = (bf16_t*)(ws + WS_H);
    bf16_t* Z = (bf16_t*)(ws + WS_Z);
    constexpr int pb = 1 + 9 * l;
    const unsigned char* wl = ws + WS_W + (size_t)l * WL_SIZE;
    const float* modl = MOD + (size_t)l * 12 * 6144;
    const float* srcp = l == 0 ? P.x_prompt : P.out + O_YP;
    const float* srcs = l == 0 ? P.x_sample : P.out + O_YS;
    if (RUN(pb + 0)) { phase_norm(P, srcp, srcs, P.norm1_g + l * D, modl + 0 * D, modl + 1 * D); SYNC(pb + 0); }
    if (RUN(pb + 1)) {
        pg8::SimpleOrder S{(const char*)H, (const char*)(wl + WL_IN), (size_t)D * 2, (size_t)D * 2, M / 256, NIN / 256, D / 64, G, c};
        EpiZ E{Z, P.out, l};
        pg8::gemm_phase<EpiZ, pg8::SimpleOrder>(lds, (size_t)D * 2, (size_t)D * 2, S, E);
        SYNC(pb + 1);
    }
    if (l == 0 && PROBE == 1) {
        pg8::SimpleOrder S{(const char*)H, (const char*)(wl + WL_IN), (size_t)D * 2, (size_t)D * 2, M / 256, NIN / 256, D / 64, G, c};
        EpiZ E{Z, P.out, l};
        pg8::gemm_phase<EpiZ, pg8::SimpleOrder>(lds, (size_t)D * 2, (size_t)D * 2, S, E);
        xcd_barrier(bar);
    }
    if (l == 0 && PROBE == 6) { const bool dry = P.ph_hi < 100; for (int it = blockIdx.x; it < 1040; it += gridDim.x) attn_item(P, l, it, lds, dry); xcd_barrier(bar); }
    if (l == 0 && PROBE == 7) { const bool dry = P.ph_hi < 100; for (int it = blockIdx.x; it < 264; it += gridDim.x) mix_item(P, l, it, lds, dry); xcd_barrier(bar); }
    if (RUN(pb + 2)) { phase_mixers(P, l, lds); SYNC(pb + 2); }
    if (l == 0 && PROBE == 2) {
        pg8::SimpleOrder S{(const char*)H, (const char*)(wl + WL_IN), (size_t)D * 2, (size_t)D * 2, M / 256, NIN / 256, D / 64, G, c};
        EpiZ E{Z, P.out, l};
        pg8::gemm_phase<EpiZ, pg8::SimpleOrder>(lds, (size_t)D * 2, (size_t)D * 2, S, E);
        xcd_barrier(bar);
        phase_mixers(P, l, lds);
        xcd_barrier(bar);
    }
    if (RUN(pb + 3)) {
        pg8::MergeOrder S{(const char*)Z, (const char*)(wl + WL_CAT), (size_t)NIN * 2, (size_t)2048 * 2, M / 256, D / 256, G, c};
        EpiMerge E{Z, H};
        pg8::gemm_phase<EpiMerge, pg8::MergeOrder>(lds, (size_t)NIN * 2, (size_t)2048 * 2, S, E);
        SYNC(pb + 3);
    }
    if (RUN(pb + 4)) {
        pg8::SimpleOrder S{(const char*)H, (const char*)(wl + WL_OUT), (size_t)D * 2, (size_t)D * 2, M / 256, D / 256, D / 64, G, c};
        EpiRes E{srcp, srcs, P.out, modl + 2 * D};
        pg8::gemm_phase<EpiRes, pg8::SimpleOrder>(lds, (size_t)D * 2, (size_t)D * 2, S, E);
        SYNC(pb + 4);
    }
    if (RUN(pb + 5)) { phase_norm(P, P.out + O_YP, P.out + O_YS, P.norm2_g + l * D, modl + 3 * D, modl + 4 * D); SYNC(pb + 5); }
    if (RUN(pb + 6)) {
        pg8::UpOrder S{(const char*)H, (const char*)(wl + WL_UP), (size_t)D * 2, (size_t)D * 2, (M + 253) / 254, NUP / 256, D / 64, G, c};
        EpiUpConv E{Z, P.out, P.ffn_conv_w + (size_t)l * 3 * DFF, P.ffn_conv_b + (size_t)l * DFF, P.state_conv + (size_t)l * 8 * 2 * DFF, l, lds};
        pg8::gemm_phase<EpiUpConv, pg8::UpOrder>(lds, (size_t)D * 2, (size_t)D * 2, S, E);
        SYNC(pb + 6);
    }
    if (l == 0 && PROBE == 8) {
        pg8::UpOrder S{(const char*)H, (const char*)(wl + WL_UP), (size_t)D * 2, (size_t)D * 2, (M + 253) / 254, NUP / 256, D / 64, G, c};
        EpiUpConv E{Z, P.out, P.ffn_conv_w + (size_t)l * 3 * DFF, P.ffn_conv_b + (size_t)l * DFF, P.state_conv + (size_t)l * 8 * 2 * DFF, l, lds};
        pg8::gemm_phase<EpiUpConv, pg8::UpOrder>(lds, (size_t)D * 2, (size_t)D * 2, S, E);
        xcd_barrier(bar);
    }
    if (RUN(pb + 8)) {
        pg8::SimpleOrder S{(const char*)Z, (const char*)(wl + WL_DN), (size_t)DFF * 2, (size_t)DFF * 2, M / 256, D / 256, DFF / 64, G, c};
        EpiRes E{P.out + O_YP, P.out + O_YS, P.out, modl + 5 * D};
        pg8::gemm_phase<EpiRes, pg8::SimpleOrder>(lds, (size_t)DFF * 2, (size_t)DFF * 2, S, E);
        SYNC(pb + 8);
    }
}
__global__ void __launch_bounds__(NTHREADS) mk_fwd(Params P) {
    extern __shared__ __attribute__((aligned(16))) unsigned char lds_raw[];
    LAS unsigned char* lds = (LAS unsigned char*)lds_raw;
    cg::grid_group grid = cg::this_grid();
    const int lo = P.ph_lo, hi = P.ph_hi;
    unsigned* barw = (unsigned*)(P.ws + WS_BAR);
    volatile LAS unsigned* st = (volatile LAS unsigned*)(lds + XCH_OFF + 4096);
    if (threadIdx.x < 2) st[threadIdx.x] = 0u;
    if (lo == 0 && blockIdx.x == 0) for (int i = threadIdx.x; i < XCD_BAR_WORDS; i += NTHREADS) barw[i] = 0u;
    __syncthreads();
    if (RUN(0)) { phase_p0(P, lds); if (1 < hi) grid.sync(); }
    XcdBarrier bar = xcd_barrier_post(barw, st);
    if (PROBE == 4) { phase_p0(P, lds); xcd_barrier(bar); phase_norm(P, P.x_prompt, P.x_sample, P.norm1_g, (const float*)(P.ws + WS_MOD), (const float*)(P.ws + WS_MOD) + D); xcd_barrier(bar); }
    if (PROBE == 5) { for (int i = 0; i < 20; ++i) xcd_barrier(bar); }
    layer_phases<0>(P, lds, bar);
    layer_phases<1>(P, lds, bar);
    if (RUN(19)) phase_final(P);
}
#undef RUN
#undef SYNC

extern "C" void kernel_launch(void* const* d_in, const int* in_sizes, int n_in, void* d_out, int out_size, void* d_ws, size_t ws_size, hipStream_t stream) {
    static int grid = 0;
    if (grid == 0) {
        if (n_in != 28 || ws_size < WS_END) { fprintf(stderr, "kernel_launch: need 28 inputs and %zu B of workspace (got %d, %zu)\n", (size_t)WS_END, n_in, ws_size); grid = -1; return; }
        int dev = 0, cus = 0, per_cu = 0;
        hipGetDevice(&dev);
        hipDeviceGetAttribute(&cus, hipDeviceAttributeMultiprocessorCount, dev);
        if (hipFuncSetAttribute((const void*)mk_fwd, hipFuncAttributeMaxDynamicSharedMemorySize, LDS_BYTES) != hipSuccess) { fprintf(stderr, "kernel_launch: hipFuncSetAttribute failed\n"); grid = -1; return; }
        if (hipOccupancyMaxActiveBlocksPerMultiprocessor(&per_cu, (const void*)mk_fwd, NTHREADS, LDS_BYTES) != hipSuccess || per_cu < 1) { fprintf(stderr, "kernel_launch: occupancy query failed (%d)\n", per_cu); per_cu = 1; }
        (void)hipGetLastError();
        grid = cus * per_cu;
    }
    if (grid < 0) return;
    Params p{};
    const float** ip = (const float**)&p;
    for (int i = 0; i < 28; ++i) ip[i] = (const float*)d_in[i];
    p.out = (float*)d_out; p.ws = (unsigned char*)d_ws;
#if MULTI_LAUNCH
    for (int ph = 0; ph < NPHASES; ++ph) {
        p.ph_lo = ph; p.ph_hi = ph + 1;
        hipLaunchKernelGGL(mk_fwd, dim3(grid), dim3(NTHREADS), LDS_BYTES, stream, p);
    }
#else
    p.ph_lo = 0; p.ph_hi = NPHASES;
    void* args[] = {&p};
    hipError_t e = hipLaunchCooperativeKernel((const void*)mk_fwd, dim3(grid), dim3(NTHREADS), args, LDS_BYTES, stream);
    if (e != hipSuccess) fprintf(stderr, "cooperative launch failed: %s (grid %d)\n", hipGetErrorString(e), grid);
#endif
}
```

```cpp
#include <hip/hip_runtime.h>
#include <hip/hip_cooperative_groups.h>
#include <cstdio>
namespace cg = cooperative_groups;

#ifndef MULTI_LAUNCH
#define MULTI_LAUNCH 0
#endif

#ifndef PROBE
#define PROBE 0
#endif
#ifndef STG_BIG
#define STG_BIG 0u
#define STG_MERGE 0u
#define STG_OUT 0u
#define STG_DOWN 0u
#endif
#ifndef P0_BOTH_LAYERS
#define P0_BOTH_LAYERS 0
#endif
#ifndef PG8_SP2
#define PG8_SP2 1
#endif
#define LAS __attribute__((address_space(3)))
typedef unsigned short bf16_t;
typedef short bf16x8 __attribute__((ext_vector_type(8)));
typedef float f32x4 __attribute__((ext_vector_type(4)));
typedef unsigned u32x4 __attribute__((ext_vector_type(4)));
typedef unsigned u32x2 __attribute__((ext_vector_type(2)));

constexpr int D = 1024, SEQ = 8192, NBP = 4, NBS = 8, ST = 32;
constexpr int MP = NBP * SEQ;
constexpr int MS = NBS * ST;
constexpr int M = MP + MS;
constexpr int NIN = 5888, DFF = 2816, NUP = 5632;
constexpr int NTHREADS = 512, NWAVES = 8;
constexpr int ZC_Q = 0, ZC_K = 1024, ZC_V = 1152, ZC_PU = 1280, ZC_SU = 1792, ZC_SV = 2304, ZC_G = 2816;
constexpr size_t O_YP = 0;
constexpr size_t O_YS = O_YP + (size_t)MP * D;
constexpr size_t O_KP = O_YS + (size_t)MS * D;
constexpr size_t O_VP = O_KP + 2 * 4 * 128 * 128;
constexpr size_t O_PP = O_VP + 2 * 4 * 128 * 128;
constexpr size_t O_CP = O_PP + 2 * 4 * 15 * 512;
constexpr size_t O_KS = O_CP + 2 * 4 * 2 * DFF;
constexpr size_t O_VS = O_KS + 2 * 8 * 128 * 128;
constexpr size_t O_PS = O_VS + 2 * 8 * 128 * 128;
constexpr size_t O_CS = O_PS + 2 * 8 * 15 * 512;
constexpr size_t O_SV = O_CS + 2 * 8 * 2 * DFF;
constexpr size_t WS_MOD = 4096;
constexpr size_t WS_BAR = 655360;
constexpr size_t WS_W = 1048576;
constexpr size_t WL_IN = 0;
constexpr size_t WL_CAT = WL_IN + (size_t)NIN * D * 2;
constexpr size_t WL_OUT = WL_CAT + (size_t)D * 2048 * 2;
constexpr size_t WL_UP = WL_OUT + (size_t)D * D * 2;
constexpr size_t WL_DN = WL_UP + (size_t)NUP * D * 2;
constexpr size_t WL_PW = WL_DN + (size_t)D * DFF * 2;
constexpr size_t WL_SG = WL_PW + 4 * 128 * 128 * 2;
constexpr size_t WL_SIZE = WL_SG + 4 * 128 * 128 * 2;
constexpr size_t WS_H = WS_W + 2 * WL_SIZE;
constexpr size_t WS_Z = WS_H + (size_t)M * D * 2;
constexpr size_t WS_PS = WS_Z + (size_t)M * NIN * 2;
constexpr size_t WS_END = WS_PS + 3 * (size_t)MS * D * 2;
constexpr int LDS_BYTES = 131072 + 8192;

struct Params {
    const float *x_prompt, *x_sample, *c_prompt, *c_sample, *cache_k, *cache_v, *state_pool, *state_conv;
    const float *norm1_g, *norm2_g, *w_ada, *b_ada, *w_in, *attn_sink, *w_o_attn, *pool_w, *pool_scale, *w_o_pool;
    const float *sgu_norm_g, *sgu_w, *sgu_b, *w_o_sgu, *w_out, *ffn_w_up, *ffn_conv_w, *ffn_conv_b, *ffn_w_down, *final_norm_g;
    float* out; unsigned char* ws;
    int ph_lo, ph_hi;
};

typedef __bf16 bf16x2_t __attribute__((ext_vector_type(2)));
typedef float f32x2_t __attribute__((ext_vector_type(2)));
__device__ __forceinline__ unsigned pk2(float lo, float hi) { const f32x2_t v = {lo, hi}; return __builtin_bit_cast(unsigned, __builtin_convertvector(v, bf16x2_t)); }
__device__ __forceinline__ unsigned f2bf(float f) { return pk2(f, 0.f) & 0xffffu; }
__device__ __forceinline__ float bflo(unsigned w) { return __builtin_bit_cast(float, w << 16); }
__device__ __forceinline__ float bfhi(unsigned w) { return __builtin_bit_cast(float, w & 0xffff0000u); }
__device__ __forceinline__ float bf1(bf16_t h) { return __builtin_bit_cast(float, ((unsigned)h) << 16); }
__device__ __forceinline__ float sigmoidf_(float x) { return __builtin_amdgcn_rcpf(1.0f + __builtin_amdgcn_exp2f(-1.4426950408889634f * x)); }
__device__ __forceinline__ float gelu_tanh(float x) { const float e = __builtin_amdgcn_exp2f(x * (-2.3022081985f - 0.1029432347f * x * x)); return x * __builtin_amdgcn_rcpf(1.0f + e); }
__device__ __forceinline__ float wave_sum(float v) {
#pragma unroll
    for (int o = 1; o < 64; o <<= 1) v += __shfl_xor(v, o);
    return v;
}
__device__ __forceinline__ int batch_of_row(int row) { return row < MP ? (row >> 13) : 4 + ((row - MP) >> 5); }

namespace pg8 {
constexpr int BM = 256, BK = 64, HALF = 128, HTB = HALF * BK * 2, NXCD = 8, WGM = 8;
__device__ __forceinline__ int lds_byte(int r, int c) { const int st = (r >> 4) * 2 + (c >> 5), rr = r & 15, cc = c & 31, ob = rr * 64 + cc * 2; return st * 1024 + (ob ^ (((ob >> 9) & 1) << 5)); }
__device__ __forceinline__ void stage_rc(int b, int& R, int& C) { const int st = b / 1024, sb = b % 1024, swz = sb ^ (((sb >> 9) & 1) << 5); R = (st >> 1) * 16 + swz / 64; C = (st & 1) * 32 + (swz % 64) / 2; }
__device__ __forceinline__ int perm32(int rho) { const int n = rho >> 4, i = rho & 15; return 8 * (i >> 2) + 4 * n + (i & 3); }

struct Unit { const char* A; const char* B; int nt, pm, pn, mode; };

__device__ __forceinline__ void tile_of(int wgid, int nM, int nN, int& pm, int& pn) {
    const int nwg = nM * nN;
    { const int q = nwg / NXCD, r = nwg % NXCD, xcd = wgid % NXCD, off = wgid / NXCD; wgid = (xcd < r ? xcd * (q + 1) : r * (q + 1) + (xcd - r) * q) + off; }
    const int nig = WGM * nN, gid = wgid / nig, fm = gid * WGM, gsz = (nM - fm) < WGM ? (nM - fm) : WGM;
    pm = fm + ((wgid % nig) % gsz); pn = (wgid % nig) / gsz;
}

struct SimpleOrder {
    const char* A; const char* B; size_t lda, ldb; int nM, nN, nt, G, c;
    __device__ __forceinline__ bool next(int i, Unit& u) const {
        const long L = (long)i * G + c; if (L >= (long)nM * nN) return false;
        int pm, pn; tile_of((int)L, nM, nN, pm, pn);
        u.pm = pm; u.pn = pn; u.nt = nt; u.mode = 0; u.A = A + (size_t)pm * 256 * lda; u.B = B + (size_t)pn * 256 * ldb; return true;
    }
};
struct MergeOrder {
    const char* A; const char* B; size_t lda, ldb; int G, c;
    __device__ __forceinline__ void fill(Unit& u, int pm, int pn, int br, int mode) const {
        u.pm = pm; u.pn = pn; u.mode = mode;
        const int ak = br == 0 ? ZC_Q : (br == 1 ? ZC_SV : ZC_SU);
        const int bk = br == 0 ? 0 : (br == 1 ? 1024 : 1536);
        u.nt = br == 0 ? 16 : 8;
        u.A = A + (size_t)pm * 256 * lda + (size_t)ak * 2; u.B = B + (size_t)pn * 256 * ldb + (size_t)bk * 2;
    }
    __device__ __forceinline__ bool next(int i, Unit& u) const {
        const int ti = i / 3, br = i - ti * 3;
        const long L = (long)ti * G + c;
        if (L < 512) { int pm, pn; tile_of((int)L, 128, 4, pm, pn); fill(u, pm, pn, br, br); return true; }
        const int e = (int)(L - 512); if (e >= 12 || br != 0) return false;
        fill(u, 128, e / 3, e % 3, 4 + e % 3); return true;
    }
};
struct ResOrder {
    const char* A; const char* B; size_t lda, ldb; int nt, G, c;
    const char* As0; const char* As1; const char* As2; int ppt;
    __device__ __forceinline__ bool next(int i, Unit& u) const {
        const long L = (long)i * G + c;
        if (L < 512) { int pm, pn; tile_of((int)L, 128, 4, pm, pn); u.pm = pm; u.pn = pn; u.nt = nt; u.mode = 0; u.A = A + (size_t)pm * 256 * lda; u.B = B + (size_t)pn * 256 * ldb; return true; }
        const int e = (int)(L - 512); if (e >= 4 * ppt) return false;
        const int pn = e / ppt, kp = e - pn * ppt;
        u.pm = 128; u.pn = pn; u.nt = 4; u.mode = 1;
        if (As1) { const int b = kp >> 2, ko = (kp & 3) * 256; u.A = (b == 0 ? As0 : (b == 1 ? As1 : As2)) + (size_t)ko * 2; u.B = B + (size_t)pn * 256 * ldb + (size_t)ko * 2; }
        else { u.A = As0 + (size_t)kp * 512; u.B = B + (size_t)pn * 256 * ldb + (size_t)kp * 512; }
        return true;
    }
};

struct UpOrder {
    const char* A; const char* B; size_t lda, ldb; int nM, nN, nt, G, c;
    __device__ __forceinline__ bool next(int i, Unit& u) const {
        const long L = (long)i * G + c; if (L >= (long)nM * nN) return false;
        int pm, pn; tile_of((int)L, nM, nN, pm, pn);
        u.pm = pm; u.pn = pn; u.nt = nt; u.mode = 0; u.A = A + ((long)pm * 254 - 2) * (long)lda; u.B = B + (size_t)pn * 256 * ldb; return true;
    }
};

__device__ __forceinline__ void stagger_wait(unsigned ticks) {
    if (ticks) { const unsigned long long t0 = __builtin_amdgcn_s_memrealtime(); while (__builtin_amdgcn_s_memrealtime() - t0 < ticks) __builtin_amdgcn_s_sleep(8); }
}
template <class Epi, class Sched>
__device__ __forceinline__ void gemm_phase(LAS unsigned char* lds, const size_t lda, const size_t ldb, const Sched& S, const Epi& E, const unsigned stagger = 0u) {
    stagger_wait(stagger);
    int tid_ = threadIdx.x; asm volatile("" : "+v"(tid_));
    const int tid = tid_, wid = __builtin_amdgcn_readfirstlane(tid >> 6), lane = tid & 63, wr = wid >> 2, wc = wid & 3, fr = lane & 15, fq = lane >> 4;
    unsigned voffA[2], voffB[2];
#pragma unroll
    for (int i = 0; i < 2; ++i) { int R, C; stage_rc(tid * 16 + i * 8192, R, C); const int Rb = Epi::PERM ? ((R & ~31) + perm32(R & 31)) : R;
        voffA[i] = (unsigned)(R * lda + C * 2); voffB[i] = (unsigned)(Rb * ldb + C * 2); }
    const size_t kstep = (size_t)(BK * 2);
    const size_t hstepA = (size_t)HALF * lda, hstepB = (size_t)HALF * ldb;
    const unsigned ldsw = (unsigned)wid * 1024u;
    const int aoff = lds_byte(wr * 64 + fr, fq * 8), boff = lds_byte(wc * 32 + fr, fq * 8);
#define PG8_SA(b, h) (((b) * 2 + (h)) * HTB)
#define PG8_SB(b, h) ((4 + (b) * 2 + (h)) * HTB)
#define PG8_STAGE(bufoff, gbase, voff) do { _Pragma("unroll") for (int _i = 0; _i < 2; ++_i) \
        __builtin_amdgcn_global_load_lds((const unsigned*)((const char*)(gbase) + (voff)[_i]), (LAS unsigned*)(lds + (bufoff) + ldsw + _i * 8192), 16, 0, 0); } while (0)
#define PG8_LDA(dst, b, h) do { _Pragma("unroll") for (int m = 0; m < 4; ++m) _Pragma("unroll") for (int k = 0; k < 2; ++k) dst[m][k] = *(const LAS bf16x8*)(lds + PG8_SA(b, h) + aoff + m * 2048 + k * 1024); } while (0)
#define PG8_LDB(dst, b, h) do { _Pragma("unroll") for (int n = 0; n < 2; ++n) _Pragma("unroll") for (int k = 0; k < 2; ++k) dst[n][k] = *(const LAS bf16x8*)(lds + PG8_SB(b, h) + boff + n * 2048 + k * 1024); } while (0)
#define PG8_MMA(ai, bj, At, Bt) do { __builtin_amdgcn_s_setprio(1); _Pragma("unroll") for (int m = 0; m < 4; ++m) _Pragma("unroll") for (int n = 0; n < 2; ++n) _Pragma("unroll") for (int k = 0; k < 2; ++k) \
        acc[ai][bj][m][n] = __builtin_amdgcn_mfma_f32_16x16x32_bf16(Bt[n][k], At[m][k], acc[ai][bj][m][n], 0, 0, 0); __builtin_amdgcn_s_setprio(0); } while (0)
#define PG8_WAIT_V(n) asm volatile("s_waitcnt vmcnt(" #n ")" ::: "memory")
#define PG8_WAIT_L(n) asm volatile("s_waitcnt lgkmcnt(" #n ")" ::: "memory")
#define PG8_BAR __builtin_amdgcn_s_barrier()
#define PG8_SCHED __builtin_amdgcn_sched_barrier(0)
    Unit cur, nxt; int ui = 0;
    if (!S.next(0, cur)) return;
    f32x4 acc[2][2][4][2];
#pragma unroll
    for (int a = 0; a < 2; ++a)
#pragma unroll
        for (int b = 0; b < 2; ++b)
#pragma unroll
            for (int m = 0; m < 4; ++m)
#pragma unroll
                for (int n = 0; n < 2; ++n) acc[a][b][m][n] = (f32x4){0.f, 0.f, 0.f, 0.f};
    bf16x8 At[4][2], B0[2][2], B1[2][2];
    const char* cA = cur.A; const char* cB = cur.B;
#if PG8_SP2
    PG8_STAGE(PG8_SB(0, 0), cB, voffB); PG8_STAGE(PG8_SB(0, 1), cB + hstepB, voffB); PG8_STAGE(PG8_SA(0, 0), cA, voffA); PG8_STAGE(PG8_SA(0, 1), cA + hstepA, voffA);
    if (wr == 1) PG8_BAR;
    PG8_WAIT_V(2); PG8_BAR;
    PG8_STAGE(PG8_SB(1, 0), cB + kstep, voffB); PG8_STAGE(PG8_SA(1, 0), cA + kstep, voffA); PG8_STAGE(PG8_SB(1, 1), cB + hstepB + kstep, voffB);
    PG8_WAIT_V(6); PG8_BAR;
#else
    PG8_STAGE(PG8_SB(0, 0), cB, voffB); PG8_STAGE(PG8_SA(0, 0), cA, voffA); PG8_STAGE(PG8_SB(0, 1), cB + hstepB, voffB); PG8_STAGE(PG8_SA(0, 1), cA + hstepA, voffA);
    if (wr == 1) PG8_BAR;
    PG8_WAIT_V(4); PG8_BAR;
    PG8_STAGE(PG8_SB(1, 0), cB + kstep, voffB); PG8_STAGE(PG8_SA(1, 0), cA + kstep, voffA); PG8_STAGE(PG8_SB(1, 1), cB + hstepB + kstep, voffB);
    PG8_WAIT_V(6); PG8_BAR;
#endif
    for (;;) {
        const bool has_next = S.next(ui + 1, nxt);
        const char* nA = has_next ? nxt.A : cA; const char* nB = has_next ? nxt.B : cB;
        const int nt = cur.nt;
        for (int t = 0; t < nt; t += 2) {
            const bool last = (t == nt - 2);
            const char* a1 = cA + (size_t)(t + 1) * kstep;
            const char* a2 = last ? nA : cA + (size_t)(t + 2) * kstep; const char* b2 = last ? nB : cB + (size_t)(t + 2) * kstep;
            const char* a3 = a2 + kstep; const char* b3 = b2 + kstep;
#if PG8_SP2
            PG8_LDB(B0, 0, 0); PG8_LDB(B1, 0, 1); PG8_SCHED; PG8_LDA(At, 0, 0); PG8_STAGE(PG8_SA(1, 1), a1 + hstepA, voffA);
            PG8_WAIT_V(8); PG8_WAIT_L(0); PG8_BAR; PG8_MMA(0, 0, At, B0); PG8_MMA(0, 1, At, B1); PG8_BAR; PG8_SCHED;
            PG8_LDA(At, 0, 1); PG8_STAGE(PG8_SB(0, 0), b2, voffB); PG8_STAGE(PG8_SB(0, 1), b2 + hstepB, voffB); PG8_STAGE(PG8_SA(0, 0), a2, voffA);
            PG8_WAIT_V(8); PG8_WAIT_L(0); PG8_BAR; PG8_MMA(1, 0, At, B0); PG8_MMA(1, 1, At, B1); PG8_BAR; PG8_SCHED;
            PG8_LDB(B0, 1, 0); PG8_LDB(B1, 1, 1); PG8_SCHED; PG8_LDA(At, 1, 0); PG8_STAGE(PG8_SA(0, 1), a2 + hstepA, voffA);
            PG8_WAIT_V(8); PG8_WAIT_L(0); PG8_BAR; PG8_MMA(0, 0, At, B0); PG8_MMA(0, 1, At, B1); PG8_BAR; PG8_SCHED;
            PG8_LDA(At, 1, 1); PG8_STAGE(PG8_SB(1, 0), b3, voffB); PG8_STAGE(PG8_SB(1, 1), b3 + hstepB, voffB); PG8_STAGE(PG8_SA(1, 0), a3, voffA);
            PG8_WAIT_V(8); PG8_WAIT_L(0); PG8_BAR; PG8_MMA(1, 0, At, B0); PG8_MMA(1, 1, At, B1); PG8_BAR; PG8_SCHED;
#else
            PG8_LDB(B0, 0, 0); PG8_SCHED; PG8_LDA(At, 0, 0); PG8_STAGE(PG8_SA(1, 1), a1 + hstepA, voffA);
            PG8_WAIT_L(8); PG8_BAR; PG8_WAIT_L(0); PG8_MMA(0, 0, At, B0); PG8_BAR; PG8_SCHED;
            PG8_LDB(B1, 0, 1); PG8_STAGE(PG8_SB(0, 0), b2, voffB);
            PG8_BAR; PG8_WAIT_L(0); PG8_MMA(0, 1, At, B1); PG8_BAR;
            PG8_LDA(At, 0, 1); PG8_STAGE(PG8_SA(0, 0), a2, voffA);
            PG8_BAR; PG8_WAIT_L(0); PG8_MMA(1, 0, At, B0); PG8_BAR; PG8_SCHED;
            PG8_STAGE(PG8_SB(0, 1), b2 + hstepB, voffB);
            PG8_WAIT_V(6); PG8_BAR; PG8_MMA(1, 1, At, B1); PG8_BAR;
            PG8_LDB(B0, 1, 0); PG8_SCHED; PG8_LDA(At, 1, 0); PG8_STAGE(PG8_SA(0, 1), a2 + hstepA, voffA);
            PG8_WAIT_L(8); PG8_BAR; PG8_WAIT_L(0); PG8_MMA(0, 0, At, B0); PG8_BAR; PG8_SCHED;
            PG8_LDB(B1, 1, 1); PG8_STAGE(PG8_SB(1, 0), b3, voffB);
            PG8_BAR; PG8_WAIT_L(0); PG8_MMA(0, 1, At, B1); PG8_BAR;
            PG8_LDA(At, 1, 1); PG8_STAGE(PG8_SA(1, 0), a3, voffA);
            PG8_BAR; PG8_WAIT_L(0); PG8_MMA(1, 0, At, B0); PG8_BAR; PG8_SCHED;
            PG8_STAGE(PG8_SB(1, 1), b3 + hstepB, voffB);
            PG8_WAIT_V(6); PG8_BAR; PG8_MMA(1, 1, At, B1); PG8_BAR;
#endif
        }
        if (wr == 0) PG8_BAR;
        E(acc, cur, wr, wc, fr, fq);
        if (!has_next) break;
#pragma unroll
        for (int a = 0; a < 2; ++a)
#pragma unroll
            for (int b = 0; b < 2; ++b)
#pragma unroll
                for (int m = 0; m < 4; ++m)
#pragma unroll
                    for (int n = 0; n < 2; ++n) acc[a][b][m][n] = (f32x4){0.f, 0.f, 0.f, 0.f};
        cur = nxt; cA = nA; cB = nB; ++ui;
        if (wr == 1) PG8_BAR;
    }
    PG8_WAIT_V(0);
    PG8_BAR;
#undef PG8_SA
#undef PG8_SB
#undef PG8_STAGE
#undef PG8_LDA
#undef PG8_LDB
#undef PG8_MMA
#undef PG8_WAIT_V
#undef PG8_WAIT_L
#undef PG8_BAR
#undef PG8_SCHED
}
}

struct EpiZ {
    static constexpr bool PERM = true;
    bf16_t* Z; float* out; int layer;
    template <int ACT>
    __device__ __forceinline__ void plain(const f32x4 (&acc)[2][2][4][2], const pg8::Unit& u, int wr, int wc, int fr, int fq) const {
#pragma unroll
        for (int ai = 0; ai < 2; ++ai)
#pragma unroll
            for (int m = 0; m < 4; ++m) {
                const int row = u.pm * 256 + ai * 128 + wr * 64 + m * 16 + fr;
#pragma unroll
                for (int bj = 0; bj < 2; ++bj) {
                    const int col0 = u.pn * 256 + bj * 128 + wc * 32 + 8 * fq;
                    f32x4 v0 = acc[ai][bj][m][0], v1 = acc[ai][bj][m][1];
                    if (ACT == 2) {
#pragma unroll
                        for (int j = 0; j < 4; ++j) { v0[j] = sigmoidf_(v0[j]); v1[j] = sigmoidf_(v1[j]); }
                    } else if (ACT == 1) {
#pragma unroll
                        for (int j = 0; j < 4; ++j) { v0[j] = gelu_tanh(v0[j]); v1[j] = gelu_tanh(v1[j]); }
                    }
                    u32x4 w; w.x = pk2(v0[0], v0[1]); w.y = pk2(v0[2], v0[3]); w.z = pk2(v1[0], v1[1]); w.w = pk2(v1[2], v1[3]);
                    *(u32x4*)(Z + (size_t)row * NIN + col0) = w;
                }
            }
    }
    __device__ __forceinline__ void operator()(const f32x4 (&acc)[2][2][4][2], const pg8::Unit& u, int wr, int wc, int fr, int fq) const {
        const int pn = u.pn;
        if (pn >= 11) { plain<2>(acc, u, wr, wc, fr, fq); return; }
        if (pn >= 7) { plain<1>(acc, u, wr, wc, fr, fq); return; }
        plain<0>(acc, u, wr, wc, fr, fq);
        if (pn < 4) return;
#pragma unroll
        for (int ai = 0; ai < 2; ++ai)
#pragma unroll
            for (int m = 0; m < 4; ++m) {
                const int row = u.pm * 256 + ai * 128 + wr * 64 + m * 16 + fr;
                int b, t; const bool samp = row >= MP;
                if (!samp) { b = row >> 13; t = row & 8191; } else { b = (row - MP) >> 5; t = (row - MP) & 31; }
#pragma unroll
                for (int bj = 0; bj < 2; ++bj) {
                    const int col0 = pn * 256 + bj * 128 + wc * 32 + 8 * fq;
                    float* dst = nullptr;
                    if (pn == 4) {
                        const int cc = col0 - ZC_K;
                        if (!samp) { if (t >= SEQ - 128) dst = out + (cc < 128 ? O_KP : O_VP) + ((size_t)((layer * 4 + b) * 128 + (t - (SEQ - 128))) * 128 + (cc & 127)); }
                        else dst = out + (cc < 128 ? O_KS : O_VS) + ((size_t)((layer * 8 + b) * 128 + 96 + t) * 128 + (cc & 127));
                    } else {
                        const int cc = col0 - ZC_PU;
                        if (!samp) { if (t >= SEQ - 15) dst = out + O_PP + ((size_t)((layer * 4 + b) * 15 + (t - (SEQ - 15))) * 512 + cc); }
                        else { if (t >= ST - 15) dst = out + O_PS + ((size_t)((layer * 8 + b) * 15 + (t - (ST - 15))) * 512 + cc); }
                    }
                    if (dst) { *(f32x4*)dst = acc[ai][bj][m][0]; *(f32x4*)(dst + 4) = acc[ai][bj][m][1]; }
                }
            }
    }
};
struct EpiMerge {
    static constexpr bool PERM = true;
    const bf16_t* Z; bf16_t* MG; bf16_t* PS;
        __device__ __forceinline__ void operator()(const f32x4 (&acc)[2][2][4][2], const pg8::Unit& u, int wr, int wc, int fr, int fq) const {
        const bool smp = u.mode >= 4; const int mode = smp ? u.mode - 4 : u.mode;
        const bool rmw = mode != 0 && !smp;
        const int colb = u.pn * 256 + wc * 32 + 8 * fq;
        const bf16_t* gbase = Z + ZC_G + mode * 1024 + colb;
#pragma unroll
        for (int ai = 0; ai < 2; ++ai)
#pragma unroll
            for (int mp = 0; mp < 2; ++mp) {
                u32x4 gt[2][2], ov[2][2];
#pragma unroll
                for (int mm = 0; mm < 2; ++mm) {
                    const int row = u.pm * 256 + ai * 128 + wr * 64 + (2 * mp + mm) * 16 + fr;
#pragma unroll
                    for (int bj = 0; bj < 2; ++bj) gt[mm][bj] = *(const u32x4*)(gbase + (size_t)row * NIN + bj * 128);
                }
                if (rmw) {
#pragma unroll
                    for (int mm = 0; mm < 2; ++mm) {
                        const int row = u.pm * 256 + ai * 128 + wr * 64 + (2 * mp + mm) * 16 + fr;
#pragma unroll
                        for (int bj = 0; bj < 2; ++bj) ov[mm][bj] = *(const u32x4*)(MG + (size_t)row * D + colb + bj * 128);
                    }
                }
#pragma unroll
                for (int mm = 0; mm < 2; ++mm) {
                    const int m = 2 * mp + mm;
                    const int row = u.pm * 256 + ai * 128 + wr * 64 + m * 16 + fr;
#pragma unroll
                    for (int bj = 0; bj < 2; ++bj) {
                        const u32x4 g = gt[mm][bj];
                        f32x4 v0 = acc[ai][bj][m][0], v1 = acc[ai][bj][m][1];
                        v0[0] *= bflo(g.x); v0[1] *= bfhi(g.x); v0[2] *= bflo(g.y); v0[3] *= bfhi(g.y);
                        v1[0] *= bflo(g.z); v1[1] *= bfhi(g.z); v1[2] *= bflo(g.w); v1[3] *= bfhi(g.w);
                        if (rmw) { const u32x4 o = ov[mm][bj];
                            v0[0] += bflo(o.x); v0[1] += bfhi(o.x); v0[2] += bflo(o.y); v0[3] += bfhi(o.y);
                            v1[0] += bflo(o.z); v1[1] += bfhi(o.z); v1[2] += bflo(o.w); v1[3] += bfhi(o.w); }
                        bf16_t* mp_ = smp ? PS + ((size_t)mode * MS + (row - MP)) * D + colb + bj * 128 : MG + (size_t)row * D + colb + bj * 128;
                        u32x4 w; w.x = pk2(v0[0], v0[1]); w.y = pk2(v0[2], v0[3]); w.z = pk2(v1[0], v1[1]); w.w = pk2(v1[2], v1[3]);
                        *(u32x4*)mp_ = w;
                    }
                }
            }
    }
};
struct EpiRes {
    static constexpr bool PERM = false;
    const float* srcp; const float* srcs; float* X; const float* gmod;
        __device__ __forceinline__ void operator()(const f32x4 (&acc)[2][2][4][2], const pg8::Unit& u, int wr, int wc, int fr, int fq) const {
        const int colb = u.pn * 256 + wc * 32 + 4 * fq;
        if (u.mode == 0) {
            const float* gp = gmod + (size_t)(u.pm >> 5) * 6144 + colb;
            f32x4 g[2][2];
#pragma unroll
            for (int bj = 0; bj < 2; ++bj)
#pragma unroll
                for (int n = 0; n < 2; ++n) g[bj][n] = *(const f32x4*)(gp + bj * 128 + 16 * n);
#pragma unroll
            for (int ai = 0; ai < 2; ++ai)
#pragma unroll
                for (int mp = 0; mp < 2; ++mp) {
                    f32x4 sv[2][2][2];
#pragma unroll
                    for (int mm = 0; mm < 2; ++mm) {
                        const int row = u.pm * 256 + ai * 128 + wr * 64 + (2 * mp + mm) * 16 + fr;
                        const float* sp = srcp + (size_t)row * D + colb;
#pragma unroll
                        for (int bj = 0; bj < 2; ++bj)
#pragma unroll
                            for (int n = 0; n < 2; ++n) sv[mm][bj][n] = *(const f32x4*)(sp + bj * 128 + 16 * n);
                    }
#pragma unroll
                    for (int mm = 0; mm < 2; ++mm) {
                        const int m = 2 * mp + mm;
                        const int row = u.pm * 256 + ai * 128 + wr * 64 + m * 16 + fr;
                        float* xp = X + (size_t)row * D + colb;
#pragma unroll
                        for (int bj = 0; bj < 2; ++bj)
#pragma unroll
                            for (int n = 0; n < 2; ++n) *(f32x4*)(xp + bj * 128 + 16 * n) = sv[mm][bj][n] + g[bj][n] * acc[ai][bj][m][n];
                    }
                }
        } else {
#pragma unroll
            for (int ai = 0; ai < 2; ++ai)
#pragma unroll
                for (int m = 0; m < 4; ++m) {
                    const int row = u.pm * 256 + ai * 128 + wr * 64 + m * 16 + fr;
                    const float* gp = gmod + (size_t)batch_of_row(row) * 6144 + colb;
                    float* xp = X + (size_t)row * D + colb;
                    f32x4 g[2][2];
#pragma unroll
                    for (int bj = 0; bj < 2; ++bj)
#pragma unroll
                        for (int n = 0; n < 2; ++n) g[bj][n] = *(const f32x4*)(gp + bj * 128 + 16 * n);
#pragma unroll
                    for (int bj = 0; bj < 2; ++bj)
#pragma unroll
                        for (int n = 0; n < 2; ++n) { const f32x4 v = g[bj][n] * acc[ai][bj][m][n]; float* q = xp + bj * 128 + 16 * n;
                            unsafeAtomicAdd(q + 0, v[0]); unsafeAtomicAdd(q + 1, v[1]); unsafeAtomicAdd(q + 2, v[2]); unsafeAtomicAdd(q + 3, v[3]); }
                }
        }
    }
};
constexpr int XCH_OFF = 131072;
struct EpiUpConv {
    static constexpr bool PERM = true;
    bf16_t* Gb; float* out; const float* cw; const float* cb; const float* pref; int layer; LAS unsigned char* lds;
    __device__ __forceinline__ void operator()(const f32x4 (&acc)[2][2][4][2], const pg8::Unit& u, int wr, int wc, int fr, int fq) const {
        const int lane = fq * 16 + fr;
        LAS float* xch = (LAS float*)(lds + XCH_OFF);
        const int cl = wc * 32 + 8 * fq;
#pragma unroll
        for (int ai = 0; ai < 2; ++ai) {
            const int bnd = 2 * ai + wr;
            if (bnd < 3 && fr >= 14) {
                *(LAS f32x4*)(xch + (bnd * 2 + (fr - 14)) * 128 + cl) = acc[ai][0][3][0];
                *(LAS f32x4*)(xch + (bnd * 2 + (fr - 14)) * 128 + cl + 4) = acc[ai][0][3][1];
            }
        }
        asm volatile("s_waitcnt lgkmcnt(0)" ::: "memory"); __builtin_amdgcn_s_barrier(); asm volatile("" ::: "memory");
        const int rbase = u.pm * 254 - 2;
        const int rm = rbase & 8191;
        const bool plain = rbase >= 0 && rbase + 256 <= MP && rm >= 2 && rm <= 7934;
        if (plain) {
            const int f0 = u.pn * 128 + cl;
            f32x4 w0[2], w1[2], w2[2], bb[2];
#pragma unroll
            for (int n = 0; n < 2; ++n) { w0[n] = *(const f32x4*)(cw + f0 + 4 * n); w1[n] = *(const f32x4*)(cw + DFF + f0 + 4 * n); w2[n] = *(const f32x4*)(cw + 2 * DFF + f0 + 4 * n); bb[n] = *(const f32x4*)(cb + f0 + 4 * n); }
#pragma unroll
            for (int ai = 0; ai < 2; ++ai) {
                const int bp = 2 * ai + wr - 1 < 0 ? 0 : 2 * ai + wr - 1;
#pragma unroll
                for (int m = 0; m < 4; ++m) {
                    float gv[8];
#pragma unroll
                    for (int n = 0; n < 2; ++n) {
                        f32x4 x1 = (f32x4){0.f, 0.f, 0.f, 0.f}, x2 = x1;
                        if (m == 0) { x1 = *(const LAS f32x4*)(xch + (bp * 2 + 1) * 128 + cl + 4 * n); x2 = *(const LAS f32x4*)(xch + (bp * 2 + (fr & 1)) * 128 + cl + 4 * n); }
#pragma unroll
                        for (int j = 0; j < 4; ++j) {
                            const float cur = acc[ai][0][m][n][j];
                            const int curi = __float_as_int(cur);
                            int q1i, q2i;
                            if (m > 0) {
                                const float prvf = acc[ai][0][m > 0 ? m - 1 : 0][n][j]; const int prv = __float_as_int(prvf);
                                q1i = __builtin_amdgcn_update_dpp(0, prv, 0x121, 0xf, 0xf, false);
                                q2i = __builtin_amdgcn_update_dpp(0, prv, 0x122, 0xf, 0xf, false);
                            } else { const float x1f = x1[j], x2f = x2[j]; q1i = __float_as_int(x1f); q2i = __float_as_int(x2f); }
                            const float up1 = __int_as_float(__builtin_amdgcn_update_dpp(q1i, curi, 0x111, 0xf, 0xf, false));
                            const float up2 = __int_as_float(__builtin_amdgcn_update_dpp(q2i, curi, 0x112, 0xf, 0xf, false));
                            const float cv = up2 * w0[n][j] + up1 * w1[n][j] + cur * w2[n][j] + bb[n][j];
                            gv[4 * n + j] = gelu_tanh(cv) * acc[ai][1][m][n][j];
                        }
                    }
                    if (!(ai == 0 && m == 0 && wr == 0 && fr < 2)) {
                        const int row = rbase + ai * 128 + wr * 64 + m * 16 + fr;
                        u32x4 w; w.x = pk2(gv[0], gv[1]); w.y = pk2(gv[2], gv[3]); w.z = pk2(gv[4], gv[5]); w.w = pk2(gv[6], gv[7]);
                        *(u32x4*)(Gb + (size_t)row * DFF + f0) = w;
                    }
                }
            }
            return;
        }
#pragma unroll
        for (int n = 0; n < 2; ++n) {
            const int f0 = u.pn * 128 + cl + 4 * n;
            const f32x4 w0 = *(const f32x4*)(cw + f0), w1 = *(const f32x4*)(cw + DFF + f0), w2 = *(const f32x4*)(cw + 2 * DFF + f0), bb = *(const f32x4*)(cb + f0);
#pragma unroll
            for (int ai = 0; ai < 2; ++ai) {
                const int bp = 2 * ai + wr - 1 < 0 ? 0 : 2 * ai + wr - 1;
                const f32x4 x1 = *(const LAS f32x4*)(xch + (bp * 2 + 1) * 128 + cl + 4 * n), x2 = *(const LAS f32x4*)(xch + (bp * 2 + (fr & 1)) * 128 + cl + 4 * n);
#pragma unroll
                for (int m = 0; m < 4; ++m) {
                    const int tl = ai * 128 + wr * 64 + m * 16 + fr, row = rbase + tl;
                    int t, sb = 0; const bool samp = row >= MP;
                    if (!samp) t = row & 8191; else { t = (row - MP) & 31; sb = (row - MP) >> 5; }
                    const bool valid = tl >= 2 && row < M;
                    f32x4 p1 = (f32x4){0.f, 0.f, 0.f, 0.f}, p0 = p1;
                    if (samp && t < 2 && row < M) { const float* pp = pref + (size_t)sb * 2 * DFF + f0; p0 = *(const f32x4*)pp; p1 = *(const f32x4*)(pp + DFF); }
                    float gv[4];
#pragma unroll
                    for (int j = 0; j < 4; ++j) {
                        const float cur = acc[ai][0][m][n][j];
                        const int curi = __float_as_int(cur);
                        int q1i, q2i;
                        if (m > 0) {
                            const float prvf = acc[ai][0][m > 0 ? m - 1 : 0][n][j]; const int prv = __float_as_int(prvf);
                            q1i = __builtin_amdgcn_update_dpp(0, prv, 0x121, 0xf, 0xf, false);
                            q2i = __builtin_amdgcn_update_dpp(0, prv, 0x122, 0xf, 0xf, false);
                        } else { const float x1f = x1[j], x2f = x2[j]; q1i = __float_as_int(x1f); q2i = __float_as_int(x2f); }
                        float up1 = __int_as_float(__builtin_amdgcn_update_dpp(q1i, curi, 0x111, 0xf, 0xf, false));
                        float up2 = __int_as_float(__builtin_amdgcn_update_dpp(q2i, curi, 0x112, 0xf, 0xf, false));
                        if (t < 2) { if (t == 0) { up1 = p1[j]; up2 = p0[j]; } else { up2 = p1[j]; } }
                        const float cv = up2 * w0[j] + up1 * w1[j] + cur * w2[j] + bb[j];
                        gv[j] = gelu_tanh(cv) * acc[ai][1][m][n][j];
                    }
                    if (valid) {
                        int b, tt; if (!samp) { b = row >> 13; tt = t - (SEQ - 2); } else { b = sb; tt = t - (ST - 2); }
                        if (tt >= 0) *(f32x4*)(out + (samp ? O_CS : O_CP) + ((size_t)((layer * (samp ? 8 : 4) + b) * 2 + tt) * DFF + f0)) = acc[ai][0][m][n];
                        u32x2 w; w.x = pk2(gv[0], gv[1]); w.y = pk2(gv[2], gv[3]);
                        *(u32x2*)(Gb + (size_t)row * DFF + f0) = w;
                    }
                }
            }
        }
    }
};

template <bool UPMAP = false>
__device__ __forceinline__ void p0_transpose_item(const float* W, int N, bf16_t* WT, size_t ldt, int col_off, LAS float* scr, int item, int lane) {
    const int nblk = N / 32, kb = item / nblk, nb = item % nblk, k0 = 64 * kb, n0 = 32 * nb;
    const int r0 = UPMAP ? (n0 < DFF ? 256 * (n0 >> 7) + (n0 & 127) : 256 * ((n0 - DFF) >> 7) + 128 + ((n0 - DFF) & 127)) : n0;
    float tv[32];
#pragma unroll
    for (int i = 0; i < 32; ++i) tv[i] = W[(size_t)(k0 + 2 * i + (lane >> 5)) * N + n0 + (lane & 31)];
#pragma unroll
    for (int i = 0; i < 32; ++i) scr[(2 * i + (lane >> 5)) * 33 + (lane & 31)] = tv[i];
    asm volatile("s_waitcnt lgkmcnt(0)" ::: "memory");
    const int c = lane & 7;
#pragma unroll
    for (int j = 0; j < 4; ++j) { const int n = (lane >> 3) + 8 * j; const LAS float* s = scr + (8 * c) * 33 + n;
        u32x4 o; o.x = pk2(s[0 * 33], s[1 * 33]); o.y = pk2(s[2 * 33], s[3 * 33]); o.z = pk2(s[4 * 33], s[5 * 33]); o.w = pk2(s[6 * 33], s[7 * 33]);
        *(u32x4*)(WT + (size_t)(r0 + n) * ldt + col_off + k0 + 8 * c) = o; }
    asm volatile("s_waitcnt lgkmcnt(0)" ::: "memory");
}

constexpr int P0_I_IN = 16 * (NIN / 32), P0_I_OA = 16 * 32, P0_I_OP = 8 * 32, P0_I_OS = 8 * 32, P0_I_OUT = 16 * 32, P0_I_UP = 16 * (NUP / 32), P0_I_DN = (DFF / 64) * 32, P0_I_PW = 4 * 2 * 4;
constexpr int P0_I_L = P0_I_IN + P0_I_OA + P0_I_OP + P0_I_OS + P0_I_OUT + P0_I_UP + P0_I_DN + P0_I_PW;
__device__ __forceinline__ void p0_convert_layer(const Params& P, int l, LAS float* scr, int lane, int w0, int nw) {
    unsigned char* wl = P.ws + WS_W + (size_t)l * WL_SIZE;
    for (int it = w0; it < P0_I_L; it += nw) {
        int r = it;
        if (r < P0_I_IN) { p0_transpose_item(P.w_in + (size_t)l * D * NIN, NIN, (bf16_t*)(wl + WL_IN), D, 0, scr, r, lane); continue; } r -= P0_I_IN;
        if (r < P0_I_OA) { p0_transpose_item(P.w_o_attn + (size_t)l * D * D, D, (bf16_t*)(wl + WL_CAT), 2048, 0, scr, r, lane); continue; } r -= P0_I_OA;
        if (r < P0_I_OP) { p0_transpose_item(P.w_o_pool + (size_t)l * 512 * D, D, (bf16_t*)(wl + WL_CAT), 2048, 1024, scr, r, lane); continue; } r -= P0_I_OP;
        if (r < P0_I_OS) { p0_transpose_item(P.w_o_sgu + (size_t)l * 512 * D, D, (bf16_t*)(wl + WL_CAT), 2048, 1536, scr, r, lane); continue; } r -= P0_I_OS;
        if (r < P0_I_OUT) { p0_transpose_item(P.w_out + (size_t)l * D * D, D, (bf16_t*)(wl + WL_OUT), D, 0, scr, r, lane); continue; } r -= P0_I_OUT;
        if (r < P0_I_UP) { p0_transpose_item<true>(P.ffn_w_up + (size_t)l * D * NUP, NUP, (bf16_t*)(wl + WL_UP), D, 0, scr, r, lane); continue; } r -= P0_I_UP;
        if (r < P0_I_DN) { p0_transpose_item(P.ffn_w_down + (size_t)l * DFF * D, D, (bf16_t*)(wl + WL_DN), DFF, 0, scr, r, lane); continue; } r -= P0_I_DN;
        { const int g = r >> 3, rr = r & 7;
          p0_transpose_item(P.pool_w + ((size_t)l * 4 + g) * 128 * 128, 128, (bf16_t*)(wl + WL_PW) + (size_t)g * 128 * 128, 128, 0, scr, rr, lane); }
    }
}
__device__ __forceinline__ void phase_p0(const Params& P, LAS unsigned char* lds) {
    const int tid = threadIdx.x, lane = tid & 63, wave = tid >> 6;
    const int G = gridDim.x, gw = blockIdx.x * NWAVES + wave, NGW = G * NWAVES;
    LAS float* scr = (LAS float*)(lds + wave * 8704);
    p0_convert_layer(P, 0, scr, lane, gw, NGW);
#if P0_BOTH_LAYERS
    p0_convert_layer(P, 1, scr, lane, gw, NGW);
#endif
    const int gt = blockIdx.x * NTHREADS + tid, NGT = G * NTHREADS;
    for (int e = gt; e < 2 * 4 * 128 * 128; e += NGT) {
        const int l = e >> 16, r = e & 65535, i = (r >> 7) & 127, j = r & 127;
        const float v = ((j >> 6) <= (i >> 6)) ? P.sgu_w[e] : 0.f;
        ((bf16_t*)(P.ws + WS_W + (size_t)l * WL_SIZE + WL_SG))[r] = (bf16_t)f2bf(v);
    }
    for (int e = gt; e < 2 * 8 * 96 * 128; e += NGT) {
        const int lb = e / (96 * 128), r = e - lb * (96 * 128);
        P.out[O_KS + (size_t)lb * 128 * 128 + r] = P.cache_k[(size_t)lb * 128 * 128 + 32 * 128 + r];
        P.out[O_VS + (size_t)lb * 128 * 128 + r] = P.cache_v[(size_t)lb * 128 * 128 + 32 * 128 + r];
    }
    __syncthreads();
    LAS float* part = (LAS float*)lds;
    for (int it = blockIdx.x; it < 2 * 96; it += G) {
        const int l = it / 96, e0 = (it % 96) * 64;
        float acc[12];
#pragma unroll
        for (int b = 0; b < 12; ++b) acc[b] = 0.f;
        const float* wp = P.w_ada + (size_t)l * D * 6144 + e0 + lane;
        for (int d0 = wave * 128; d0 < wave * 128 + 128; d0 += 8) {
            float wv[8];
#pragma unroll
            for (int q = 0; q < 8; ++q) wv[q] = wp[(size_t)(d0 + q) * 6144];
#pragma unroll
            for (int q = 0; q < 8; ++q) {
#pragma unroll
                for (int b = 0; b < 12; ++b) { const float cv = b < 4 ? P.c_prompt[b * D + d0 + q] : P.c_sample[(b - 4) * D + d0 + q]; acc[b] += cv * sigmoidf_(cv) * wv[q]; }
            }
        }
#pragma unroll
        for (int b = 0; b < 12; ++b) part[(wave * 12 + b) * 64 + lane] = acc[b];
        __syncthreads();
        for (int o = tid; o < 12 * 64; o += NTHREADS) {
            const int b = o >> 6, c = o & 63; float s = P.b_ada[(size_t)l * 6144 + e0 + c];
#pragma unroll
            for (int w = 0; w < 8; ++w) s += part[(w * 12 + b) * 64 + c];
            ((float*)(P.ws + WS_MOD))[((size_t)l * 12 + b) * 6144 + e0 + c] = s;
        }
        __syncthreads();
    }
}

__device__ __forceinline__ void phase_norm(const Params& P, LAS unsigned char* lds, const float* srcp, const float* srcs, const float* g, const float* mod_sh, const float* mod_sc, float* copy_s = nullptr) {
    const int tid = threadIdx.x, lane = tid & 63, wave = __builtin_amdgcn_readfirstlane(tid >> 6);
    const int gw = blockIdx.x * NWAVES + wave, NGW = gridDim.x * NWAVES;
    bf16_t* H = (bf16_t*)(P.ws + WS_H);
    LAS float* GM = (LAS float*)lds;
    LAS float* SH = (LAS float*)(lds + 49152);
    __syncthreads();
    for (int idx = tid * 4; idx < 12 * 1024; idx += NTHREADS * 4) {
        const int b = idx >> 10, c = idx & 1023;
        const f32x4 gg = *(const f32x4*)(g + c), sc = *(const f32x4*)(mod_sc + (size_t)b * 6144 + c), sh = *(const f32x4*)(mod_sh + (size_t)b * 6144 + c);
        *(LAS f32x4*)(GM + idx) = gg * (sc + 1.0f); *(LAS f32x4*)(SH + idx) = sh;
    }
    __syncthreads();
    for (int row0 = gw; row0 < M; row0 += 4 * NGW) {
        f32x4 v[4][4]; float ss[4];
#pragma unroll
        for (int r = 0; r < 4; ++r) {
            const int row = row0 + r * NGW; const int rc = row < M ? row : row0;
            const float* xr = rc < MP ? srcp + (size_t)rc * D : srcs + (size_t)(rc - MP) * D;
#pragma unroll
            for (int j = 0; j < 4; ++j) v[r][j] = *(const f32x4*)(xr + 4 * lane + 256 * j);
        }
#pragma unroll
        for (int r = 0; r < 4; ++r) {
            float s_ = 0.f;
#pragma unroll
            for (int j = 0; j < 4; ++j) s_ += (v[r][j][0] * v[r][j][0] + v[r][j][1] * v[r][j][1]) + (v[r][j][2] * v[r][j][2] + v[r][j][3] * v[r][j][3]);
            ss[r] = s_;
        }
#pragma unroll
        for (int o = 1; o < 64; o <<= 1) {
#pragma unroll
            for (int r = 0; r < 4; ++r) ss[r] += __shfl_xor(ss[r], o);
        }
#pragma unroll
        for (int r = 0; r < 4; ++r) {
            const int row = row0 + r * NGW;
            if (row < M) {
                const int b = batch_of_row(row);
                const float rstd = rsqrtf(ss[r] * (1.f / D) + 1e-6f);
                if (copy_s && row >= MP) {
#pragma unroll
                    for (int j = 0; j < 4; ++j) *(f32x4*)(copy_s + (size_t)(row - MP) * D + 4 * lane + 256 * j) = v[r][j];
                }
#pragma unroll
                for (int j = 0; j < 4; ++j) {
                    const int c = 4 * lane + 256 * j;
                    const f32x4 gm = *(const LAS f32x4*)(GM + b * 1024 + c), sh = *(const LAS f32x4*)(SH + b * 1024 + c);
                    const f32x4 h = v[r][j] * rstd * gm + sh;
                    u32x2 w; w.x = pk2(h[0], h[1]); w.y = pk2(h[2], h[3]);
                    *(u32x2*)(H + (size_t)row * D + c) = w;
                }
            }
        }
    }
}
__device__ __forceinline__ void phase_final(const Params& P) {
    const int lane = threadIdx.x & 63, wave = __builtin_amdgcn_readfirstlane(threadIdx.x >> 6);
    const int gw = blockIdx.x * NWAVES + wave, NGW = gridDim.x * NWAVES;
    f32x4 gg[4];
#pragma unroll
    for (int j = 0; j < 4; ++j) gg[j] = *(const f32x4*)(P.final_norm_g + 4 * lane + 256 * j);
    for (int row0 = gw; row0 < M; row0 += 4 * NGW) {
        f32x4 v[4][4]; float ss[4];
#pragma unroll
        for (int r = 0; r < 4; ++r) {
            const int row = row0 + r * NGW; const float* xr = P.out + (size_t)(row < M ? row : row0) * D;
#pragma unroll
            for (int j = 0; j < 4; ++j) v[r][j] = *(const f32x4*)(xr + 4 * lane + 256 * j);
        }
#pragma unroll
        for (int r = 0; r < 4; ++r) {
            float s_ = 0.f;
#pragma unroll
            for (int j = 0; j < 4; ++j) s_ += (v[r][j][0] * v[r][j][0] + v[r][j][1] * v[r][j][1]) + (v[r][j][2] * v[r][j][2] + v[r][j][3] * v[r][j][3]);
            ss[r] = s_;
        }
#pragma unroll
        for (int o = 1; o < 64; o <<= 1) {
#pragma unroll
            for (int r = 0; r < 4; ++r) ss[r] += __shfl_xor(ss[r], o);
        }
#pragma unroll
        for (int r = 0; r < 4; ++r) {
            const int row = row0 + r * NGW;
            if (row < M) {
                const float rstd = rsqrtf(ss[r] * (1.f / D) + 1e-6f);
                float* xr = P.out + (size_t)row * D;
#pragma unroll
                for (int j = 0; j < 4; ++j) *(f32x4*)(xr + 4 * lane + 256 * j) = v[r][j] * rstd * gg[j];
            }
        }
    }
}

__device__ __forceinline__ void lds_barrier() { asm volatile("s_waitcnt lgkmcnt(0)" ::: "memory"); __builtin_amdgcn_s_barrier(); asm volatile("" ::: "memory"); }

constexpr int KS_STRIDE = 144;
constexpr int VT_STRIDE = 400;
constexpr int ATT_KS = 0, ATT_VT = 192 * KS_STRIDE;

__device__ __forceinline__ void attn_item(const Params& P, int layer, int item, LAS unsigned char* lds, const bool dry = false) {
    const int tid = threadIdx.x, lane = tid & 63, wave = __builtin_amdgcn_readfirstlane(tid >> 6), fr = lane & 15, fq = lane >> 4;
    bf16_t* Z = (bf16_t*)(P.ws + WS_Z);
    const bool samp = item >= 1024;
    int kvh, c = 0, sb = 0, qrow0, klo, khi, nqt;
    if (!samp) { kvh = item & 1; c = (item >> 1) & 127; const int b = item >> 8; qrow0 = b * SEQ + 64 * c; klo = 128 - 64 * (c < 2 ? c : 2); khi = 192; nqt = 4; }
    else { const int s = item - 1024; kvh = s & 1; sb = s >> 1; qrow0 = MP + sb * ST; klo = 0; khi = 160; nqt = 2; }
    lds_barrier();
    const int h = kvh * 8 + wave;
    bf16x8 qc0, qc1;
    { const bf16_t* qp = Z + (size_t)(qrow0 + fr) * NIN + h * 64; qc0 = *(const bf16x8*)(qp + 8 * fq); qc1 = *(const bf16x8*)(qp + 32 + 8 * fq); }
    {
        const int ch = tid & 7, key0 = tid >> 3;
#pragma unroll
        for (int p = 0; p < 3; ++p) {
            const int j = key0 + 64 * p;
            u32x4 kk = (u32x4){0u, 0u, 0u, 0u}, vv = (u32x4){0u, 0u, 0u, 0u};
            if (j >= klo && j < khi) {
                if (samp && j < 128) {
                    const float* kp = P.cache_k + ((((size_t)layer * 8 + sb) * 128 + j) * 2 + kvh) * 64 + ch * 8;
                    const float* vp = P.cache_v + ((((size_t)layer * 8 + sb) * 128 + j) * 2 + kvh) * 64 + ch * 8;
                    const f32x4 k0 = *(const f32x4*)kp, k1 = *(const f32x4*)(kp + 4), v0 = *(const f32x4*)vp, v1 = *(const f32x4*)(vp + 4);
                    kk.x = pk2(k0[0], k0[1]); kk.y = pk2(k0[2], k0[3]); kk.z = pk2(k1[0], k1[1]); kk.w = pk2(k1[2], k1[3]);
                    vv.x = pk2(v0[0], v0[1]); vv.y = pk2(v0[2], v0[3]); vv.z = pk2(v1[0], v1[1]); vv.w = pk2(v1[2], v1[3]);
                } else {
                    const int row = samp ? (qrow0 + j - 128) : (qrow0 - 128 + j);
                    const bf16_t* zp = Z + (size_t)row * NIN + kvh * 64 + ch * 8;
                    kk = *(const u32x4*)(zp + ZC_K); vv = *(const u32x4*)(zp + ZC_V);
                }
            }
            *(LAS u32x4*)(lds + ATT_KS + j * KS_STRIDE + ch * 16) = kk;
            const int pj = (j & ~31) | ((j & 12) << 1) | ((j & 16) >> 2) | (j & 3);
            LAS bf16_t* vt = (LAS bf16_t*)(lds + ATT_VT + (ch * 8) * VT_STRIDE + pj * 2);
            vt[0 * (VT_STRIDE / 2)] = (bf16_t)(vv.x & 0xffff); vt[1 * (VT_STRIDE / 2)] = (bf16_t)(vv.x >> 16);
            vt[2 * (VT_STRIDE / 2)] = (bf16_t)(vv.y & 0xffff); vt[3 * (VT_STRIDE / 2)] = (bf16_t)(vv.y >> 16);
            vt[4 * (VT_STRIDE / 2)] = (bf16_t)(vv.z & 0xffff); vt[5 * (VT_STRIDE / 2)] = (bf16_t)(vv.z >> 16);
            vt[6 * (VT_STRIDE / 2)] = (bf16_t)(vv.w & 0xffff); vt[7 * (VT_STRIDE / 2)] = (bf16_t)(vv.w >> 16);
        }
    }
    lds_barrier();
    const float slope = exp2f(-0.5f * (float)(h + 1)) * 1.4426950408889634f;
    const float sink = P.attn_sink[layer * 16 + h] * 1.4426950408889634f;
    const bool need_mask = klo > 0 || khi < 192;
#pragma unroll 1
    for (int qt = 0; qt < nqt; ++qt) {
        const int qrow = qrow0 + 16 * qt + fr;
        bf16_t* qp = Z + (size_t)qrow * NIN + h * 64;
        const bf16x8 q0 = qc0, q1 = qc1;
        { const bf16_t* qn = Z + (size_t)(qrow0 + 16 * (qt + 1 < nqt ? qt + 1 : qt) + fr) * NIN + h * 64;
          qc0 = *(const bf16x8*)(qn + 8 * fq); qc1 = *(const bf16x8*)(qn + 32 + 8 * fq); }
        f32x4 st[12];
#pragma unroll
        for (int kt = 0; kt < 12; ++kt) {
            const LAS unsigned char* kp = lds + ATT_KS + (16 * kt + fr) * KS_STRIDE + 16 * fq;
            const bf16x8 a0 = *(const LAS bf16x8*)kp, a1 = *(const LAS bf16x8*)(kp + 64);
            f32x4 a = (f32x4){0.f, 0.f, 0.f, 0.f};
            a = __builtin_amdgcn_mfma_f32_16x16x32_bf16(a0, q0, a, 0, 0, 0);
            a = __builtin_amdgcn_mfma_f32_16x16x32_bf16(a1, q1, a, 0, 0, 0);
            st[kt] = a;
            if ((kt & 3) == 3) asm volatile("" ::: "memory");
        }
        const float d0 = (float)(128 + 16 * qt + fr - 4 * fq);
        float mx = -INFINITY;
#pragma unroll
        for (int kt = 0; kt < 12; ++kt)
#pragma unroll
            for (int jj = 0; jj < 4; ++jj) {
                const float t = slope * fabsf(d0 - (float)(16 * kt + jj));
                float lg = st[kt][jj] * (0.125f * 1.4426950408889634f) - t;
                if (need_mask) { const int key = 16 * kt + 4 * fq + jj; lg = (key >= klo && key < khi) ? lg : -INFINITY; }
                st[kt][jj] = lg; mx = fmaxf(mx, lg);
            }
        mx = fmaxf(mx, __shfl_xor(mx, 16)); mx = fmaxf(mx, __shfl_xor(mx, 32));
        mx = fmaxf(mx, sink);
        float sum = 0.f;
#pragma unroll
        for (int kt = 0; kt < 12; ++kt)
#pragma unroll
            for (int jj = 0; jj < 4; ++jj) { const float p = __builtin_amdgcn_exp2f(st[kt][jj] - mx); st[kt][jj] = p; sum += p; }
        sum += __shfl_xor(sum, 16); sum += __shfl_xor(sum, 32);
        const float inv = __builtin_amdgcn_rcpf(sum + __builtin_amdgcn_exp2f(sink - mx));
        bf16x8 pb[6];
#pragma unroll
        for (int s = 0; s < 6; ++s) {
            u32x4 w; w.x = pk2(st[2 * s][0], st[2 * s][1]); w.y = pk2(st[2 * s][2], st[2 * s][3]);
            w.z = pk2(st[2 * s + 1][0], st[2 * s + 1][1]); w.w = pk2(st[2 * s + 1][2], st[2 * s + 1][3]);
            pb[s] = __builtin_bit_cast(bf16x8, w);
        }
#pragma unroll 1
        for (int dp = 0; dp < 2; ++dp) {
            f32x4 o0 = (f32x4){0.f, 0.f, 0.f, 0.f}, o1 = o0;
            const int vrow = 32 * dp + 8 * (fr >> 2) + (fr & 3);
#pragma unroll
            for (int s = 0; s < 6; ++s) {
                const bf16x8 av0 = *(const LAS bf16x8*)(lds + ATT_VT + vrow * VT_STRIDE + (32 * s + 8 * fq) * 2);
                const bf16x8 av1 = *(const LAS bf16x8*)(lds + ATT_VT + (vrow + 4) * VT_STRIDE + (32 * s + 8 * fq) * 2);
                o0 = __builtin_amdgcn_mfma_f32_16x16x32_bf16(av0, pb[s], o0, 0, 0, 0);
                o1 = __builtin_amdgcn_mfma_f32_16x16x32_bf16(av1, pb[s], o1, 0, 0, 0);
            }
            u32x4 w; w.x = pk2(o0[0] * inv, o0[1] * inv); w.y = pk2(o0[2] * inv, o0[3] * inv); w.z = pk2(o1[0] * inv, o1[1] * inv); w.w = pk2(o1[2] * inv, o1[3] * inv);
            if (!dry) *(u32x4*)(qp + 32 * dp + 8 * fq) = w;
        }
    }
}

constexpr int MX_RS = 0, MX_VNT = 1024, MX_U = 36864, MX_DT = 76800, MX_NG = 112640, MX_ST = 272;
__device__ __forceinline__ void mix_item(const Params& P, int layer, int item, LAS unsigned char* lds, const bool dry = false) {
    const int tid = threadIdx.x, lane = tid & 63, wave = __builtin_amdgcn_readfirstlane(tid >> 6), fr = lane & 15, fq = lane >> 4;
    bf16_t* Z = (bf16_t*)(P.ws + WS_Z);
    const unsigned char* wl = P.ws + WS_W + (size_t)layer * WL_SIZE;
    const bool samp = item >= 256;
    int row0, L, t0, sb = 0;
    if (!samp) { const int b = item >> 6, ch = item & 63; row0 = b * SEQ + ch * 128; L = 128; t0 = ch * 128; }
    else { sb = item - 256; row0 = MP + sb * ST; L = ST; t0 = 0; }
    LAS float* RS = (LAS float*)(lds + MX_RS);
    LAS float* NG = (LAS float*)(lds + MX_NG);
    const bool act = wave * 16 < L;
    const int ti = wave * 16 + fr;
    lds_barrier();
    { const float n0_ = P.sgu_norm_g[layer * 512 + tid], n1_ = P.pool_scale[layer * 512 + tid], n2_ = P.sgu_b[layer * 512 + tid]; NG[tid] = n0_; NG[512 + tid] = n1_; NG[1024 + tid] = n2_; }
    {
        u32x4 rw[16];
#pragma unroll
        for (int k = 0; k < 16; ++k) { const int i = wave * 16 + k; rw[k] = *(const u32x4*)(Z + (size_t)(row0 + (i < L ? i : 0)) * NIN + ZC_SV + lane * 8); }
#pragma unroll
        for (int k = 0; k < 16; ++k) {
            const u32x4 w = rw[k];
            float s = bflo(w.x) * bflo(w.x) + bfhi(w.x) * bfhi(w.x) + bflo(w.y) * bflo(w.y) + bfhi(w.y) * bfhi(w.y)
                    + bflo(w.z) * bflo(w.z) + bfhi(w.z) * bfhi(w.z) + bflo(w.w) * bflo(w.w) + bfhi(w.w) * bfhi(w.w);
            s = wave_sum(s);
            if (lane == 0) RS[wave * 16 + k] = rsqrtf(s * (1.f / 512.f) + 1e-6f);
        }
    }
    u32x4 svr[4]; bf16x8 wf[4]; u32x2 uu[8];
    bf16_t* const zsu = Z + (size_t)(row0 + (act ? ti : 0)) * NIN + ZC_SU + 4 * fq;
    const bf16_t* const wsg = (const bf16_t*)(wl + WL_SG) + (size_t)(act ? ti : 0) * 128 + 8 * fq;
#define MIX_LOAD_SGU(gg) do { \
        _Pragma("unroll") for (int p = 0; p < 4; ++p) { const int idx = tid + NTHREADS * p, j = idx >> 4, c8 = idx & 15; \
            if (j < L) svr[p] = *(const u32x4*)(Z + (size_t)(row0 + j) * NIN + ZC_SV + (gg) * 128 + c8 * 8); } \
        _Pragma("unroll") for (int ks = 0; ks < 4; ++ks) wf[ks] = *(const bf16x8*)(wsg + (size_t)(gg) * 128 * 128 + 32 * ks); \
        _Pragma("unroll") for (int ct = 0; ct < 8; ++ct) uu[ct] = *(const u32x2*)(zsu + (gg) * 128 + 16 * ct); } while (0)
#pragma unroll
    for (int p = 0; p < 4; ++p) svr[p] = (u32x4){0u, 0u, 0u, 0u};
    MIX_LOAD_SGU(0);
    lds_barrier();
#pragma unroll 1
    for (int g = 0; g < 4; ++g) {
#pragma unroll
        for (int p = 0; p < 4; ++p) {
            const int idx = tid + NTHREADS * p, j = idx >> 4, c8 = idx & 15;
            float vn[8];
            if (j < L) {
                const u32x4 w = svr[p];
                const float rs = RS[j];
                const f32x4 n0 = *(const LAS f32x4*)(NG + g * 128 + c8 * 8), n1 = *(const LAS f32x4*)(NG + g * 128 + c8 * 8 + 4);
                vn[0] = bflo(w.x) * rs * n0[0]; vn[1] = bfhi(w.x) * rs * n0[1]; vn[2] = bflo(w.y) * rs * n0[2]; vn[3] = bfhi(w.y) * rs * n0[3];
                vn[4] = bflo(w.z) * rs * n1[0]; vn[5] = bfhi(w.z) * rs * n1[1]; vn[6] = bflo(w.w) * rs * n1[2]; vn[7] = bfhi(w.w) * rs * n1[3];
                if (samp) { float* dst = P.out + O_SV + ((size_t)((layer * 8 + sb) * ST + j)) * 512 + g * 128 + c8 * 8;
                    *(f32x4*)dst = (f32x4){vn[0], vn[1], vn[2], vn[3]}; *(f32x4*)(dst + 4) = (f32x4){vn[4], vn[5], vn[6], vn[7]}; }
            } else {
#pragma unroll
                for (int e = 0; e < 8; ++e) vn[e] = 0.f;
            }
            LAS bf16_t* vt = (LAS bf16_t*)(lds + MX_VNT + (c8 * 8) * MX_ST + (((j >> 3) ^ c8) << 4) + (j & 7) * 2);
#pragma unroll
            for (int e = 0; e < 8; ++e) vt[e * (MX_ST / 2)] = (bf16_t)f2bf(vn[e]);
        }
        bf16x8 wc_[4]; u32x2 uc[8];
#pragma unroll
        for (int ks = 0; ks < 4; ++ks) wc_[ks] = wf[ks];
#pragma unroll
        for (int ct = 0; ct < 8; ++ct) uc[ct] = uu[ct];
        if (g < 3) MIX_LOAD_SGU(g + 1);
        const float bias = NG[1024 + g * 128 + (act ? ti : 0)];
        lds_barrier();
        if (act) {
            bf16_t* zrow = zsu + g * 128;
#pragma unroll
            for (int ct = 0; ct < 8; ++ct) {
                f32x4 a = (f32x4){0.f, 0.f, 0.f, 0.f};
#pragma unroll
                for (int ks = 0; ks < 4; ++ks) {
                    const bf16x8 av = *(const LAS bf16x8*)(lds + MX_VNT + (16 * ct + fr) * MX_ST + (((4 * ks + fq) ^ (2 * ct + (fr >> 3))) << 4));
                    a = __builtin_amdgcn_mfma_f32_16x16x32_bf16(av, wc_[ks], a, 0, 0, 0);
                }
                u32x2 w; w.x = pk2(bflo(uc[ct].x) * (a[0] + bias), bfhi(uc[ct].x) * (a[1] + bias)); w.y = pk2(bflo(uc[ct].y) * (a[2] + bias), bfhi(uc[ct].y) * (a[3] + bias));
                if (!dry) *(u32x2*)(zrow + 16 * ct) = w;
            }
        }
        lds_barrier();
    }
#undef MIX_LOAD_SGU
    u32x4 ur[5], wq[4];
#define MIX_LOAD_U(gg) do { _Pragma("unroll") for (int p = 0; p < 5; ++p) { const int idx = tid + NTHREADS * p, hh = idx >> 4, c8 = idx & 15, rel = hh - 15; \
            ur[p] = (u32x4){0u, 0u, 0u, 0u}; \
            if (idx < (15 + L) * 16) { \
                if (rel >= 0 || (!samp && t0 > 0)) ur[p] = *(const u32x4*)(Z + (size_t)(row0 + rel) * NIN + ZC_PU + (gg) * 128 + c8 * 8); \
                else if (samp) { const float* sp = P.state_pool + ((size_t)(layer * 8 + sb) * 15 + hh) * 512 + (gg) * 128 + c8 * 8; \
                    const f32x4 a_ = *(const f32x4*)sp, b_ = *(const f32x4*)(sp + 4); \
                    ur[p].x = pk2(a_[0], a_[1]); ur[p].y = pk2(a_[2], a_[3]); ur[p].z = pk2(b_[0], b_[1]); ur[p].w = pk2(b_[2], b_[3]); } } } \
        _Pragma("unroll") for (int p = 0; p < 4; ++p) { const int idx = tid + NTHREADS * p; \
            wq[p] = *(const u32x4*)((const bf16_t*)(wl + WL_PW) + (size_t)(gg) * 128 * 128 + (size_t)(idx >> 4) * 128 + (idx & 15) * 8); } } while (0)
    MIX_LOAD_U(0);
#pragma unroll 1
    for (int g = 0; g < 4; ++g) {
        const int wlen = 2 << g;
#pragma unroll
        for (int p = 0; p < 5; ++p) { const int idx = tid + NTHREADS * p; if (idx < (15 + L) * 16) *(LAS u32x4*)(lds + MX_U + (idx >> 4) * MX_ST + (idx & 15) * 16) = ur[p]; }
#pragma unroll
        for (int p = 0; p < 4; ++p) { const int idx = tid + NTHREADS * p; *(LAS u32x4*)(lds + MX_VNT + (idx >> 4) * MX_ST + (idx & 15) * 16) = wq[p]; }
        if (g < 3) MIX_LOAD_U(g + 1);
        lds_barrier();
        for (int idx = tid; idx < L * 16; idx += NTHREADS) {
            const int i = idx >> 4, c8 = idx & 15;
            float sm[8];
#pragma unroll
            for (int e = 0; e < 8; ++e) sm[e] = 0.f;
            for (int k = 0; k < wlen; ++k) {
                const u32x4 w = *(const LAS u32x4*)(lds + MX_U + (15 + i - k) * MX_ST + c8 * 16);
                sm[0] += bflo(w.x); sm[1] += bfhi(w.x); sm[2] += bflo(w.y); sm[3] += bfhi(w.y); sm[4] += bflo(w.z); sm[5] += bfhi(w.z); sm[6] += bflo(w.w); sm[7] += bfhi(w.w);
            }
            const u32x4 w = *(const LAS u32x4*)(lds + MX_U + (15 + i) * MX_ST + c8 * 16);
            const int pos1 = samp ? (1024 + i + 1) : (t0 + i + 1);
            const float rc = 1.0f / (float)(pos1 < wlen ? pos1 : wlen);
            u32x4 o;
            o.x = pk2(sm[0] * rc - bflo(w.x), sm[1] * rc - bfhi(w.x)); o.y = pk2(sm[2] * rc - bflo(w.y), sm[3] * rc - bfhi(w.y));
            o.z = pk2(sm[4] * rc - bflo(w.z), sm[5] * rc - bfhi(w.z)); o.w = pk2(sm[6] * rc - bflo(w.w), sm[7] * rc - bfhi(w.w));
            *(LAS u32x4*)(lds + MX_DT + i * MX_ST + c8 * 16) = o;
        }
        lds_barrier();
        if (act) {
            const int i = wave * 16 + fr;
            bf16x8 df[4];
#pragma unroll
            for (int ks = 0; ks < 4; ++ks) df[ks] = *(const LAS bf16x8*)(lds + MX_DT + i * MX_ST + (32 * ks + 8 * fq) * 2);
            bf16_t* zrow = Z + (size_t)(row0 + i) * NIN + ZC_SV + g * 128 + 4 * fq;
#pragma unroll
            for (int nt = 0; nt < 8; ++nt) {
                f32x4 a = (f32x4){0.f, 0.f, 0.f, 0.f};
#pragma unroll
                for (int ks = 0; ks < 4; ++ks) {
                    const bf16x8 wv = *(const LAS bf16x8*)(lds + MX_VNT + (16 * nt + fr) * MX_ST + (32 * ks + 8 * fq) * 2);
                    a = __builtin_amdgcn_mfma_f32_16x16x32_bf16(wv, df[ks], a, 0, 0, 0);
                }
                const f32x4 sc = *(const LAS f32x4*)(NG + 512 + g * 128 + 16 * nt + 4 * fq);
                u32x2 w; w.x = pk2(a[0] * sc[0], a[1] * sc[1]); w.y = pk2(a[2] * sc[2], a[3] * sc[3]);
                if (!dry) *(u32x2*)(zrow + 16 * nt) = w;
            }
        }
        lds_barrier();
    }
#undef MIX_LOAD_U
}

__device__ __forceinline__ void phase_mixers(const Params& P, int layer, LAS unsigned char* lds) {
    for (int it = blockIdx.x; it < 1304; it += gridDim.x) {
        if (it < 256) mix_item(P, layer, it, lds);
        else if (it < 1280) attn_item(P, layer, it - 256, lds);
        else if (it < 1296) attn_item(P, layer, 1024 + (it - 1280), lds);
        else mix_item(P, layer, 256 + (it - 1296), lds);
    }
}

__device__ __forceinline__ void phase_conv(const Params& P, int layer) {
    bf16_t* AB = (bf16_t*)(P.ws + WS_Z);
    const int gt = blockIdx.x * NTHREADS + threadIdx.x, NGT = gridDim.x * NTHREADS;
    const float* cw = P.ffn_conv_w + (size_t)layer * 3 * DFF; const float* cb = P.ffn_conv_b + (size_t)layer * DFF;
    for (int idx = gt; idx < M * (DFF / 8); idx += NGT) {
        const int r = idx / (DFF / 8), f = (idx - r * (DFF / 8)) * 8;
        int t, sb = 0; const bool samp = r >= MP;
        if (!samp) t = r & 8191; else { t = (r - MP) & 31; sb = (r - MP) >> 5; }
        float a0[8], a1[8], a2[8];
        { const u32x4 w = *(const u32x4*)(AB + (size_t)r * NUP + f);
          a0[0] = bflo(w.x); a0[1] = bfhi(w.x); a0[2] = bflo(w.y); a0[3] = bfhi(w.y); a0[4] = bflo(w.z); a0[5] = bfhi(w.z); a0[6] = bflo(w.w); a0[7] = bfhi(w.w); }
        const float* pf = P.state_conv + ((size_t)(layer * 8 + sb) * 2) * DFF + f;
        if (t >= 1) { const u32x4 w = *(const u32x4*)(AB + (size_t)(r - 1) * NUP + f);
          a1[0] = bflo(w.x); a1[1] = bfhi(w.x); a1[2] = bflo(w.y); a1[3] = bfhi(w.y); a1[4] = bflo(w.z); a1[5] = bfhi(w.z); a1[6] = bflo(w.w); a1[7] = bfhi(w.w); }
        else {
#pragma unroll
            for (int e = 0; e < 8; ++e) a1[e] = samp ? pf[DFF + e] : 0.f; }
        if (t >= 2) { const u32x4 w = *(const u32x4*)(AB + (size_t)(r - 2) * NUP + f);
          a2[0] = bflo(w.x); a2[1] = bfhi(w.x); a2[2] = bflo(w.y); a2[3] = bfhi(w.y); a2[4] = bflo(w.z); a2[5] = bfhi(w.z); a2[6] = bflo(w.w); a2[7] = bfhi(w.w); }
        else {
#pragma unroll
            for (int e = 0; e < 8; ++e) a2[e] = samp ? pf[(t == 1 ? DFF : 0) + e] : 0.f; }
        const u32x4 bw = *(const u32x4*)(AB + (size_t)r * NUP + DFF + f);
        float bb[8] = {bflo(bw.x), bfhi(bw.x), bflo(bw.y), bfhi(bw.y), bflo(bw.z), bfhi(bw.z), bflo(bw.w), bfhi(bw.w)};
        float go[8];
#pragma unroll
        for (int e = 0; e < 8; ++e) {
            const float cv = a2[e] * cw[f + e] + a1[e] * cw[DFF + f + e] + a0[e] * cw[2 * DFF + f + e] + cb[f + e];
            go[e] = gelu_tanh(cv) * bb[e];
        }
        u32x4 o; o.x = pk2(go[0], go[1]); o.y = pk2(go[2], go[3]); o.z = pk2(go[4], go[5]); o.w = pk2(go[6], go[7]);
        *(u32x4*)(AB + (size_t)r * NUP + DFF + f) = o;
    }
}

constexpr int NPHASES = 20;
#define XB_TMO      128
#define XB_XCNT(j)  (256  + 64 * (j))
#define XB_XSUB(j)  (1280 + 64 * (j))
#define XB_XGEN(j)  (2304 + 64 * (j))
#define XB_TOP      3328
#define XB_TOPGEN   3392
#define XCD_BAR_WORDS 3456
#define XB_SPIN_CAP (1u << 18)

__device__ __forceinline__ unsigned xb_ld(unsigned* p)              { return __hip_atomic_load(p, __ATOMIC_RELAXED, __HIP_MEMORY_SCOPE_AGENT); }
__device__ __forceinline__ unsigned xb_add(unsigned* p, unsigned v) { return __hip_atomic_fetch_add(p, v, __ATOMIC_RELAXED, __HIP_MEMORY_SCOPE_AGENT); }
__device__ __forceinline__ unsigned xb_xcc_id() { return (unsigned)__builtin_amdgcn_s_getreg((3 << 11) | 20) & 0xFu; }
#define XB_SPIN(cond, bar) do { unsigned _sp = 0; while (cond) { __builtin_amdgcn_s_sleep(1); \
    if ((++_sp & 255u) == 0u) { if (xb_ld(&(bar)[XB_TMO])) break; if (_sp > XB_SPIN_CAP) { atomicAdd(&(bar)[XB_TMO], 1u); break; } } } } while (0)

struct XcdBarrier {
    unsigned* bar; unsigned x;
    volatile LAS unsigned* st;
};

__device__ __forceinline__ XcdBarrier xcd_barrier_post(unsigned* bar, volatile LAS unsigned* st) {
    XcdBarrier b; b.bar = bar; b.x = xb_xcc_id(); b.st = st;
    if (threadIdx.x == 0) (void)xb_add(&bar[XB_XCNT(b.x)], 1u);
    return b;
}
__device__ __forceinline__ void xcd_barrier_complete(unsigned* bar, unsigned x, unsigned& nloc, unsigned& nx) {
    const unsigned G = gridDim.x * gridDim.y * gridDim.z;
    unsigned sum, cnt, mine, sp = 0u;
    for (;;) {
        sum = 0u; cnt = 0u; mine = 0u;
#pragma unroll
        for (unsigned j = 0; j < 16; ++j) { const unsigned c = xb_ld(&bar[XB_XCNT(j)]); sum += c; cnt += (c > 0u) ? 1u : 0u; mine = (j == x) ? c : mine; }
        if (sum == G) break;
        __builtin_amdgcn_s_sleep(1);
        if ((++sp & 255u) == 0u) { if (xb_ld(&bar[XB_TMO])) break; if (sp > XB_SPIN_CAP) { atomicAdd(&bar[XB_TMO], 1u); break; } }
    }
    nloc = mine > 0u ? mine : 1u; nx = cnt > 0u ? cnt : 1u;
}

__device__ __forceinline__ void xcd_barrier(const XcdBarrier& b) {
    asm volatile("s_waitcnt vmcnt(0)" ::: "memory");
    __syncthreads();
    if (threadIdx.x == 0) {
        unsigned* bar = b.bar;
        __builtin_amdgcn_s_waitcnt(0);
        unsigned nloc = b.st[0], nx = b.st[1];
        if (nloc == 0u) { xcd_barrier_complete(bar, b.x, nloc, nx); b.st[0] = nloc; b.st[1] = nx; }
        const unsigned old = xb_add(&bar[XB_XSUB(b.x)], 1u);
        const unsigned gen = old / nloc;
        if (old + 1u == (gen + 1u) * nloc) {
            __builtin_amdgcn_fence(__ATOMIC_RELEASE, "agent");
            asm volatile("s_waitcnt vmcnt(0)" ::: "memory");
            const unsigned og = xb_add(&bar[XB_TOP], 1u);
            const unsigned tg = og / nx;
            if (og + 1u == (tg + 1u) * nx) xb_add(&bar[XB_TOPGEN], 1u);
            else XB_SPIN(xb_ld(&bar[XB_TOPGEN]) == tg, bar);
            __builtin_amdgcn_fence(__ATOMIC_ACQUIRE, "agent");
            xb_add(&bar[XB_XGEN(b.x)], 1u);
            asm volatile("s_waitcnt vmcnt(0)" ::: "memory");
        } else {
            XB_SPIN(xb_ld(&bar[XB_XGEN(b.x)]) == gen, bar);
            __builtin_amdgcn_fence(__ATOMIC_ACQUIRE, "agent");
            asm volatile("s_waitcnt vmcnt(0)" ::: "memory");
        }
    }
    __syncthreads();
}


#define RUN(k) (lo <= (k) && (k) < hi)
#define SYNC(k) do { if ((k) + 1 < hi) xcd_barrier(bar); } while (0)
template <int l>
__device__ __forceinline__ void layer_phases(const Params& P, LAS unsigned char* lds, const XcdBarrier& bar) {
    const int lo = P.ph_lo, hi = P.ph_hi;
    const int G = gridDim.x, c = blockIdx.x;
    unsigned char* ws = P.ws;
    const float* MOD = (const float*)(ws + WS_MOD);
    bf16_t* H = (bf16_t*)(ws + WS_H);
    bf16_t* Z = (bf16_t*)(ws + WS_Z);
    bf16_t* PSb = (bf16_t*)(ws + WS_PS);
    constexpr int pb = 1 + 9 * l;
    const unsigned char* wl = ws + WS_W + (size_t)l * WL_SIZE;
    const float* modl = MOD + (size_t)l * 12 * 6144;
    const float* srcp = l == 0 ? P.x_prompt : P.out + O_YP;
    const float* srcs = l == 0 ? P.x_sample : P.out + O_YS;
    if (RUN(pb + 0)) { phase_norm(P, lds, srcp, srcs, P.norm1_g + l * D, modl + 0 * D, modl + 1 * D, l == 0 ? P.out + O_YS : nullptr); SYNC(pb + 0); }
    if (RUN(pb + 1)) {
        pg8::SimpleOrder S{(const char*)H, (const char*)(wl + WL_IN), (size_t)D * 2, (size_t)D * 2, M / 256, NIN / 256, D / 64, G, c};
        EpiZ E{Z, P.out, l};
        pg8::gemm_phase<EpiZ, pg8::SimpleOrder>(lds, (size_t)D * 2, (size_t)D * 2, S, E, STG_BIG * ((c >> 3) & 7));
        SYNC(pb + 1);
    }
    if (l == 0 && PROBE == 1) {
        pg8::SimpleOrder S{(const char*)H, (const char*)(wl + WL_IN), (size_t)D * 2, (size_t)D * 2, M / 256, NIN / 256, D / 64, G, c};
        EpiZ E{Z, P.out, l};
        pg8::gemm_phase<EpiZ, pg8::SimpleOrder>(lds, (size_t)D * 2, (size_t)D * 2, S, E);
        xcd_barrier(bar);
    }
    if (l == 0 && PROBE == 6) { const bool dry = P.ph_hi < 100; for (int it = blockIdx.x; it < 1040; it += gridDim.x) attn_item(P, l, it, lds, dry); xcd_barrier(bar); }
    if (l == 0 && PROBE == 7) { const bool dry = P.ph_hi < 100; for (int it = blockIdx.x; it < 264; it += gridDim.x) mix_item(P, l, it, lds, dry); xcd_barrier(bar); }
    if (RUN(pb + 2)) { phase_mixers(P, l, lds); SYNC(pb + 2); }
    if (l == 0 && PROBE == 2) {
        pg8::SimpleOrder S{(const char*)H, (const char*)(wl + WL_IN), (size_t)D * 2, (size_t)D * 2, M / 256, NIN / 256, D / 64, G, c};
        EpiZ E{Z, P.out, l};
        pg8::gemm_phase<EpiZ, pg8::SimpleOrder>(lds, (size_t)D * 2, (size_t)D * 2, S, E);
        xcd_barrier(bar);
        phase_mixers(P, l, lds);
        xcd_barrier(bar);
    }
    if (RUN(pb + 3)) {
        pg8::MergeOrder S{(const char*)Z, (const char*)(wl + WL_CAT), (size_t)NIN * 2, (size_t)2048 * 2, G, c};
        EpiMerge E{Z, H, PSb};
        pg8::gemm_phase<EpiMerge, pg8::MergeOrder>(lds, (size_t)NIN * 2, (size_t)2048 * 2, S, E, c < 48 ? 0u : STG_MERGE * ((c >> 3) & 7));
        SYNC(pb + 3);
    }
    if (RUN(pb + 4)) {
        pg8::ResOrder S{(const char*)H, (const char*)(wl + WL_OUT), (size_t)D * 2, (size_t)D * 2, D / 64, G, c,
                        (const char*)PSb, (const char*)(PSb + (size_t)MS * D), (const char*)(PSb + 2 * (size_t)MS * D), 12};
        EpiRes E{srcp, srcs, P.out, modl + 2 * D};
        pg8::gemm_phase<EpiRes, pg8::ResOrder>(lds, (size_t)D * 2, (size_t)D * 2, S, E, c < 48 ? 0u : STG_OUT * ((c >> 3) & 7));
        SYNC(pb + 4);
    }
    if (RUN(pb + 5)) { phase_norm(P, lds, P.out + O_YP, P.out + O_YS, P.norm2_g + l * D, modl + 3 * D, modl + 4 * D); SYNC(pb + 5); }
    if (RUN(pb + 6)) {
        pg8::UpOrder S{(const char*)H, (const char*)(wl + WL_UP), (size_t)D * 2, (size_t)D * 2, (M + 253) / 254, NUP / 256, D / 64, G, c};
        EpiUpConv E{Z, P.out, P.ffn_conv_w + (size_t)l * 3 * DFF, P.ffn_conv_b + (size_t)l * DFF, P.state_conv + (size_t)l * 8 * 2 * DFF, l, lds};
        pg8::gemm_phase<EpiUpConv, pg8::UpOrder>(lds, (size_t)D * 2, (size_t)D * 2, S, E, STG_BIG * ((c >> 3) & 7));
        if (l == 0 && !P0_BOTH_LAYERS) {
            const int nunits = ((M + 253) / 254) * (NUP / 256), heavy = nunits % G, nlight = heavy ? G - heavy : G;
            if (c >= (heavy ? heavy : 0)) {
                const int wave = __builtin_amdgcn_readfirstlane(threadIdx.x >> 6);
                p0_convert_layer(P, 1, (LAS float*)(lds + wave * 8704), threadIdx.x & 63, (c - (heavy ? heavy : 0)) * NWAVES + wave, nlight * NWAVES);
            }
        }
        SYNC(pb + 6);
    }
    if (l == 0 && PROBE == 8) {
        pg8::UpOrder S{(const char*)H, (const char*)(wl + WL_UP), (size_t)D * 2, (size_t)D * 2, (M + 253) / 254, NUP / 256, D / 64, G, c};
        EpiUpConv E{Z, P.out, P.ffn_conv_w + (size_t)l * 3 * DFF, P.ffn_conv_b + (size_t)l * DFF, P.state_conv + (size_t)l * 8 * 2 * DFF, l, lds};
        pg8::gemm_phase<EpiUpConv, pg8::UpOrder>(lds, (size_t)D * 2, (size_t)D * 2, S, E);
        xcd_barrier(bar);
    }
    if (RUN(pb + 8)) {
        pg8::ResOrder S{(const char*)Z, (const char*)(wl + WL_DN), (size_t)DFF * 2, (size_t)DFF * 2, DFF / 64, G, c,
                        (const char*)(Z + (size_t)MP * DFF), nullptr, nullptr, 11};
        EpiRes E{P.out + O_YP, P.out + O_YS, P.out, modl + 5 * D};
        pg8::gemm_phase<EpiRes, pg8::ResOrder>(lds, (size_t)DFF * 2, (size_t)DFF * 2, S, E, c < 48 ? 0u : STG_DOWN * ((c >> 3) & 7));
        SYNC(pb + 8);
    }
}
__global__ void __launch_bounds__(NTHREADS) mk_fwd(Params P) {
    extern __shared__ __attribute__((aligned(16))) unsigned char lds_raw[];
    LAS unsigned char* lds = (LAS unsigned char*)lds_raw;
    cg::grid_group grid = cg::this_grid();
    const int lo = P.ph_lo, hi = P.ph_hi;
    unsigned* barw = (unsigned*)(P.ws + WS_BAR);
    volatile LAS unsigned* st = (volatile LAS unsigned*)(lds + XCH_OFF + 4096);
    if (threadIdx.x < 2) st[threadIdx.x] = 0u;
    if (lo == 0 && blockIdx.x == 0) for (int i = threadIdx.x; i < XCD_BAR_WORDS; i += NTHREADS) barw[i] = 0u;
    __syncthreads();
    if (RUN(0)) { phase_p0(P, lds); if (1 < hi) grid.sync(); }
    XcdBarrier bar = xcd_barrier_post(barw, st);
    if (PROBE == 4) { phase_p0(P, lds); xcd_barrier(bar); phase_norm(P, lds, P.x_prompt, P.x_sample, P.norm1_g, (const float*)(P.ws + WS_MOD), (const float*)(P.ws + WS_MOD) + D); xcd_barrier(bar); }
    if (PROBE == 5) { for (int i = 0; i < 20; ++i) xcd_barrier(bar); }
    layer_phases<0>(P, lds, bar);
    layer_phases<1>(P, lds, bar);
    if (RUN(19)) phase_final(P);
}
#undef RUN
#undef SYNC

extern "C" void kernel_launch(void* const* d_in, const int* in_sizes, int n_in, void* d_out, int out_size, void* d_ws, size_t ws_size, hipStream_t stream) {
    static int grid = 0;
    if (grid == 0) {
        if (n_in != 28 || ws_size < WS_END) { fprintf(stderr, "kernel_launch: need 28 inputs and %zu B of workspace (got %d, %zu)\n", (size_t)WS_END, n_in, ws_size); grid = -1; return; }
        int dev = 0, cus = 0, per_cu = 0;
        hipGetDevice(&dev);
        hipDeviceGetAttribute(&cus, hipDeviceAttributeMultiprocessorCount, dev);
        if (hipFuncSetAttribute((const void*)mk_fwd, hipFuncAttributeMaxDynamicSharedMemorySize, LDS_BYTES) != hipSuccess) { fprintf(stderr, "kernel_launch: hipFuncSetAttribute failed\n"); grid = -1; return; }
        if (hipOccupancyMaxActiveBlocksPerMultiprocessor(&per_cu, (const void*)mk_fwd, NTHREADS, LDS_BYTES) != hipSuccess || per_cu < 1) { fprintf(stderr, "kernel_launch: occupancy query failed (%d)\n", per_cu); per_cu = 1; }
        (void)hipGetLastError();
        grid = cus * per_cu;
    }
    if (grid < 0) return;
    Params p{};
    const float** ip = (const float**)&p;
    for (int i = 0; i < 28; ++i) ip[i] = (const float*)d_in[i];
    p.out = (float*)d_out; p.ws = (unsigned char*)d_ws;
#if MULTI_LAUNCH
    for (int ph = 0; ph < NPHASES; ++ph) {
        p.ph_lo = ph; p.ph_hi = ph + 1;
        hipLaunchKernelGGL(mk_fwd, dim3(grid), dim3(NTHREADS), LDS_BYTES, stream, p);
    }
#else
    p.ph_lo = 0; p.ph_hi = NPHASES;
    void* args[] = {&p};
    hipError_t e = hipLaunchCooperativeKernel((const void*)mk_fwd, dim3(grid), dim3(NTHREADS), args, LDS_BYTES, stream);
    if (e != hipSuccess) fprintf(stderr, "cooperative launch failed: %s (grid %d)\n", hipGetErrorString(e), grid);
#endif
}
```

```cpp
#include <hip/hip_runtime.h>
#include <hip/hip_cooperative_groups.h>
#include <cstdio>
namespace cg = cooperative_groups;

#ifndef MULTI_LAUNCH
#define MULTI_LAUNCH 0
#endif

#ifndef PROBE
#define PROBE 0
#endif
#ifndef STG_BIG
#define STG_BIG 0u
#define STG_MERGE 0u
#define STG_OUT 0u
#define STG_DOWN 0u
#endif
#ifndef P0_BOTH_LAYERS
#define P0_BOTH_LAYERS 0
#endif
#define P0_SPLIT 3100
#ifndef PG8_SP2
#define PG8_SP2 1
#endif
#define LAS __attribute__((address_space(3)))
typedef unsigned short bf16_t;
typedef short bf16x8 __attribute__((ext_vector_type(8)));
typedef float f32x4 __attribute__((ext_vector_type(4)));
typedef unsigned u32x4 __attribute__((ext_vector_type(4)));
typedef unsigned u32x2 __attribute__((ext_vector_type(2)));

constexpr int D = 1024, SEQ = 8192, NBP = 4, NBS = 8, ST = 32;
constexpr int MP = NBP * SEQ;
constexpr int MS = NBS * ST;
constexpr int M = MP + MS;
constexpr int NIN = 5888, DFF = 2816, NUP = 5632;
constexpr int NTHREADS = 512, NWAVES = 8;
constexpr int ZC_Q = 0, ZC_K = 1024, ZC_V = 1152, ZC_PU = 1280, ZC_SU = 1792, ZC_SV = 2304, ZC_G = 2816;
constexpr size_t O_YP = 0;
constexpr size_t O_YS = O_YP + (size_t)MP * D;
constexpr size_t O_KP = O_YS + (size_t)MS * D;
constexpr size_t O_VP = O_KP + 2 * 4 * 128 * 128;
constexpr size_t O_PP = O_VP + 2 * 4 * 128 * 128;
constexpr size_t O_CP = O_PP + 2 * 4 * 15 * 512;
constexpr size_t O_KS = O_CP + 2 * 4 * 2 * DFF;
constexpr size_t O_VS = O_KS + 2 * 8 * 128 * 128;
constexpr size_t O_PS = O_VS + 2 * 8 * 128 * 128;
constexpr size_t O_CS = O_PS + 2 * 8 * 15 * 512;
constexpr size_t O_SV = O_CS + 2 * 8 * 2 * DFF;
constexpr size_t WS_MOD = 4096;
constexpr size_t WS_BAR = 655360;
constexpr size_t WS_W = 1048576;
constexpr size_t WL_IN = 0;
constexpr size_t WL_CAT = WL_IN + (size_t)NIN * D * 2;
constexpr size_t WL_OUT = WL_CAT + (size_t)D * 2048 * 2;
constexpr size_t WL_UP = WL_OUT + (size_t)D * D * 2;
constexpr size_t WL_DN = WL_UP + (size_t)NUP * D * 2;
constexpr size_t WL_PW = WL_DN + (size_t)D * DFF * 2;
constexpr size_t WL_SG = WL_PW + 4 * 128 * 128 * 2;
constexpr size_t WL_SIZE = WL_SG + 4 * 128 * 128 * 2;
constexpr size_t WS_H = WS_W + 2 * WL_SIZE;
constexpr size_t WS_Z = WS_H + (size_t)M * D * 2;
constexpr size_t WS_PS = WS_Z + (size_t)M * NIN * 2;
constexpr size_t WS_END = WS_PS + 3 * (size_t)MS * D * 2;
constexpr int LDS_BYTES = 131072 + 8192;

struct Params {
    const float *x_prompt, *x_sample, *c_prompt, *c_sample, *cache_k, *cache_v, *state_pool, *state_conv;
    const float *norm1_g, *norm2_g, *w_ada, *b_ada, *w_in, *attn_sink, *w_o_attn, *pool_w, *pool_scale, *w_o_pool;
    const float *sgu_norm_g, *sgu_w, *sgu_b, *w_o_sgu, *w_out, *ffn_w_up, *ffn_conv_w, *ffn_conv_b, *ffn_w_down, *final_norm_g;
    float* out; unsigned char* ws;
    int ph_lo, ph_hi;
};

typedef __bf16 bf16x2_t __attribute__((ext_vector_type(2)));
typedef float f32x2_t __attribute__((ext_vector_type(2)));
__device__ __forceinline__ unsigned pk2(float lo, float hi) { const f32x2_t v = {lo, hi}; return __builtin_bit_cast(unsigned, __builtin_convertvector(v, bf16x2_t)); }
__device__ __forceinline__ unsigned f2bf(float f) { return pk2(f, 0.f) & 0xffffu; }
__device__ __forceinline__ float bflo(unsigned w) { return __builtin_bit_cast(float, w << 16); }
__device__ __forceinline__ float bfhi(unsigned w) { return __builtin_bit_cast(float, w & 0xffff0000u); }
__device__ __forceinline__ float bf1(bf16_t h) { return __builtin_bit_cast(float, ((unsigned)h) << 16); }
__device__ __forceinline__ float sigmoidf_(float x) { return __builtin_amdgcn_rcpf(1.0f + __builtin_amdgcn_exp2f(-1.4426950408889634f * x)); }
__device__ __forceinline__ float gelu_tanh(float x) { const float e = __builtin_amdgcn_exp2f(x * (-2.3022081985f - 0.1029432347f * x * x)); return x * __builtin_amdgcn_rcpf(1.0f + e); }
__device__ __forceinline__ float wave_sum(float v) {
#pragma unroll
    for (int o = 1; o < 64; o <<= 1) v += __shfl_xor(v, o);
    return v;
}
__device__ __forceinline__ int batch_of_row(int row) { return row < MP ? (row >> 13) : 4 + ((row - MP) >> 5); }

namespace pg8 {
constexpr int BM = 256, BK = 64, HALF = 128, HTB = HALF * BK * 2, NXCD = 8, WGM = 8;
__device__ __forceinline__ int lds_byte(int r, int c) { const int st = (r >> 4) * 2 + (c >> 5), rr = r & 15, cc = c & 31, ob = rr * 64 + cc * 2; return st * 1024 + (ob ^ (((ob >> 9) & 1) << 5)); }
__device__ __forceinline__ void stage_rc(int b, int& R, int& C) { const int st = b / 1024, sb = b % 1024, swz = sb ^ (((sb >> 9) & 1) << 5); R = (st >> 1) * 16 + swz / 64; C = (st & 1) * 32 + (swz % 64) / 2; }
__device__ __forceinline__ int perm32(int rho) { const int n = rho >> 4, i = rho & 15; return 8 * (i >> 2) + 4 * n + (i & 3); }

struct Unit { const char* A; const char* B; int nt, pm, pn, mode; };

__device__ __forceinline__ void tile_of(int wgid, int nM, int nN, int& pm, int& pn) {
    const int nwg = nM * nN;
    { const int q = nwg / NXCD, r = nwg % NXCD, xcd = wgid % NXCD, off = wgid / NXCD; wgid = (xcd < r ? xcd * (q + 1) : r * (q + 1) + (xcd - r) * q) + off; }
    const int nig = WGM * nN, gid = wgid / nig, fm = gid * WGM, gsz = (nM - fm) < WGM ? (nM - fm) : WGM;
    pm = fm + ((wgid % nig) % gsz); pn = (wgid % nig) / gsz;
}

struct SimpleOrder {
    const char* A; const char* B; size_t lda, ldb; int nM, nN, nt, G, c;
    __device__ __forceinline__ bool next(int i, Unit& u) const {
        const long L = (long)i * G + c; if (L >= (long)nM * nN) return false;
        int pm, pn; tile_of((int)L, nM, nN, pm, pn);
        u.pm = pm; u.pn = pn; u.nt = nt; u.mode = 0; u.A = A + (size_t)pm * 256 * lda; u.B = B + (size_t)pn * 256 * ldb; return true;
    }
};
struct MergeOrder {
    const char* A; const char* B; size_t lda, ldb; int G, c;
    __device__ __forceinline__ void fill(Unit& u, int pm, int pn, int br, int mode) const {
        u.pm = pm; u.pn = pn; u.mode = mode;
        const int ak = br == 0 ? ZC_Q : (br == 1 ? ZC_SV : ZC_SU);
        const int bk = br == 0 ? 0 : (br == 1 ? 1024 : 1536);
        u.nt = br == 0 ? 16 : 8;
        u.A = A + (size_t)pm * 256 * lda + (size_t)ak * 2; u.B = B + (size_t)pn * 256 * ldb + (size_t)bk * 2;
    }
    __device__ __forceinline__ bool next(int i, Unit& u) const {
        const int ti = i / 3, br = i - ti * 3;
        const long L = (long)ti * G + c;
        if (L < 512) { int pm, pn; tile_of((int)L, 128, 4, pm, pn); fill(u, pm, pn, br, br); return true; }
        const int e = (int)(L - 512); if (e >= 12 || br != 0) return false;
        fill(u, 128, e / 3, e % 3, 4 + e % 3); return true;
    }
};
struct ResOrder {
    const char* A; const char* B; size_t lda, ldb; int nt, G, c;
    const char* As0; const char* As1; const char* As2; int ppt;
    __device__ __forceinline__ bool next(int i, Unit& u) const {
        const long L = (long)i * G + c;
        if (L < 512) { int pm, pn; tile_of((int)L, 128, 4, pm, pn); u.pm = pm; u.pn = pn; u.nt = nt; u.mode = 0; u.A = A + (size_t)pm * 256 * lda; u.B = B + (size_t)pn * 256 * ldb; return true; }
        const int e = (int)(L - 512); if (e >= 4 * ppt) return false;
        const int pn = e / ppt, kp = e - pn * ppt;
        u.pm = 128; u.pn = pn; u.nt = 4; u.mode = 1;
        if (As1) { const int b = kp >> 2, ko = (kp & 3) * 256; u.A = (b == 0 ? As0 : (b == 1 ? As1 : As2)) + (size_t)ko * 2; u.B = B + (size_t)pn * 256 * ldb + (size_t)ko * 2; }
        else { u.A = As0 + (size_t)kp * 512; u.B = B + (size_t)pn * 256 * ldb + (size_t)kp * 512; }
        return true;
    }
};

struct UpOrder {
    const char* A; const char* B; size_t lda, ldb; int nM, nN, nt, G, c;
    __device__ __forceinline__ bool next(int i, Unit& u) const {
        const long L = (long)i * G + c; if (L >= (long)nM * nN) return false;
        int pm, pn; tile_of((int)L, nM, nN, pm, pn);
        u.pm = pm; u.pn = pn; u.nt = nt; u.mode = 0; u.A = A + ((long)pm * 254 - 2) * (long)lda; u.B = B + (size_t)pn * 256 * ldb; return true;
    }
};

__device__ __forceinline__ void stagger_wait(unsigned ticks) {
    if (ticks) { const unsigned long long t0 = __builtin_amdgcn_s_memrealtime(); while (__builtin_amdgcn_s_memrealtime() - t0 < ticks) __builtin_amdgcn_s_sleep(8); }
}
template <class Epi, class Sched>
__device__ __forceinline__ void gemm_phase(LAS unsigned char* lds, const size_t lda, const size_t ldb, const Sched& S, const Epi& E, const unsigned stagger = 0u) {
    stagger_wait(stagger);
    int tid_ = threadIdx.x; asm volatile("" : "+v"(tid_));
    const int tid = tid_, wid = __builtin_amdgcn_readfirstlane(tid >> 6), lane = tid & 63, wr = wid >> 2, wc = wid & 3, fr = lane & 15, fq = lane >> 4;
    unsigned voffA[2], voffB[2];
#pragma unroll
    for (int i = 0; i < 2; ++i) { int R, C; stage_rc(tid * 16 + i * 8192, R, C); const int Rb = Epi::PERM ? ((R & ~31) + perm32(R & 31)) : R;
        voffA[i] = (unsigned)(R * lda + C * 2); voffB[i] = (unsigned)(Rb * ldb + C * 2); }
    const size_t kstep = (size_t)(BK * 2);
    const size_t hstepA = (size_t)HALF * lda, hstepB = (size_t)HALF * ldb;
    const unsigned ldsw = (unsigned)wid * 1024u;
    const int aoff = lds_byte(wr * 64 + fr, fq * 8), boff = lds_byte(wc * 32 + fr, fq * 8);
#define PG8_SA(b, h) (((b) * 2 + (h)) * HTB)
#define PG8_SB(b, h) ((4 + (b) * 2 + (h)) * HTB)
#define PG8_STAGE(bufoff, gbase, voff) do { _Pragma("unroll") for (int _i = 0; _i < 2; ++_i) \
        __builtin_amdgcn_global_load_lds((const unsigned*)((const char*)(gbase) + (voff)[_i]), (LAS unsigned*)(lds + (bufoff) + ldsw + _i * 8192), 16, 0, 0); } while (0)
#define PG8_LDA(dst, b, h) do { _Pragma("unroll") for (int m = 0; m < 4; ++m) _Pragma("unroll") for (int k = 0; k < 2; ++k) dst[m][k] = *(const LAS bf16x8*)(lds + PG8_SA(b, h) + aoff + m * 2048 + k * 1024); } while (0)
#define PG8_LDB(dst, b, h) do { _Pragma("unroll") for (int n = 0; n < 2; ++n) _Pragma("unroll") for (int k = 0; k < 2; ++k) dst[n][k] = *(const LAS bf16x8*)(lds + PG8_SB(b, h) + boff + n * 2048 + k * 1024); } while (0)
#define PG8_MMA(ai, bj, At, Bt) do { __builtin_amdgcn_s_setprio(1); _Pragma("unroll") for (int m = 0; m < 4; ++m) _Pragma("unroll") for (int n = 0; n < 2; ++n) _Pragma("unroll") for (int k = 0; k < 2; ++k) \
        acc[ai][bj][m][n] = __builtin_amdgcn_mfma_f32_16x16x32_bf16(Bt[n][k], At[m][k], acc[ai][bj][m][n], 0, 0, 0); __builtin_amdgcn_s_setprio(0); } while (0)
#define PG8_WAIT_V(n) asm volatile("s_waitcnt vmcnt(" #n ")" ::: "memory")
#define PG8_WAIT_L(n) asm volatile("s_waitcnt lgkmcnt(" #n ")" ::: "memory")
#define PG8_BAR __builtin_amdgcn_s_barrier()
#define PG8_SCHED __builtin_amdgcn_sched_barrier(0)
    Unit cur, nxt; int ui = 0;
    if (!S.next(0, cur)) return;
    f32x4 acc[2][2][4][2];
#pragma unroll
    for (int a = 0; a < 2; ++a)
#pragma unroll
        for (int b = 0; b < 2; ++b)
#pragma unroll
            for (int m = 0; m < 4; ++m)
#pragma unroll
                for (int n = 0; n < 2; ++n) acc[a][b][m][n] = (f32x4){0.f, 0.f, 0.f, 0.f};
    bf16x8 At[4][2], B0[2][2], B1[2][2];
    const char* cA = cur.A; const char* cB = cur.B;
#if PG8_SP2
    PG8_STAGE(PG8_SB(0, 0), cB, voffB); PG8_STAGE(PG8_SB(0, 1), cB + hstepB, voffB); PG8_STAGE(PG8_SA(0, 0), cA, voffA); PG8_STAGE(PG8_SA(0, 1), cA + hstepA, voffA);
    if (wr == 1) PG8_BAR;
    PG8_WAIT_V(2); PG8_BAR;
    PG8_STAGE(PG8_SB(1, 0), cB + kstep, voffB); PG8_STAGE(PG8_SA(1, 0), cA + kstep, voffA); PG8_STAGE(PG8_SB(1, 1), cB + hstepB + kstep, voffB);
    PG8_WAIT_V(6); PG8_BAR;
#else
    PG8_STAGE(PG8_SB(0, 0), cB, voffB); PG8_STAGE(PG8_SA(0, 0), cA, voffA); PG8_STAGE(PG8_SB(0, 1), cB + hstepB, voffB); PG8_STAGE(PG8_SA(0, 1), cA + hstepA, voffA);
    if (wr == 1) PG8_BAR;
    PG8_WAIT_V(4); PG8_BAR;
    PG8_STAGE(PG8_SB(1, 0), cB + kstep, voffB); PG8_STAGE(PG8_SA(1, 0), cA + kstep, voffA); PG8_STAGE(PG8_SB(1, 1), cB + hstepB + kstep, voffB);
    PG8_WAIT_V(6); PG8_BAR;
#endif
    for (;;) {
        const bool has_next = S.next(ui + 1, nxt);
        const char* nA = has_next ? nxt.A : cA; const char* nB = has_next ? nxt.B : cB;
        const int nt = cur.nt;
        for (int t = 0; t < nt; t += 2) {
            const bool last = (t == nt - 2);
            const char* a1 = cA + (size_t)(t + 1) * kstep;
            const char* a2 = last ? nA : cA + (size_t)(t + 2) * kstep; const char* b2 = last ? nB : cB + (size_t)(t + 2) * kstep;
            const char* a3 = a2 + kstep; const char* b3 = b2 + kstep;
#if PG8_SP2
            PG8_LDB(B0, 0, 0); PG8_LDB(B1, 0, 1); PG8_SCHED; PG8_LDA(At, 0, 0); PG8_STAGE(PG8_SA(1, 1), a1 + hstepA, voffA);
            PG8_WAIT_V(8); PG8_WAIT_L(0); PG8_BAR; PG8_MMA(0, 0, At, B0); PG8_MMA(0, 1, At, B1); PG8_BAR; PG8_SCHED;
            PG8_LDA(At, 0, 1); PG8_STAGE(PG8_SB(0, 0), b2, voffB); PG8_STAGE(PG8_SB(0, 1), b2 + hstepB, voffB); PG8_STAGE(PG8_SA(0, 0), a2, voffA);
            PG8_WAIT_V(8); PG8_WAIT_L(0); PG8_BAR; PG8_MMA(1, 0, At, B0); PG8_MMA(1, 1, At, B1); PG8_BAR; PG8_SCHED;
            PG8_LDB(B0, 1, 0); PG8_LDB(B1, 1, 1); PG8_SCHED; PG8_LDA(At, 1, 0); PG8_STAGE(PG8_SA(0, 1), a2 + hstepA, voffA);
            PG8_WAIT_V(8); PG8_WAIT_L(0); PG8_BAR; PG8_MMA(0, 0, At, B0); PG8_MMA(0, 1, At, B1); PG8_BAR; PG8_SCHED;
            PG8_LDA(At, 1, 1); PG8_STAGE(PG8_SB(1, 0), b3, voffB); PG8_STAGE(PG8_SB(1, 1), b3 + hstepB, voffB); PG8_STAGE(PG8_SA(1, 0), a3, voffA);
            PG8_WAIT_V(8); PG8_WAIT_L(0); PG8_BAR; PG8_MMA(1, 0, At, B0); PG8_MMA(1, 1, At, B1); PG8_BAR; PG8_SCHED;
#else
            PG8_LDB(B0, 0, 0); PG8_SCHED; PG8_LDA(At, 0, 0); PG8_STAGE(PG8_SA(1, 1), a1 + hstepA, voffA);
            PG8_WAIT_L(8); PG8_BAR; PG8_WAIT_L(0); PG8_MMA(0, 0, At, B0); PG8_BAR; PG8_SCHED;
            PG8_LDB(B1, 0, 1); PG8_STAGE(PG8_SB(0, 0), b2, voffB);
            PG8_BAR; PG8_WAIT_L(0); PG8_MMA(0, 1, At, B1); PG8_BAR;
            PG8_LDA(At, 0, 1); PG8_STAGE(PG8_SA(0, 0), a2, voffA);
            PG8_BAR; PG8_WAIT_L(0); PG8_MMA(1, 0, At, B0); PG8_BAR; PG8_SCHED;
            PG8_STAGE(PG8_SB(0, 1), b2 + hstepB, voffB);
            PG8_WAIT_V(6); PG8_BAR; PG8_MMA(1, 1, At, B1); PG8_BAR;
            PG8_LDB(B0, 1, 0); PG8_SCHED; PG8_LDA(At, 1, 0); PG8_STAGE(PG8_SA(0, 1), a2 + hstepA, voffA);
            PG8_WAIT_L(8); PG8_BAR; PG8_WAIT_L(0); PG8_MMA(0, 0, At, B0); PG8_BAR; PG8_SCHED;
            PG8_LDB(B1, 1, 1); PG8_STAGE(PG8_SB(1, 0), b3, voffB);
            PG8_BAR; PG8_WAIT_L(0); PG8_MMA(0, 1, At, B1); PG8_BAR;
            PG8_LDA(At, 1, 1); PG8_STAGE(PG8_SA(1, 0), a3, voffA);
            PG8_BAR; PG8_WAIT_L(0); PG8_MMA(1, 0, At, B0); PG8_BAR; PG8_SCHED;
            PG8_STAGE(PG8_SB(1, 1), b3 + hstepB, voffB);
            PG8_WAIT_V(6); PG8_BAR; PG8_MMA(1, 1, At, B1); PG8_BAR;
#endif
        }
        if (wr == 0) PG8_BAR;
        E(acc, cur, wr, wc, fr, fq);
        if (!has_next) break;
#pragma unroll
        for (int a = 0; a < 2; ++a)
#pragma unroll
            for (int b = 0; b < 2; ++b)
#pragma unroll
                for (int m = 0; m < 4; ++m)
#pragma unroll
                    for (int n = 0; n < 2; ++n) acc[a][b][m][n] = (f32x4){0.f, 0.f, 0.f, 0.f};
        cur = nxt; cA = nA; cB = nB; ++ui;
        if (wr == 1) PG8_BAR;
    }
    PG8_WAIT_V(0);
    PG8_BAR;
#undef PG8_SA
#undef PG8_SB
#undef PG8_STAGE
#undef PG8_LDA
#undef PG8_LDB
#undef PG8_MMA
#undef PG8_WAIT_V
#undef PG8_WAIT_L
#undef PG8_BAR
#undef PG8_SCHED
}
}

struct EpiZ {
    static constexpr bool PERM = true;
    bf16_t* Z; float* out; int layer;
    template <int ACT>
    __device__ __forceinline__ void plain(const f32x4 (&acc)[2][2][4][2], const pg8::Unit& u, int wr, int wc, int fr, int fq) const {
#pragma unroll
        for (int ai = 0; ai < 2; ++ai)
#pragma unroll
            for (int m = 0; m < 4; ++m) {
                const int row = u.pm * 256 + ai * 128 + wr * 64 + m * 16 + fr;
#pragma unroll
                for (int bj = 0; bj < 2; ++bj) {
                    const int col0 = u.pn * 256 + bj * 128 + wc * 32 + 8 * fq;
                    f32x4 v0 = acc[ai][bj][m][0], v1 = acc[ai][bj][m][1];
                    if (ACT == 2) {
#pragma unroll
                        for (int j = 0; j < 4; ++j) { v0[j] = sigmoidf_(v0[j]); v1[j] = sigmoidf_(v1[j]); }
                    } else if (ACT == 1) {
#pragma unroll
                        for (int j = 0; j < 4; ++j) { v0[j] = gelu_tanh(v0[j]); v1[j] = gelu_tanh(v1[j]); }
                    }
                    u32x4 w; w.x = pk2(v0[0], v0[1]); w.y = pk2(v0[2], v0[3]); w.z = pk2(v1[0], v1[1]); w.w = pk2(v1[2], v1[3]);
                    *(u32x4*)(Z + (size_t)row * NIN + col0) = w;
                }
            }
    }
    __device__ __forceinline__ void operator()(const f32x4 (&acc)[2][2][4][2], const pg8::Unit& u, int wr, int wc, int fr, int fq) const {
        const int pn = u.pn;
        if (pn >= 11) { plain<2>(acc, u, wr, wc, fr, fq); return; }
        if (pn >= 7) { plain<1>(acc, u, wr, wc, fr, fq); return; }
        plain<0>(acc, u, wr, wc, fr, fq);
        if (pn < 4) return;
#pragma unroll
        for (int ai = 0; ai < 2; ++ai)
#pragma unroll
            for (int m = 0; m < 4; ++m) {
                const int row = u.pm * 256 + ai * 128 + wr * 64 + m * 16 + fr;
                int b, t; const bool samp = row >= MP;
                if (!samp) { b = row >> 13; t = row & 8191; } else { b = (row - MP) >> 5; t = (row - MP) & 31; }
#pragma unroll
                for (int bj = 0; bj < 2; ++bj) {
                    const int col0 = pn * 256 + bj * 128 + wc * 32 + 8 * fq;
                    float* dst = nullptr;
                    if (pn == 4) {
                        const int cc = col0 - ZC_K;
                        if (!samp) { if (t >= SEQ - 128) dst = out + (cc < 128 ? O_KP : O_VP) + ((size_t)((layer * 4 + b) * 128 + (t - (SEQ - 128))) * 128 + (cc & 127)); }
                        else dst = out + (cc < 128 ? O_KS : O_VS) + ((size_t)((layer * 8 + b) * 128 + 96 + t) * 128 + (cc & 127));
                    } else {
                        const int cc = col0 - ZC_PU;
                        if (!samp) { if (t >= SEQ - 15) dst = out + O_PP + ((size_t)((layer * 4 + b) * 15 + (t - (SEQ - 15))) * 512 + cc); }
                        else { if (t >= ST - 15) dst = out + O_PS + ((size_t)((layer * 8 + b) * 15 + (t - (ST - 15))) * 512 + cc); }
                    }
                    if (dst) { *(f32x4*)dst = acc[ai][bj][m][0]; *(f32x4*)(dst + 4) = acc[ai][bj][m][1]; }
                }
            }
    }
};
struct EpiMerge {
    static constexpr bool PERM = true;
    const bf16_t* Z; bf16_t* MG; bf16_t* PS;
        __device__ __forceinline__ void operator()(const f32x4 (&acc)[2][2][4][2], const pg8::Unit& u, int wr, int wc, int fr, int fq) const {
        const bool smp = u.mode >= 4; const int mode = smp ? u.mode - 4 : u.mode;
        const bool rmw = mode != 0 && !smp;
        const int colb = u.pn * 256 + wc * 32 + 8 * fq;
        const bf16_t* gbase = Z + ZC_G + mode * 1024 + colb;
#pragma unroll
        for (int ai = 0; ai < 2; ++ai)
#pragma unroll
            for (int mp = 0; mp < 2; ++mp) {
                u32x4 gt[2][2], ov[2][2];
#pragma unroll
                for (int mm = 0; mm < 2; ++mm) {
                    const int row = u.pm * 256 + ai * 128 + wr * 64 + (2 * mp + mm) * 16 + fr;
#pragma unroll
                    for (int bj = 0; bj < 2; ++bj) gt[mm][bj] = *(const u32x4*)(gbase + (size_t)row * NIN + bj * 128);
                }
                if (rmw) {
#pragma unroll
                    for (int mm = 0; mm < 2; ++mm) {
                        const int row = u.pm * 256 + ai * 128 + wr * 64 + (2 * mp + mm) * 16 + fr;
#pragma unroll
                        for (int bj = 0; bj < 2; ++bj) ov[mm][bj] = *(const u32x4*)(MG + (size_t)row * D + colb + bj * 128);
                    }
                }
#pragma unroll
                for (int mm = 0; mm < 2; ++mm) {
                    const int m = 2 * mp + mm;
                    const int row = u.pm * 256 + ai * 128 + wr * 64 + m * 16 + fr;
#pragma unroll
                    for (int bj = 0; bj < 2; ++bj) {
                        const u32x4 g = gt[mm][bj];
                        f32x4 v0 = acc[ai][bj][m][0], v1 = acc[ai][bj][m][1];
                        v0[0] *= bflo(g.x); v0[1] *= bfhi(g.x); v0[2] *= bflo(g.y); v0[3] *= bfhi(g.y);
                        v1[0] *= bflo(g.z); v1[1] *= bfhi(g.z); v1[2] *= bflo(g.w); v1[3] *= bfhi(g.w);
                        if (rmw) { const u32x4 o = ov[mm][bj];
                            v0[0] += bflo(o.x); v0[1] += bfhi(o.x); v0[2] += bflo(o.y); v0[3] += bfhi(o.y);
                            v1[0] += bflo(o.z); v1[1] += bfhi(o.z); v1[2] += bflo(o.w); v1[3] += bfhi(o.w); }
                        bf16_t* mp_ = smp ? PS + ((size_t)mode * MS + (row - MP)) * D + colb + bj * 128 : MG + (size_t)row * D + colb + bj * 128;
                        u32x4 w; w.x = pk2(v0[0], v0[1]); w.y = pk2(v0[2], v0[3]); w.z = pk2(v1[0], v1[1]); w.w = pk2(v1[2], v1[3]);
                        *(u32x4*)mp_ = w;
                    }
                }
            }
    }
};
struct EpiRes {
    static constexpr bool PERM = false;
    const float* srcp; const float* srcs; float* X; const float* gmod;
        __device__ __forceinline__ void operator()(const f32x4 (&acc)[2][2][4][2], const pg8::Unit& u, int wr, int wc, int fr, int fq) const {
        const int colb = u.pn * 256 + wc * 32 + 4 * fq;
        if (u.mode == 0) {
            const float* gp = gmod + (size_t)(u.pm >> 5) * 6144 + colb;
            f32x4 g[2][2];
#pragma unroll
            for (int bj = 0; bj < 2; ++bj)
#pragma unroll
                for (int n = 0; n < 2; ++n) g[bj][n] = *(const f32x4*)(gp + bj * 128 + 16 * n);
#pragma unroll
            for (int ai = 0; ai < 2; ++ai)
#pragma unroll
                for (int mp = 0; mp < 2; ++mp) {
                    f32x4 sv[2][2][2];
#pragma unroll
                    for (int mm = 0; mm < 2; ++mm) {
                        const int row = u.pm * 256 + ai * 128 + wr * 64 + (2 * mp + mm) * 16 + fr;
                        const float* sp = srcp + (size_t)row * D + colb;
#pragma unroll
                        for (int bj = 0; bj < 2; ++bj)
#pragma unroll
                            for (int n = 0; n < 2; ++n) sv[mm][bj][n] = *(const f32x4*)(sp + bj * 128 + 16 * n);
                    }
#pragma unroll
                    for (int mm = 0; mm < 2; ++mm) {
                        const int m = 2 * mp + mm;
                        const int row = u.pm * 256 + ai * 128 + wr * 64 + m * 16 + fr;
                        float* xp = X + (size_t)row * D + colb;
#pragma unroll
                        for (int bj = 0; bj < 2; ++bj)
#pragma unroll
                            for (int n = 0; n < 2; ++n) *(f32x4*)(xp + bj * 128 + 16 * n) = sv[mm][bj][n] + g[bj][n] * acc[ai][bj][m][n];
                    }
                }
        } else {
#pragma unroll
            for (int ai = 0; ai < 2; ++ai)
#pragma unroll
                for (int m = 0; m < 4; ++m) {
                    const int row = u.pm * 256 + ai * 128 + wr * 64 + m * 16 + fr;
                    const float* gp = gmod + (size_t)batch_of_row(row) * 6144 + colb;
                    float* xp = X + (size_t)row * D + colb;
                    f32x4 g[2][2];
#pragma unroll
                    for (int bj = 0; bj < 2; ++bj)
#pragma unroll
                        for (int n = 0; n < 2; ++n) g[bj][n] = *(const f32x4*)(gp + bj * 128 + 16 * n);
#pragma unroll
                    for (int bj = 0; bj < 2; ++bj)
#pragma unroll
                        for (int n = 0; n < 2; ++n) { const f32x4 v = g[bj][n] * acc[ai][bj][m][n]; float* q = xp + bj * 128 + 16 * n;
                            unsafeAtomicAdd(q + 0, v[0]); unsafeAtomicAdd(q + 1, v[1]); unsafeAtomicAdd(q + 2, v[2]); unsafeAtomicAdd(q + 3, v[3]); }
                }
        }
    }
};
constexpr int XCH_OFF = 131072;
struct EpiUpConv {
    static constexpr bool PERM = true;
    bf16_t* Gb; float* out; const float* cw; const float* cb; const float* pref; int layer; LAS unsigned char* lds;
    __device__ __forceinline__ void operator()(const f32x4 (&acc)[2][2][4][2], const pg8::Unit& u, int wr, int wc, int fr, int fq) const {
        const int lane = fq * 16 + fr;
        LAS float* xch = (LAS float*)(lds + XCH_OFF);
        const int cl = wc * 32 + 8 * fq;
#pragma unroll
        for (int ai = 0; ai < 2; ++ai) {
            const int bnd = 2 * ai + wr;
            if (bnd < 3 && fr >= 14) {
                *(LAS f32x4*)(xch + (bnd * 2 + (fr - 14)) * 128 + cl) = acc[ai][0][3][0];
                *(LAS f32x4*)(xch + (bnd * 2 + (fr - 14)) * 128 + cl + 4) = acc[ai][0][3][1];
            }
        }
        asm volatile("s_waitcnt lgkmcnt(0)" ::: "memory"); __builtin_amdgcn_s_barrier(); asm volatile("" ::: "memory");
        const int rbase = u.pm * 254 - 2;
        const int rm = rbase & 8191;
        const bool plain = rbase >= 0 && rbase + 256 <= MP && rm >= 2 && rm <= 7934;
        if (plain) {
            const int f0 = u.pn * 128 + cl;
            f32x4 w0[2], w1[2], w2[2], bb[2];
#pragma unroll
            for (int n = 0; n < 2; ++n) { w0[n] = *(const f32x4*)(cw + f0 + 4 * n); w1[n] = *(const f32x4*)(cw + DFF + f0 + 4 * n); w2[n] = *(const f32x4*)(cw + 2 * DFF + f0 + 4 * n); bb[n] = *(const f32x4*)(cb + f0 + 4 * n); }
#pragma unroll
            for (int ai = 0; ai < 2; ++ai) {
                const int bp = 2 * ai + wr - 1 < 0 ? 0 : 2 * ai + wr - 1;
#pragma unroll
                for (int m = 0; m < 4; ++m) {
                    float gv[8];
#pragma unroll
                    for (int n = 0; n < 2; ++n) {
                        f32x4 x1 = (f32x4){0.f, 0.f, 0.f, 0.f}, x2 = x1;
                        if (m == 0) { x1 = *(const LAS f32x4*)(xch + (bp * 2 + 1) * 128 + cl + 4 * n); x2 = *(const LAS f32x4*)(xch + (bp * 2 + (fr & 1)) * 128 + cl + 4 * n); }
#pragma unroll
                        for (int j = 0; j < 4; ++j) {
                            const float cur = acc[ai][0][m][n][j];
                            const int curi = __float_as_int(cur);
                            int q1i, q2i;
                            if (m > 0) {
                                const float prvf = acc[ai][0][m > 0 ? m - 1 : 0][n][j]; const int prv = __float_as_int(prvf);
                                q1i = __builtin_amdgcn_update_dpp(0, prv, 0x121, 0xf, 0xf, false);
                                q2i = __builtin_amdgcn_update_dpp(0, prv, 0x122, 0xf, 0xf, false);
                            } else { const float x1f = x1[j], x2f = x2[j]; q1i = __float_as_int(x1f); q2i = __float_as_int(x2f); }
                            const float up1 = __int_as_float(__builtin_amdgcn_update_dpp(q1i, curi, 0x111, 0xf, 0xf, false));
                            const float up2 = __int_as_float(__builtin_amdgcn_update_dpp(q2i, curi, 0x112, 0xf, 0xf, false));
                            const float cv = up2 * w0[n][j] + up1 * w1[n][j] + cur * w2[n][j] + bb[n][j];
                            gv[4 * n + j] = gelu_tanh(cv) * acc[ai][1][m][n][j];
                        }
                    }
                    if (!(ai == 0 && m == 0 && wr == 0 && fr < 2)) {
                        const int row = rbase + ai * 128 + wr * 64 + m * 16 + fr;
                        u32x4 w; w.x = pk2(gv[0], gv[1]); w.y = pk2(gv[2], gv[3]); w.z = pk2(gv[4], gv[5]); w.w = pk2(gv[6], gv[7]);
                        *(u32x4*)(Gb + (size_t)row * DFF + f0) = w;
                    }
                }
            }
            return;
        }
#pragma unroll
        for (int n = 0; n < 2; ++n) {
            const int f0 = u.pn * 128 + cl + 4 * n;
            const f32x4 w0 = *(const f32x4*)(cw + f0), w1 = *(const f32x4*)(cw + DFF + f0), w2 = *(const f32x4*)(cw + 2 * DFF + f0), bb = *(const f32x4*)(cb + f0);
#pragma unroll
            for (int ai = 0; ai < 2; ++ai) {
                const int bp = 2 * ai + wr - 1 < 0 ? 0 : 2 * ai + wr - 1;
                const f32x4 x1 = *(const LAS f32x4*)(xch + (bp * 2 + 1) * 128 + cl + 4 * n), x2 = *(const LAS f32x4*)(xch + (bp * 2 + (fr & 1)) * 128 + cl + 4 * n);
#pragma unroll
                for (int m = 0; m < 4; ++m) {
                    const int tl = ai * 128 + wr * 64 + m * 16 + fr, row = rbase + tl;
                    int t, sb = 0; const bool samp = row >= MP;
                    if (!samp) t = row & 8191; else { t = (row - MP) & 31; sb = (row - MP) >> 5; }
                    const bool valid = tl >= 2 && row < M;
                    f32x4 p1 = (f32x4){0.f, 0.f, 0.f, 0.f}, p0 = p1;
                    if (samp && t < 2 && row < M) { const float* pp = pref + (size_t)sb * 2 * DFF + f0; p0 = *(const f32x4*)pp; p1 = *(const f32x4*)(pp + DFF); }
                    float gv[4];
#pragma unroll
                    for (int j = 0; j < 4; ++j) {
                        const float cur = acc[ai][0][m][n][j];
                        const int curi = __float_as_int(cur);
                        int q1i, q2i;
                        if (m > 0) {
                            const float prvf = acc[ai][0][m > 0 ? m - 1 : 0][n][j]; const int prv = __float_as_int(prvf);
                            q1i = __builtin_amdgcn_update_dpp(0, prv, 0x121, 0xf, 0xf, false);
                            q2i = __builtin_amdgcn_update_dpp(0, prv, 0x122, 0xf, 0xf, false);
                        } else { const float x1f = x1[j], x2f = x2[j]; q1i = __float_as_int(x1f); q2i = __float_as_int(x2f); }
                        float up1 = __int_as_float(__builtin_amdgcn_update_dpp(q1i, curi, 0x111, 0xf, 0xf, false));
                        float up2 = __int_as_float(__builtin_amdgcn_update_dpp(q2i, curi, 0x112, 0xf, 0xf, false));
                        if (t < 2) { if (t == 0) { up1 = p1[j]; up2 = p0[j]; } else { up2 = p1[j]; } }
                        const float cv = up2 * w0[j] + up1 * w1[j] + cur * w2[j] + bb[j];
                        gv[j] = gelu_tanh(cv) * acc[ai][1][m][n][j];
                    }
                    if (valid) {
                        int b, tt; if (!samp) { b = row >> 13; tt = t - (SEQ - 2); } else { b = sb; tt = t - (ST - 2); }
                        if (tt >= 0) *(f32x4*)(out + (samp ? O_CS : O_CP) + ((size_t)((layer * (samp ? 8 : 4) + b) * 2 + tt) * DFF + f0)) = acc[ai][0][m][n];
                        u32x2 w; w.x = pk2(gv[0], gv[1]); w.y = pk2(gv[2], gv[3]);
                        *(u32x2*)(Gb + (size_t)row * DFF + f0) = w;
                    }
                }
            }
        }
    }
};

template <bool UPMAP = false>
__device__ __forceinline__ void p0_transpose_item(const float* W, int N, bf16_t* WT, size_t ldt, int col_off, LAS float* scr, int item, int lane) {
    const int nblk = N / 32, kb = item / nblk, nb = item % nblk, k0 = 64 * kb, n0 = 32 * nb;
    const int r0 = UPMAP ? (n0 < DFF ? 256 * (n0 >> 7) + (n0 & 127) : 256 * ((n0 - DFF) >> 7) + 128 + ((n0 - DFF) & 127)) : n0;
    float tv[32];
#pragma unroll
    for (int i = 0; i < 32; ++i) tv[i] = W[(size_t)(k0 + 2 * i + (lane >> 5)) * N + n0 + (lane & 31)];
#pragma unroll
    for (int i = 0; i < 32; ++i) scr[(2 * i + (lane >> 5)) * 33 + (lane & 31)] = tv[i];
    asm volatile("s_waitcnt lgkmcnt(0)" ::: "memory");
    const int c = lane & 7;
#pragma unroll
    for (int j = 0; j < 4; ++j) { const int n = (lane >> 3) + 8 * j; const LAS float* s = scr + (8 * c) * 33 + n;
        u32x4 o; o.x = pk2(s[0 * 33], s[1 * 33]); o.y = pk2(s[2 * 33], s[3 * 33]); o.z = pk2(s[4 * 33], s[5 * 33]); o.w = pk2(s[6 * 33], s[7 * 33]);
        *(u32x4*)(WT + (size_t)(r0 + n) * ldt + col_off + k0 + 8 * c) = o; }
    asm volatile("s_waitcnt lgkmcnt(0)" ::: "memory");
}

constexpr int P0_I_IN = 16 * (NIN / 32), P0_I_OA = 16 * 32, P0_I_OP = 8 * 32, P0_I_OS = 8 * 32, P0_I_OUT = 16 * 32, P0_I_UP = 16 * (NUP / 32), P0_I_DN = (DFF / 64) * 32, P0_I_PW = 4 * 2 * 4;
constexpr int P0_I_L = P0_I_IN + P0_I_OA + P0_I_OP + P0_I_OS + P0_I_OUT + P0_I_UP + P0_I_DN + P0_I_PW;
__device__ __forceinline__ void p0_convert_layer(const Params& P, int l, LAS float* scr, int lane, int w0, int nw, int it_lo = 0, int it_hi = P0_I_L) {
    unsigned char* wl = P.ws + WS_W + (size_t)l * WL_SIZE;
    for (int it = it_lo + w0; it < it_hi; it += nw) {
        int r = it;
        if (r < P0_I_IN) { p0_transpose_item(P.w_in + (size_t)l * D * NIN, NIN, (bf16_t*)(wl + WL_IN), D, 0, scr, r, lane); continue; } r -= P0_I_IN;
        if (r < P0_I_OA) { p0_transpose_item(P.w_o_attn + (size_t)l * D * D, D, (bf16_t*)(wl + WL_CAT), 2048, 0, scr, r, lane); continue; } r -= P0_I_OA;
        if (r < P0_I_OP) { p0_transpose_item(P.w_o_pool + (size_t)l * 512 * D, D, (bf16_t*)(wl + WL_CAT), 2048, 1024, scr, r, lane); continue; } r -= P0_I_OP;
        if (r < P0_I_OS) { p0_transpose_item(P.w_o_sgu + (size_t)l * 512 * D, D, (bf16_t*)(wl + WL_CAT), 2048, 1536, scr, r, lane); continue; } r -= P0_I_OS;
        if (r < P0_I_OUT) { p0_transpose_item(P.w_out + (size_t)l * D * D, D, (bf16_t*)(wl + WL_OUT), D, 0, scr, r, lane); continue; } r -= P0_I_OUT;
        if (r < P0_I_UP) { p0_transpose_item<true>(P.ffn_w_up + (size_t)l * D * NUP, NUP, (bf16_t*)(wl + WL_UP), D, 0, scr, r, lane); continue; } r -= P0_I_UP;
        if (r < P0_I_DN) { p0_transpose_item(P.ffn_w_down + (size_t)l * DFF * D, D, (bf16_t*)(wl + WL_DN), DFF, 0, scr, r, lane); continue; } r -= P0_I_DN;
        { const int g = r >> 3, rr = r & 7;
          p0_transpose_item(P.pool_w + ((size_t)l * 4 + g) * 128 * 128, 128, (bf16_t*)(wl + WL_PW) + (size_t)g * 128 * 128, 128, 0, scr, rr, lane); }
    }
}
__device__ __forceinline__ void phase_p0(const Params& P, LAS unsigned char* lds) {
    const int tid = threadIdx.x, lane = tid & 63, wave = tid >> 6;
    const int G = gridDim.x, gw = blockIdx.x * NWAVES + wave, NGW = G * NWAVES;
    LAS float* scr = (LAS float*)(lds + wave * 8704);
    p0_convert_layer(P, 0, scr, lane, gw, NGW);
#if P0_BOTH_LAYERS
    p0_convert_layer(P, 1, scr, lane, gw, NGW);
#endif
    const int gt = blockIdx.x * NTHREADS + tid, NGT = G * NTHREADS;
    for (int e = gt; e < 2 * 4 * 128 * 128; e += NGT) {
        const int l = e >> 16, r = e & 65535, i = (r >> 7) & 127, j = r & 127;
        const float v = ((j >> 6) <= (i >> 6)) ? P.sgu_w[e] : 0.f;
        ((bf16_t*)(P.ws + WS_W + (size_t)l * WL_SIZE + WL_SG))[r] = (bf16_t)f2bf(v);
    }
    for (int e = gt; e < 2 * 8 * 96 * 128; e += NGT) {
        const int lb = e / (96 * 128), r = e - lb * (96 * 128);
        P.out[O_KS + (size_t)lb * 128 * 128 + r] = P.cache_k[(size_t)lb * 128 * 128 + 32 * 128 + r];
        P.out[O_VS + (size_t)lb * 128 * 128 + r] = P.cache_v[(size_t)lb * 128 * 128 + 32 * 128 + r];
    }
    __syncthreads();
    LAS float* part = (LAS float*)lds;
    for (int it = blockIdx.x; it < 2 * 96; it += G) {
        const int l = it / 96, e0 = (it % 96) * 64;
        float acc[12];
#pragma unroll
        for (int b = 0; b < 12; ++b) acc[b] = 0.f;
        const float* wp = P.w_ada + (size_t)l * D * 6144 + e0 + lane;
        for (int d0 = wave * 128; d0 < wave * 128 + 128; d0 += 8) {
            float wv[8];
#pragma unroll
            for (int q = 0; q < 8; ++q) wv[q] = wp[(size_t)(d0 + q) * 6144];
#pragma unroll
            for (int q = 0; q < 8; ++q) {
#pragma unroll
                for (int b = 0; b < 12; ++b) { const float cv = b < 4 ? P.c_prompt[b * D + d0 + q] : P.c_sample[(b - 4) * D + d0 + q]; acc[b] += cv * sigmoidf_(cv) * wv[q]; }
            }
        }
#pragma unroll
        for (int b = 0; b < 12; ++b) part[(wave * 12 + b) * 64 + lane] = acc[b];
        __syncthreads();
        for (int o = tid; o < 12 * 64; o += NTHREADS) {
            const int b = o >> 6, c = o & 63; float s = P.b_ada[(size_t)l * 6144 + e0 + c];
#pragma unroll
            for (int w = 0; w < 8; ++w) s += part[(w * 12 + b) * 64 + c];
            ((float*)(P.ws + WS_MOD))[((size_t)l * 12 + b) * 6144 + e0 + c] = s;
        }
        __syncthreads();
    }
}

__device__ __forceinline__ void phase_norm(const Params& P, LAS unsigned char* lds, const float* srcp, const float* srcs, const float* g, const float* mod_sh, const float* mod_sc, float* copy_s = nullptr) {
    const int tid = threadIdx.x, lane = tid & 63, wave = __builtin_amdgcn_readfirstlane(tid >> 6);
    const int gw = blockIdx.x * NWAVES + wave, NGW = gridDim.x * NWAVES;
    bf16_t* H = (bf16_t*)(P.ws + WS_H);
    LAS float* GM = (LAS float*)lds;
    LAS float* SH = (LAS float*)(lds + 49152);
    __syncthreads();
    for (int idx = tid * 4; idx < 12 * 1024; idx += NTHREADS * 4) {
        const int b = idx >> 10, c = idx & 1023;
        const f32x4 gg = *(const f32x4*)(g + c), sc = *(const f32x4*)(mod_sc + (size_t)b * 6144 + c), sh = *(const f32x4*)(mod_sh + (size_t)b * 6144 + c);
        *(LAS f32x4*)(GM + idx) = gg * (sc + 1.0f); *(LAS f32x4*)(SH + idx) = sh;
    }
    __syncthreads();
    for (int row0 = gw; row0 < M; row0 += 4 * NGW) {
        f32x4 v[4][4]; float ss[4];
#pragma unroll
        for (int r = 0; r < 4; ++r) {
            const int row = row0 + r * NGW; const int rc = row < M ? row : row0;
            const float* xr = rc < MP ? srcp + (size_t)rc * D : srcs + (size_t)(rc - MP) * D;
#pragma unroll
            for (int j = 0; j < 4; ++j) v[r][j] = *(const f32x4*)(xr + 4 * lane + 256 * j);
        }
#pragma unroll
        for (int r = 0; r < 4; ++r) {
            float s_ = 0.f;
#pragma unroll
            for (int j = 0; j < 4; ++j) s_ += (v[r][j][0] * v[r][j][0] + v[r][j][1] * v[r][j][1]) + (v[r][j][2] * v[r][j][2] + v[r][j][3] * v[r][j][3]);
            ss[r] = s_;
        }
#pragma unroll
        for (int o = 1; o < 64; o <<= 1) {
#pragma unroll
            for (int r = 0; r < 4; ++r) ss[r] += __shfl_xor(ss[r], o);
        }
#pragma unroll
        for (int r = 0; r < 4; ++r) {
            const int row = row0 + r * NGW;
            if (row < M) {
                const int b = batch_of_row(row);
                const float rstd = rsqrtf(ss[r] * (1.f / D) + 1e-6f);
                if (copy_s && row >= MP) {
#pragma unroll
                    for (int j = 0; j < 4; ++j) *(f32x4*)(copy_s + (size_t)(row - MP) * D + 4 * lane + 256 * j) = v[r][j];
                }
#pragma unroll
                for (int j = 0; j < 4; ++j) {
                    const int c = 4 * lane + 256 * j;
                    const f32x4 gm = *(const LAS f32x4*)(GM + b * 1024 + c), sh = *(const LAS f32x4*)(SH + b * 1024 + c);
                    const f32x4 h = v[r][j] * rstd * gm + sh;
                    u32x2 w; w.x = pk2(h[0], h[1]); w.y = pk2(h[2], h[3]);
                    *(u32x2*)(H + (size_t)row * D + c) = w;
                }
            }
        }
    }
}
__device__ __forceinline__ void phase_final(const Params& P) {
    const int lane = threadIdx.x & 63, wave = __builtin_amdgcn_readfirstlane(threadIdx.x >> 6);
    const int gw = blockIdx.x * NWAVES + wave, NGW = gridDim.x * NWAVES;
    f32x4 gg[4];
#pragma unroll
    for (int j = 0; j < 4; ++j) gg[j] = *(const f32x4*)(P.final_norm_g + 4 * lane + 256 * j);
    for (int row0 = gw; row0 < M; row0 += 4 * NGW) {
        f32x4 v[4][4]; float ss[4];
#pragma unroll
        for (int r = 0; r < 4; ++r) {
            const int row = row0 + r * NGW; const float* xr = P.out + (size_t)(row < M ? row : row0) * D;
#pragma unroll
            for (int j = 0; j < 4; ++j) v[r][j] = *(const f32x4*)(xr + 4 * lane + 256 * j);
        }
#pragma unroll
        for (int r = 0; r < 4; ++r) {
            float s_ = 0.f;
#pragma unroll
            for (int j = 0; j < 4; ++j) s_ += (v[r][j][0] * v[r][j][0] + v[r][j][1] * v[r][j][1]) + (v[r][j][2] * v[r][j][2] + v[r][j][3] * v[r][j][3]);
            ss[r] = s_;
        }
#pragma unroll
        for (int o = 1; o < 64; o <<= 1) {
#pragma unroll
            for (int r = 0; r < 4; ++r) ss[r] += __shfl_xor(ss[r], o);
        }
#pragma unroll
        for (int r = 0; r < 4; ++r) {
            const int row = row0 + r * NGW;
            if (row < M) {
                const float rstd = rsqrtf(ss[r] * (1.f / D) + 1e-6f);
                float* xr = P.out + (size_t)row * D;
#pragma unroll
                for (int j = 0; j < 4; ++j) *(f32x4*)(xr + 4 * lane + 256 * j) = v[r][j] * rstd * gg[j];
            }
        }
    }
}

__device__ __forceinline__ void lds_barrier() { asm volatile("s_waitcnt lgkmcnt(0)" ::: "memory"); __builtin_amdgcn_s_barrier(); asm volatile("" ::: "memory"); }

constexpr int KS_STRIDE = 144;
constexpr int VT_STRIDE = 400;
constexpr int ATT_KS = 0, ATT_VT = 192 * KS_STRIDE;

__device__ __forceinline__ void attn_item(const Params& P, int layer, int item, LAS unsigned char* lds, const bool dry = false) {
    const int tid = threadIdx.x, lane = tid & 63, wave = __builtin_amdgcn_readfirstlane(tid >> 6), fr = lane & 15, fq = lane >> 4;
    bf16_t* Z = (bf16_t*)(P.ws + WS_Z);
    const bool samp = item >= 1024;
    int kvh, c = 0, sb = 0, qrow0, klo, khi, nqt;
    if (!samp) { kvh = item & 1; c = (item >> 1) & 127; const int b = item >> 8; qrow0 = b * SEQ + 64 * c; klo = 128 - 64 * (c < 2 ? c : 2); khi = 192; nqt = 4; }
    else { const int s = item - 1024; kvh = s & 1; sb = s >> 1; qrow0 = MP + sb * ST; klo = 0; khi = 160; nqt = 2; }
    lds_barrier();
    const int h = kvh * 8 + wave;
    bf16x8 qc0, qc1;
    { const bf16_t* qp = Z + (size_t)(qrow0 + fr) * NIN + h * 64; qc0 = *(const bf16x8*)(qp + 8 * fq); qc1 = *(const bf16x8*)(qp + 32 + 8 * fq); }
    {
        const int ch = tid & 7, key0 = tid >> 3;
#pragma unroll
        for (int p = 0; p < 3; ++p) {
            const int j = key0 + 64 * p;
            u32x4 kk = (u32x4){0u, 0u, 0u, 0u}, vv = (u32x4){0u, 0u, 0u, 0u};
            if (j >= klo && j < khi) {
                if (samp && j < 128) {
                    const float* kp = P.cache_k + ((((size_t)layer * 8 + sb) * 128 + j) * 2 + kvh) * 64 + ch * 8;
                    const float* vp = P.cache_v + ((((size_t)layer * 8 + sb) * 128 + j) * 2 + kvh) * 64 + ch * 8;
                    const f32x4 k0 = *(const f32x4*)kp, k1 = *(const f32x4*)(kp + 4), v0 = *(const f32x4*)vp, v1 = *(const f32x4*)(vp + 4);
                    kk.x = pk2(k0[0], k0[1]); kk.y = pk2(k0[2], k0[3]); kk.z = pk2(k1[0], k1[1]); kk.w = pk2(k1[2], k1[3]);
                    vv.x = pk2(v0[0], v0[1]); vv.y = pk2(v0[2], v0[3]); vv.z = pk2(v1[0], v1[1]); vv.w = pk2(v1[2], v1[3]);
                } else {
                    const int row = samp ? (qrow0 + j - 128) : (qrow0 - 128 + j);
                    const bf16_t* zp = Z + (size_t)row * NIN + kvh * 64 + ch * 8;
                    kk = *(const u32x4*)(zp + ZC_K); vv = *(const u32x4*)(zp + ZC_V);
                }
            }
            *(LAS u32x4*)(lds + ATT_KS + j * KS_STRIDE + ch * 16) = kk;
            const int pj = (j & ~31) | ((j & 12) << 1) | ((j & 16) >> 2) | (j & 3);
            LAS bf16_t* vt = (LAS bf16_t*)(lds + ATT_VT + (ch * 8) * VT_STRIDE + pj * 2);
            vt[0 * (VT_STRIDE / 2)] = (bf16_t)(vv.x & 0xffff); vt[1 * (VT_STRIDE / 2)] = (bf16_t)(vv.x >> 16);
            vt[2 * (VT_STRIDE / 2)] = (bf16_t)(vv.y & 0xffff); vt[3 * (VT_STRIDE / 2)] = (bf16_t)(vv.y >> 16);
            vt[4 * (VT_STRIDE / 2)] = (bf16_t)(vv.z & 0xffff); vt[5 * (VT_STRIDE / 2)] = (bf16_t)(vv.z >> 16);
            vt[6 * (VT_STRIDE / 2)] = (bf16_t)(vv.w & 0xffff); vt[7 * (VT_STRIDE / 2)] = (bf16_t)(vv.w >> 16);
        }
    }
    lds_barrier();
    const float slope = exp2f(-0.5f * (float)(h + 1)) * 1.4426950408889634f;
    const float sink = P.attn_sink[layer * 16 + h] * 1.4426950408889634f;
    const bool need_mask = klo > 0 || khi < 192;
#pragma unroll 1
    for (int qt = 0; qt < nqt; ++qt) {
        const int qrow = qrow0 + 16 * qt + fr;
        bf16_t* qp = Z + (size_t)qrow * NIN + h * 64;
        const bf16x8 q0 = qc0, q1 = qc1;
        { const bf16_t* qn = Z + (size_t)(qrow0 + 16 * (qt + 1 < nqt ? qt + 1 : qt) + fr) * NIN + h * 64;
          qc0 = *(const bf16x8*)(qn + 8 * fq); qc1 = *(const bf16x8*)(qn + 32 + 8 * fq); }
        f32x4 st[12];
#pragma unroll
        for (int kt = 0; kt < 12; ++kt) {
            const LAS unsigned char* kp = lds + ATT_KS + (16 * kt + fr) * KS_STRIDE + 16 * fq;
            const bf16x8 a0 = *(const LAS bf16x8*)kp, a1 = *(const LAS bf16x8*)(kp + 64);
            f32x4 a = (f32x4){0.f, 0.f, 0.f, 0.f};
            a = __builtin_amdgcn_mfma_f32_16x16x32_bf16(a0, q0, a, 0, 0, 0);
            a = __builtin_amdgcn_mfma_f32_16x16x32_bf16(a1, q1, a, 0, 0, 0);
            st[kt] = a;
            if ((kt & 3) == 3) asm volatile("" ::: "memory");
        }
        const float d0 = (float)(128 + 16 * qt + fr - 4 * fq);
        float mx = -INFINITY;
#pragma unroll
        for (int kt = 0; kt < 12; ++kt)
#pragma unroll
            for (int jj = 0; jj < 4; ++jj) {
                const float t = slope * fabsf(d0 - (float)(16 * kt + jj));
                float lg = st[kt][jj] * (0.125f * 1.4426950408889634f) - t;
                if (need_mask) { const int key = 16 * kt + 4 * fq + jj; lg = (key >= klo && key < khi) ? lg : -INFINITY; }
                st[kt][jj] = lg; mx = fmaxf(mx, lg);
            }
        mx = fmaxf(mx, __shfl_xor(mx, 16)); mx = fmaxf(mx, __shfl_xor(mx, 32));
        mx = fmaxf(mx, sink);
        float sum = 0.f;
#pragma unroll
        for (int kt = 0; kt < 12; ++kt)
#pragma unroll
            for (int jj = 0; jj < 4; ++jj) { const float p = __builtin_amdgcn_exp2f(st[kt][jj] - mx); st[kt][jj] = p; sum += p; }
        sum += __shfl_xor(sum, 16); sum += __shfl_xor(sum, 32);
        const float inv = __builtin_amdgcn_rcpf(sum + __builtin_amdgcn_exp2f(sink - mx));
        bf16x8 pb[6];
#pragma unroll
        for (int s = 0; s < 6; ++s) {
            u32x4 w; w.x = pk2(st[2 * s][0], st[2 * s][1]); w.y = pk2(st[2 * s][2], st[2 * s][3]);
            w.z = pk2(st[2 * s + 1][0], st[2 * s + 1][1]); w.w = pk2(st[2 * s + 1][2], st[2 * s + 1][3]);
            pb[s] = __builtin_bit_cast(bf16x8, w);
        }
#pragma unroll 1
        for (int dp = 0; dp < 2; ++dp) {
            f32x4 o0 = (f32x4){0.f, 0.f, 0.f, 0.f}, o1 = o0;
            const int vrow = 32 * dp + 8 * (fr >> 2) + (fr & 3);
#pragma unroll
            for (int s = 0; s < 6; ++s) {
                const bf16x8 av0 = *(const LAS bf16x8*)(lds + ATT_VT + vrow * VT_STRIDE + (32 * s + 8 * fq) * 2);
                const bf16x8 av1 = *(const LAS bf16x8*)(lds + ATT_VT + (vrow + 4) * VT_STRIDE + (32 * s + 8 * fq) * 2);
                o0 = __builtin_amdgcn_mfma_f32_16x16x32_bf16(av0, pb[s], o0, 0, 0, 0);
                o1 = __builtin_amdgcn_mfma_f32_16x16x32_bf16(av1, pb[s], o1, 0, 0, 0);
            }
            u32x4 w; w.x = pk2(o0[0] * inv, o0[1] * inv); w.y = pk2(o0[2] * inv, o0[3] * inv); w.z = pk2(o1[0] * inv, o1[1] * inv); w.w = pk2(o1[2] * inv, o1[3] * inv);
            if (!dry) *(u32x4*)(qp + 32 * dp + 8 * fq) = w;
        }
    }
}

constexpr int MX_RS = 0, MX_VNT = 1024, MX_U = 36864, MX_DT = 76800, MX_NG = 112640, MX_ST = 272;
__device__ __forceinline__ void mix_item(const Params& P, int layer, int item, LAS unsigned char* lds, const bool dry = false) {
    const int tid = threadIdx.x, lane = tid & 63, wave = __builtin_amdgcn_readfirstlane(tid >> 6), fr = lane & 15, fq = lane >> 4;
    bf16_t* Z = (bf16_t*)(P.ws + WS_Z);
    const unsigned char* wl = P.ws + WS_W + (size_t)layer * WL_SIZE;
    const bool samp = item >= 256;
    int row0, L, t0, sb = 0;
    if (!samp) { const int b = item >> 6, ch = item & 63; row0 = b * SEQ + ch * 128; L = 128; t0 = ch * 128; }
    else { sb = item - 256; row0 = MP + sb * ST; L = ST; t0 = 0; }
    LAS float* RS = (LAS float*)(lds + MX_RS);
    LAS float* NG = (LAS float*)(lds + MX_NG);
    const bool act = wave * 16 < L;
    const int ti = wave * 16 + fr;
    lds_barrier();
    { const float n0_ = P.sgu_norm_g[layer * 512 + tid], n1_ = P.pool_scale[layer * 512 + tid], n2_ = P.sgu_b[layer * 512 + tid]; NG[tid] = n0_; NG[512 + tid] = n1_; NG[1024 + tid] = n2_; }
    {
        u32x4 rw[16];
#pragma unroll
        for (int k = 0; k < 16; ++k) { const int i = wave * 16 + k; rw[k] = *(const u32x4*)(Z + (size_t)(row0 + (i < L ? i : 0)) * NIN + ZC_SV + lane * 8); }
#pragma unroll
        for (int k = 0; k < 16; ++k) {
            const u32x4 w = rw[k];
            float s = bflo(w.x) * bflo(w.x) + bfhi(w.x) * bfhi(w.x) + bflo(w.y) * bflo(w.y) + bfhi(w.y) * bfhi(w.y)
                    + bflo(w.z) * bflo(w.z) + bfhi(w.z) * bfhi(w.z) + bflo(w.w) * bflo(w.w) + bfhi(w.w) * bfhi(w.w);
            s = wave_sum(s);
            if (lane == 0) RS[wave * 16 + k] = rsqrtf(s * (1.f / 512.f) + 1e-6f);
        }
    }
    u32x4 svr[4]; bf16x8 wf[4]; u32x2 uu[8];
    bf16_t* const zsu = Z + (size_t)(row0 + (act ? ti : 0)) * NIN + ZC_SU + 4 * fq;
    const bf16_t* const wsg = (const bf16_t*)(wl + WL_SG) + (size_t)(act ? ti : 0) * 128 + 8 * fq;
#define MIX_LOAD_SGU(gg) do { \
        _Pragma("unroll") for (int p = 0; p < 4; ++p) { const int idx = tid + NTHREADS * p, j = idx >> 4, c8 = idx & 15; \
            if (j < L) svr[p] = *(const u32x4*)(Z + (size_t)(row0 + j) * NIN + ZC_SV + (gg) * 128 + c8 * 8); } \
        _Pragma("unroll") for (int ks = 0; ks < 4; ++ks) wf[ks] = *(const bf16x8*)(wsg + (size_t)(gg) * 128 * 128 + 32 * ks); \
        _Pragma("unroll") for (int ct = 0; ct < 8; ++ct) uu[ct] = *(const u32x2*)(zsu + (gg) * 128 + 16 * ct); } while (0)
#pragma unroll
    for (int p = 0; p < 4; ++p) svr[p] = (u32x4){0u, 0u, 0u, 0u};
    MIX_LOAD_SGU(0);
    lds_barrier();
#pragma unroll 1
    for (int g = 0; g < 4; ++g) {
#pragma unroll
        for (int p = 0; p < 4; ++p) {
            const int idx = tid + NTHREADS * p, j = idx >> 4, c8 = idx & 15;
            float vn[8];
            if (j < L) {
                const u32x4 w = svr[p];
                const float rs = RS[j];
                const f32x4 n0 = *(const LAS f32x4*)(NG + g * 128 + c8 * 8), n1 = *(const LAS f32x4*)(NG + g * 128 + c8 * 8 + 4);
                vn[0] = bflo(w.x) * rs * n0[0]; vn[1] = bfhi(w.x) * rs * n0[1]; vn[2] = bflo(w.y) * rs * n0[2]; vn[3] = bfhi(w.y) * rs * n0[3];
                vn[4] = bflo(w.z) * rs * n1[0]; vn[5] = bfhi(w.z) * rs * n1[1]; vn[6] = bflo(w.w) * rs * n1[2]; vn[7] = bfhi(w.w) * rs * n1[3];
                if (samp) { float* dst = P.out + O_SV + ((size_t)((layer * 8 + sb) * ST + j)) * 512 + g * 128 + c8 * 8;
                    *(f32x4*)dst = (f32x4){vn[0], vn[1], vn[2], vn[3]}; *(f32x4*)(dst + 4) = (f32x4){vn[4], vn[5], vn[6], vn[7]}; }
            } else {
#pragma unroll
                for (int e = 0; e < 8; ++e) vn[e] = 0.f;
            }
            LAS bf16_t* vt = (LAS bf16_t*)(lds + MX_VNT + (c8 * 8) * MX_ST + (((j >> 3) ^ c8) << 4) + (j & 7) * 2);
#pragma unroll
            for (int e = 0; e < 8; ++e) vt[e * (MX_ST / 2)] = (bf16_t)f2bf(vn[e]);
        }
        bf16x8 wc_[4]; u32x2 uc[8];
#pragma unroll
        for (int ks = 0; ks < 4; ++ks) wc_[ks] = wf[ks];
#pragma unroll
        for (int ct = 0; ct < 8; ++ct) uc[ct] = uu[ct];
        if (g < 3) MIX_LOAD_SGU(g + 1);
        const float bias = NG[1024 + g * 128 + (act ? ti : 0)];
        lds_barrier();
        if (act) {
            bf16_t* zrow = zsu + g * 128;
#pragma unroll
            for (int ct = 0; ct < 8; ++ct) {
                f32x4 a = (f32x4){0.f, 0.f, 0.f, 0.f};
#pragma unroll
                for (int ks = 0; ks < 4; ++ks) {
                    const bf16x8 av = *(const LAS bf16x8*)(lds + MX_VNT + (16 * ct + fr) * MX_ST + (((4 * ks + fq) ^ (2 * ct + (fr >> 3))) << 4));
                    a = __builtin_amdgcn_mfma_f32_16x16x32_bf16(av, wc_[ks], a, 0, 0, 0);
                }
                u32x2 w; w.x = pk2(bflo(uc[ct].x) * (a[0] + bias), bfhi(uc[ct].x) * (a[1] + bias)); w.y = pk2(bflo(uc[ct].y) * (a[2] + bias), bfhi(uc[ct].y) * (a[3] + bias));
                if (!dry) *(u32x2*)(zrow + 16 * ct) = w;
            }
        }
        lds_barrier();
    }
#undef MIX_LOAD_SGU
    u32x4 ur[5], wq[4];
#define MIX_LOAD_U(gg) do { _Pragma("unroll") for (int p = 0; p < 5; ++p) { const int idx = tid + NTHREADS * p, hh = idx >> 4, c8 = idx & 15, rel = hh - 15; \
            ur[p] = (u32x4){0u, 0u, 0u, 0u}; \
            if (idx < (15 + L) * 16) { \
                if (rel >= 0 || (!samp && t0 > 0)) ur[p] = *(const u32x4*)(Z + (size_t)(row0 + rel) * NIN + ZC_PU + (gg) * 128 + c8 * 8); \
                else if (samp) { const float* sp = P.state_pool + ((size_t)(layer * 8 + sb) * 15 + hh) * 512 + (gg) * 128 + c8 * 8; \
                    const f32x4 a_ = *(const f32x4*)sp, b_ = *(const f32x4*)(sp + 4); \
                    ur[p].x = pk2(a_[0], a_[1]); ur[p].y = pk2(a_[2], a_[3]); ur[p].z = pk2(b_[0], b_[1]); ur[p].w = pk2(b_[2], b_[3]); } } } \
        _Pragma("unroll") for (int p = 0; p < 4; ++p) { const int idx = tid + NTHREADS * p; \
            wq[p] = *(const u32x4*)((const bf16_t*)(wl + WL_PW) + (size_t)(gg) * 128 * 128 + (size_t)(idx >> 4) * 128 + (idx & 15) * 8); } } while (0)
    MIX_LOAD_U(0);
#pragma unroll 1
    for (int g = 0; g < 4; ++g) {
        const int wlen = 2 << g;
#pragma unroll
        for (int p = 0; p < 5; ++p) { const int idx = tid + NTHREADS * p; if (idx < (15 + L) * 16) *(LAS u32x4*)(lds + MX_U + (idx >> 4) * MX_ST + (idx & 15) * 16) = ur[p]; }
#pragma unroll
        for (int p = 0; p < 4; ++p) { const int idx = tid + NTHREADS * p; *(LAS u32x4*)(lds + MX_VNT + (idx >> 4) * MX_ST + (idx & 15) * 16) = wq[p]; }
        if (g < 3) MIX_LOAD_U(g + 1);
        lds_barrier();
        for (int idx = tid; idx < L * 16; idx += NTHREADS) {
            const int i = idx >> 4, c8 = idx & 15;
            float sm[8];
#pragma unroll
            for (int e = 0; e < 8; ++e) sm[e] = 0.f;
            for (int k = 0; k < wlen; ++k) {
                const u32x4 w = *(const LAS u32x4*)(lds + MX_U + (15 + i - k) * MX_ST + c8 * 16);
                sm[0] += bflo(w.x); sm[1] += bfhi(w.x); sm[2] += bflo(w.y); sm[3] += bfhi(w.y); sm[4] += bflo(w.z); sm[5] += bfhi(w.z); sm[6] += bflo(w.w); sm[7] += bfhi(w.w);
            }
            const u32x4 w = *(const LAS u32x4*)(lds + MX_U + (15 + i) * MX_ST + c8 * 16);
            const int pos1 = samp ? (1024 + i + 1) : (t0 + i + 1);
            const float rc = 1.0f / (float)(pos1 < wlen ? pos1 : wlen);
            u32x4 o;
            o.x = pk2(sm[0] * rc - bflo(w.x), sm[1] * rc - bfhi(w.x)); o.y = pk2(sm[2] * rc - bflo(w.y), sm[3] * rc - bfhi(w.y));
            o.z = pk2(sm[4] * rc - bflo(w.z), sm[5] * rc - bfhi(w.z)); o.w = pk2(sm[6] * rc - bflo(w.w), sm[7] * rc - bfhi(w.w));
            *(LAS u32x4*)(lds + MX_DT + i * MX_ST + c8 * 16) = o;
        }
        lds_barrier();
        if (act) {
            const int i = wave * 16 + fr;
            bf16x8 df[4];
#pragma unroll
            for (int ks = 0; ks < 4; ++ks) df[ks] = *(const LAS bf16x8*)(lds + MX_DT + i * MX_ST + (32 * ks + 8 * fq) * 2);
            bf16_t* zrow = Z + (size_t)(row0 + i) * NIN + ZC_SV + g * 128 + 4 * fq;
#pragma unroll
            for (int nt = 0; nt < 8; ++nt) {
                f32x4 a = (f32x4){0.f, 0.f, 0.f, 0.f};
#pragma unroll
                for (int ks = 0; ks < 4; ++ks) {
                    const bf16x8 wv = *(const LAS bf16x8*)(lds + MX_VNT + (16 * nt + fr) * MX_ST + (32 * ks + 8 * fq) * 2);
                    a = __builtin_amdgcn_mfma_f32_16x16x32_bf16(wv, df[ks], a, 0, 0, 0);
                }
                const f32x4 sc = *(const LAS f32x4*)(NG + 512 + g * 128 + 16 * nt + 4 * fq);
                u32x2 w; w.x = pk2(a[0] * sc[0], a[1] * sc[1]); w.y = pk2(a[2] * sc[2], a[3] * sc[3]);
                if (!dry) *(u32x2*)(zrow + 16 * nt) = w;
            }
        }
        lds_barrier();
    }
#undef MIX_LOAD_U
}

__device__ __forceinline__ void phase_mixers(const Params& P, int layer, LAS unsigned char* lds) {
    for (int it = blockIdx.x; it < 1304; it += gridDim.x) {
        if (it < 256) mix_item(P, layer, it, lds);
        else if (it < 1280) attn_item(P, layer, it - 256, lds);
        else if (it < 1296) attn_item(P, layer, 1024 + (it - 1280), lds);
        else mix_item(P, layer, 256 + (it - 1296), lds);
    }
}

__device__ __forceinline__ void phase_conv(const Params& P, int layer) {
    bf16_t* AB = (bf16_t*)(P.ws + WS_Z);
    const int gt = blockIdx.x * NTHREADS + threadIdx.x, NGT = gridDim.x * NTHREADS;
    const float* cw = P.ffn_conv_w + (size_t)layer * 3 * DFF; const float* cb = P.ffn_conv_b + (size_t)layer * DFF;
    for (int idx = gt; idx < M * (DFF / 8); idx += NGT) {
        const int r = idx / (DFF / 8), f = (idx - r * (DFF / 8)) * 8;
        int t, sb = 0; const bool samp = r >= MP;
        if (!samp) t = r & 8191; else { t = (r - MP) & 31; sb = (r - MP) >> 5; }
        float a0[8], a1[8], a2[8];
        { const u32x4 w = *(const u32x4*)(AB + (size_t)r * NUP + f);
          a0[0] = bflo(w.x); a0[1] = bfhi(w.x); a0[2] = bflo(w.y); a0[3] = bfhi(w.y); a0[4] = bflo(w.z); a0[5] = bfhi(w.z); a0[6] = bflo(w.w); a0[7] = bfhi(w.w); }
        const float* pf = P.state_conv + ((size_t)(layer * 8 + sb) * 2) * DFF + f;
        if (t >= 1) { const u32x4 w = *(const u32x4*)(AB + (size_t)(r - 1) * NUP + f);
          a1[0] = bflo(w.x); a1[1] = bfhi(w.x); a1[2] = bflo(w.y); a1[3] = bfhi(w.y); a1[4] = bflo(w.z); a1[5] = bfhi(w.z); a1[6] = bflo(w.w); a1[7] = bfhi(w.w); }
        else {
#pragma unroll
            for (int e = 0; e < 8; ++e) a1[e] = samp ? pf[DFF + e] : 0.f; }
        if (t >= 2) { const u32x4 w = *(const u32x4*)(AB + (size_t)(r - 2) * NUP + f);
          a2[0] = bflo(w.x); a2[1] = bfhi(w.x); a2[2] = bflo(w.y); a2[3] = bfhi(w.y); a2[4] = bflo(w.z); a2[5] = bfhi(w.z); a2[6] = bflo(w.w); a2[7] = bfhi(w.w); }
        else {
#pragma unroll
            for (int e = 0; e < 8; ++e) a2[e] = samp ? pf[(t == 1 ? DFF : 0) + e] : 0.f; }
        const u32x4 bw = *(const u32x4*)(AB + (size_t)r * NUP + DFF + f);
        float bb[8] = {bflo(bw.x), bfhi(bw.x), bflo(bw.y), bfhi(bw.y), bflo(bw.z), bfhi(bw.z), bflo(bw.w), bfhi(bw.w)};
        float go[8];
#pragma unroll
        for (int e = 0; e < 8; ++e) {
            const float cv = a2[e] * cw[f + e] + a1[e] * cw[DFF + f + e] + a0[e] * cw[2 * DFF + f + e] + cb[f + e];
            go[e] = gelu_tanh(cv) * bb[e];
        }
        u32x4 o; o.x = pk2(go[0], go[1]); o.y = pk2(go[2], go[3]); o.z = pk2(go[4], go[5]); o.w = pk2(go[6], go[7]);
        *(u32x4*)(AB + (size_t)r * NUP + DFF + f) = o;
    }
}

constexpr int NPHASES = 20;
#define XB_TMO      128
#define XB_XCNT(j)  (256  + 64 * (j))
#define XB_XSUB(j)  (1280 + 64 * (j))
#define XB_XGEN(j)  (2304 + 64 * (j))
#define XB_TOP      3328
#define XB_TOPGEN   3392
#define XCD_BAR_WORDS 3456
#define XB_SPIN_CAP (1u << 18)

__device__ __forceinline__ unsigned xb_ld(unsigned* p)              { return __hip_atomic_load(p, __ATOMIC_RELAXED, __HIP_MEMORY_SCOPE_AGENT); }
__device__ __forceinline__ unsigned xb_add(unsigned* p, unsigned v) { return __hip_atomic_fetch_add(p, v, __ATOMIC_RELAXED, __HIP_MEMORY_SCOPE_AGENT); }
__device__ __forceinline__ unsigned xb_xcc_id() { return (unsigned)__builtin_amdgcn_s_getreg((3 << 11) | 20) & 0xFu; }
#define XB_SPIN(cond, bar) do { unsigned _sp = 0; while (cond) { __builtin_amdgcn_s_sleep(1); \
    if ((++_sp & 255u) == 0u) { if (xb_ld(&(bar)[XB_TMO])) break; if (_sp > XB_SPIN_CAP) { atomicAdd(&(bar)[XB_TMO], 1u); break; } } } } while (0)

struct XcdBarrier {
    unsigned* bar; unsigned x;
    volatile LAS unsigned* st;
};

__device__ __forceinline__ XcdBarrier xcd_barrier_post(unsigned* bar, volatile LAS unsigned* st) {
    XcdBarrier b; b.bar = bar; b.x = xb_xcc_id(); b.st = st;
    if (threadIdx.x == 0) (void)xb_add(&bar[XB_XCNT(b.x)], 1u);
    return b;
}
__device__ __forceinline__ void xcd_barrier_complete(unsigned* bar, unsigned x, unsigned& nloc, unsigned& nx) {
    const unsigned G = gridDim.x * gridDim.y * gridDim.z;
    unsigned sum, cnt, mine, sp = 0u;
    for (;;) {
        sum = 0u; cnt = 0u; mine = 0u;
#pragma unroll
        for (unsigned j = 0; j < 16; ++j) { const unsigned c = xb_ld(&bar[XB_XCNT(j)]); sum += c; cnt += (c > 0u) ? 1u : 0u; mine = (j == x) ? c : mine; }
        if (sum == G) break;
        __builtin_amdgcn_s_sleep(1);
        if ((++sp & 255u) == 0u) { if (xb_ld(&bar[XB_TMO])) break; if (sp > XB_SPIN_CAP) { atomicAdd(&bar[XB_TMO], 1u); break; } }
    }
    nloc = mine > 0u ? mine : 1u; nx = cnt > 0u ? cnt : 1u;
}

__device__ __forceinline__ void xcd_barrier(const XcdBarrier& b) {
    asm volatile("s_waitcnt vmcnt(0)" ::: "memory");
    __syncthreads();
    if (threadIdx.x == 0) {
        unsigned* bar = b.bar;
        __builtin_amdgcn_s_waitcnt(0);
        unsigned nloc = b.st[0], nx = b.st[1];
        if (nloc == 0u) { xcd_barrier_complete(bar, b.x, nloc, nx); b.st[0] = nloc; b.st[1] = nx; }
        const unsigned old = xb_add(&bar[XB_XSUB(b.x)], 1u);
        const unsigned gen = old / nloc;
        if (old + 1u == (gen + 1u) * nloc) {
            __builtin_amdgcn_fence(__ATOMIC_RELEASE, "agent");
            asm volatile("s_waitcnt vmcnt(0)" ::: "memory");
            const unsigned og = xb_add(&bar[XB_TOP], 1u);
            const unsigned tg = og / nx;
            if (og + 1u == (tg + 1u) * nx) xb_add(&bar[XB_TOPGEN], 1u);
            else XB_SPIN(xb_ld(&bar[XB_TOPGEN]) == tg, bar);
            __builtin_amdgcn_fence(__ATOMIC_ACQUIRE, "agent");
            xb_add(&bar[XB_XGEN(b.x)], 1u);
            asm volatile("s_waitcnt vmcnt(0)" ::: "memory");
        } else {
            XB_SPIN(xb_ld(&bar[XB_XGEN(b.x)]) == gen, bar);
            __builtin_amdgcn_fence(__ATOMIC_ACQUIRE, "agent");
            asm volatile("s_waitcnt vmcnt(0)" ::: "memory");
        }
    }
    __syncthreads();
}


#define RUN(k) (lo <= (k) && (k) < hi)
#define SYNC(k) do { if ((k) + 1 < hi) xcd_barrier(bar); } while (0)
template <int l>
__device__ __forceinline__ void layer_phases(const Params& P, LAS unsigned char* lds, const XcdBarrier& bar) {
    const int lo = P.ph_lo, hi = P.ph_hi;
    const int G = gridDim.x, c = blockIdx.x;
    unsigned char* ws = P.ws;
    const float* MOD = (const float*)(ws + WS_MOD);
    bf16_t* H = (bf16_t*)(ws + WS_H);
    bf16_t* Z = (bf16_t*)(ws + WS_Z);
    bf16_t* PSb = (bf16_t*)(ws + WS_PS);
    constexpr int pb = 1 + 9 * l;
    const unsigned char* wl = ws + WS_W + (size_t)l * WL_SIZE;
    const float* modl = MOD + (size_t)l * 12 * 6144;
    const float* srcp = l == 0 ? P.x_prompt : P.out + O_YP;
    const float* srcs = l == 0 ? P.x_sample : P.out + O_YS;
    if (RUN(pb + 0)) { phase_norm(P, lds, srcp, srcs, P.norm1_g + l * D, modl + 0 * D, modl + 1 * D, l == 0 ? P.out + O_YS : nullptr); SYNC(pb + 0); }
    if (RUN(pb + 1)) {
        pg8::SimpleOrder S{(const char*)H, (const char*)(wl + WL_IN), (size_t)D * 2, (size_t)D * 2, M / 256, NIN / 256, D / 64, G, c};
        EpiZ E{Z, P.out, l};
        pg8::gemm_phase<EpiZ, pg8::SimpleOrder>(lds, (size_t)D * 2, (size_t)D * 2, S, E, STG_BIG * ((c >> 3) & 7));
        if (l == 0 && !P0_BOTH_LAYERS) {
            const int nunits = (M / 256) * (NIN / 256), heavy = nunits % G, nlight = heavy ? G - heavy : G;
            if (c >= heavy) {
                const int wave = __builtin_amdgcn_readfirstlane(threadIdx.x >> 6);
                p0_convert_layer(P, 1, (LAS float*)(lds + wave * 8704), threadIdx.x & 63, (c - heavy) * NWAVES + wave, nlight * NWAVES, 0, P0_SPLIT);
            }
        }
        SYNC(pb + 1);
    }
    if (l == 0 && PROBE == 1) {
        pg8::SimpleOrder S{(const char*)H, (const char*)(wl + WL_IN), (size_t)D * 2, (size_t)D * 2, M / 256, NIN / 256, D / 64, G, c};
        EpiZ E{Z, P.out, l};
        pg8::gemm_phase<EpiZ, pg8::SimpleOrder>(lds, (size_t)D * 2, (size_t)D * 2, S, E);
        xcd_barrier(bar);
    }
    if (l == 0 && PROBE == 6) { const bool dry = P.ph_hi < 100; for (int it = blockIdx.x; it < 1040; it += gridDim.x) attn_item(P, l, it, lds, dry); xcd_barrier(bar); }
    if (l == 0 && PROBE == 7) { const bool dry = P.ph_hi < 100; for (int it = blockIdx.x; it < 264; it += gridDim.x) mix_item(P, l, it, lds, dry); xcd_barrier(bar); }
    if (RUN(pb + 2)) { phase_mixers(P, l, lds); SYNC(pb + 2); }
    if (l == 0 && PROBE == 2) {
        pg8::SimpleOrder S{(const char*)H, (const char*)(wl + WL_IN), (size_t)D * 2, (size_t)D * 2, M / 256, NIN / 256, D / 64, G, c};
        EpiZ E{Z, P.out, l};
        pg8::gemm_phase<EpiZ, pg8::SimpleOrder>(lds, (size_t)D * 2, (size_t)D * 2, S, E);
        xcd_barrier(bar);
        phase_mixers(P, l, lds);
        xcd_barrier(bar);
    }
    if (RUN(pb + 3)) {
        pg8::MergeOrder S{(const char*)Z, (const char*)(wl + WL_CAT), (size_t)NIN * 2, (size_t)2048 * 2, G, c};
        EpiMerge E{Z, H, PSb};
        pg8::gemm_phase<EpiMerge, pg8::MergeOrder>(lds, (size_t)NIN * 2, (size_t)2048 * 2, S, E, c < 48 ? 0u : STG_MERGE * ((c >> 3) & 7));
        SYNC(pb + 3);
    }
    if (RUN(pb + 4)) {
        pg8::ResOrder S{(const char*)H, (const char*)(wl + WL_OUT), (size_t)D * 2, (size_t)D * 2, D / 64, G, c,
                        (const char*)PSb, (const char*)(PSb + (size_t)MS * D), (const char*)(PSb + 2 * (size_t)MS * D), 12};
        EpiRes E{srcp, srcs, P.out, modl + 2 * D};
        pg8::gemm_phase<EpiRes, pg8::ResOrder>(lds, (size_t)D * 2, (size_t)D * 2, S, E, c < 48 ? 0u : STG_OUT * ((c >> 3) & 7));
        SYNC(pb + 4);
    }
    if (RUN(pb + 5)) { phase_norm(P, lds, P.out + O_YP, P.out + O_YS, P.norm2_g + l * D, modl + 3 * D, modl + 4 * D); SYNC(pb + 5); }
    if (RUN(pb + 6)) {
        pg8::UpOrder S{(const char*)H, (const char*)(wl + WL_UP), (size_t)D * 2, (size_t)D * 2, (M + 253) / 254, NUP / 256, D / 64, G, c};
        EpiUpConv E{Z, P.out, P.ffn_conv_w + (size_t)l * 3 * DFF, P.ffn_conv_b + (size_t)l * DFF, P.state_conv + (size_t)l * 8 * 2 * DFF, l, lds};
        pg8::gemm_phase<EpiUpConv, pg8::UpOrder>(lds, (size_t)D * 2, (size_t)D * 2, S, E, STG_BIG * ((c >> 3) & 7));
        if (l == 0 && !P0_BOTH_LAYERS) {
            const int nunits = ((M + 253) / 254) * (NUP / 256), heavy = nunits % G, nlight = heavy ? G - heavy : G;
            if (c >= (heavy ? heavy : 0)) {
                const int wave = __builtin_amdgcn_readfirstlane(threadIdx.x >> 6);
                p0_convert_layer(P, 1, (LAS float*)(lds + wave * 8704), threadIdx.x & 63, (c - (heavy ? heavy : 0)) * NWAVES + wave, nlight * NWAVES, P0_SPLIT, P0_I_L);
            }
        }
        SYNC(pb + 6);
    }
    if (l == 0 && PROBE == 8) {
        pg8::UpOrder S{(const char*)H, (const char*)(wl + WL_UP), (size_t)D * 2, (size_t)D * 2, (M + 253) / 254, NUP / 256, D / 64, G, c};
        EpiUpConv E{Z, P.out, P.ffn_conv_w + (size_t)l * 3 * DFF, P.ffn_conv_b + (size_t)l * DFF, P.state_conv + (size_t)l * 8 * 2 * DFF, l, lds};
        pg8::gemm_phase<EpiUpConv, pg8::UpOrder>(lds, (size_t)D * 2, (size_t)D * 2, S, E);
        xcd_barrier(bar);
    }
    if (RUN(pb + 8)) {
        pg8::ResOrder S{(const char*)Z, (const char*)(wl + WL_DN), (size_t)DFF * 2, (size_t)DFF * 2, DFF / 64, G, c,
                        (const char*)(Z + (size_t)MP * DFF), nullptr, nullptr, 11};
        EpiRes E{P.out + O_YP, P.out + O_YS, P.out, modl + 5 * D};
        pg8::gemm_phase<EpiRes, pg8::ResOrder>(lds, (size_t)DFF * 2, (size_t)DFF * 2, S, E, c < 48 ? 0u : STG_DOWN * ((c >> 3) & 7));
        SYNC(pb + 8);
    }
}
__global__ void __launch_bounds__(NTHREADS) mk_fwd(Params P) {
    extern __shared__ __attribute__((aligned(16))) unsigned char lds_raw[];
    LAS unsigned char* lds = (LAS unsigned char*)lds_raw;
    cg::grid_group grid = cg::this_grid();
    const int lo = P.ph_lo, hi = P.ph_hi;
    unsigned* barw = (unsigned*)(P.ws + WS_BAR);
    volatile LAS unsigned* st = (volatile LAS unsigned*)(lds + XCH_OFF + 4096);
    if (threadIdx.x < 2) st[threadIdx.x] = 0u;
    if (lo == 0 && blockIdx.x == 0) for (int i = threadIdx.x; i < XCD_BAR_WORDS; i += NTHREADS) barw[i] = 0u;
    __syncthreads();
    if (RUN(0)) { phase_p0(P, lds); if (1 < hi) grid.sync(); }
    XcdBarrier bar = xcd_barrier_post(barw, st);
    if (PROBE == 4) { phase_p0(P, lds); xcd_barrier(bar); phase_norm(P, lds, P.x_prompt, P.x_sample, P.norm1_g, (const float*)(P.ws + WS_MOD), (const float*)(P.ws + WS_MOD) + D); xcd_barrier(bar); }
    if (PROBE == 5) { for (int i = 0; i < 20; ++i) xcd_barrier(bar); }
    layer_phases<0>(P, lds, bar);
    layer_phases<1>(P, lds, bar);
    if (RUN(19)) phase_final(P);
}
#undef RUN
#undef SYNC

extern "C" void kernel_launch(void* const* d_in, const int* in_sizes, int n_in, void* d_out, int out_size, void* d_ws, size_t ws_size, hipStream_t stream) {
    static int grid = 0;
    if (grid == 0) {
        if (n_in != 28 || ws_size < WS_END) { fprintf(stderr, "kernel_launch: need 28 inputs and %zu B of workspace (got %d, %zu)\n", (size_t)WS_END, n_in, ws_size); grid = -1; return; }
        int dev = 0, cus = 0, per_cu = 0;
        hipGetDevice(&dev);
        hipDeviceGetAttribute(&cus, hipDeviceAttributeMultiprocessorCount, dev);
        if (hipFuncSetAttribute((const void*)mk_fwd, hipFuncAttributeMaxDynamicSharedMemorySize, LDS_BYTES) != hipSuccess) { fprintf(stderr, "kernel_launch: hipFuncSetAttribute failed\n"); grid = -1; return; }
        if (hipOccupancyMaxActiveBlocksPerMultiprocessor(&per_cu, (const void*)mk_fwd, NTHREADS, LDS_BYTES) != hipSuccess || per_cu < 1) { fprintf(stderr, "kernel_launch: occupancy query failed (%d)\n", per_cu); per_cu = 1; }
        (void)hipGetLastError();
        grid = cus * per_cu;
    }
    if (grid < 0) return;
    Params p{};
    const float** ip = (const float**)&p;
    for (int i = 0; i < 28; ++i) ip[i] = (const float*)d_in[i];
    p.out = (float*)d_out; p.ws = (unsigned char*)d_ws;
#if MULTI_LAUNCH
    for (int ph = 0; ph < NPHASES; ++ph) {
        p.ph_lo = ph; p.ph_hi = ph + 1;
        hipLaunchKernelGGL(mk_fwd, dim3(grid), dim3(NTHREADS), LDS_BYTES, stream, p);
    }
#else
    p.ph_lo = 0; p.ph_hi = NPHASES;
    void* args[] = {&p};
    hipError_t e = hipLaunchCooperativeKernel((const void*)mk_fwd, dim3(grid), dim3(NTHREADS), args, LDS_BYTES, stream);
    if (e != hipSuccess) fprintf(stderr, "cooperative launch failed: %s (grid %d)\n", hipGetErrorString(e), grid);
#endif
}
```
